# Optimizing an MI355X kernel written in HIP

```python
import jax, jax.numpy as jnp
from jax import lax
import numpy as np

D_MODEL = 1024
BATCH = 4
SEQ = 4096
DEPTH = 1

CONV_WIDTH = 512
CONV_K = 3
RET_HEADS = 8
RET_DK = 64
RET_DV = 128
RET_CHUNK = 128
QK_WIDTH = RET_HEADS * RET_DK
V_WIDTH = RET_HEADS * RET_DV
ROPE_BASE = 10000.0
IN_SPLITS = (CONV_WIDTH, CONV_WIDTH, CONV_WIDTH, QK_WIDTH, QK_WIDTH, V_WIDTH, V_WIDTH, D_MODEL, D_MODEL)
IN_WIDTH = sum(IN_SPLITS)
SPLIT_POINTS = [sum(IN_SPLITS[:i + 1]) for i in range(len(IN_SPLITS) - 1)]
MEM_LEN = 256
XA_HEADS = 4
XA_HEAD_DIM = D_MODEL // XA_HEADS
N_GROUPS = 4
EXPERTS_PER_GROUP = 8
N_EXPERTS = N_GROUPS * EXPERTS_PER_GROUP
TOP_K = 2
EXPERT_HIDDEN = D_MODEL // 2
EXPERT_BLOCK = 128
EPS = 1e-6

kernel_name = "hybrid_conv_retention_xattn_hmoe"


def rmsnorm(x, g):
    xf = x.astype(jnp.float32)
    y = xf * lax.rsqrt(jnp.mean(xf * xf, axis=-1, keepdims=True) + EPS)
    return (y * g.astype(jnp.float32)).astype(x.dtype)


def short_conv_branch(xin, bg, cg, conv_w, w_out):
    u = cg * xin
    rhs = conv_w[:, None, :].astype(u.dtype)
    c = lax.conv_general_dilated(u, rhs, window_strides=(1,), padding=((CONV_K - 1, 0),),
                                 dimension_numbers=('NWC', 'WIO', 'NWC'),
                                 feature_group_count=CONV_WIDTH)
    return (bg * c) @ w_out


def rotary(t, cos, sin):
    t1, t2 = jnp.split(t.astype(jnp.float32), 2, axis=-1)
    return jnp.concatenate([t1 * cos - t2 * sin, t1 * sin + t2 * cos], axis=-1).astype(t.dtype)


def retention_branch(q, k, v, g, w_out):
    b, s, _ = q.shape
    n = s // RET_CHUNK
    pos = jnp.arange(s, dtype=jnp.float32)
    inv_freq = ROPE_BASE ** (-jnp.arange(0, RET_DK, 2, dtype=jnp.float32) / RET_DK)
    ang = pos[:, None] * inv_freq[None, :]
    cos, sin = jnp.cos(ang)[:, None, :], jnp.sin(ang)[:, None, :]
    q = rotary(q.reshape(b, s, RET_HEADS, RET_DK), cos, sin)
    k = rotary(k.reshape(b, s, RET_HEADS, RET_DK), cos, sin) * (RET_DK ** -0.5)
    v = v.reshape(b, s, RET_HEADS, RET_DV)

    def to_chunks(t, d):
        return t.reshape(b, n, RET_CHUNK, RET_HEADS, d).transpose(0, 3, 1, 2, 4)

    qc, kc, vc = to_chunks(q, RET_DK), to_chunks(k, RET_DK), to_chunks(v, RET_DV)

    log_g = jnp.log(1.0 - jnp.power(2.0, -5.0 - jnp.arange(RET_HEADS, dtype=jnp.float32)))
    idx = jnp.arange(RET_CHUNK, dtype=jnp.float32)
    diff = idx[:, None] - idx[None, :]
    decay = jnp.where(diff >= 0, jnp.exp(jnp.maximum(diff, 0.0)[None] * log_g[:, None, None]), 0.0)
    zeta = jnp.exp((RET_CHUNK - 1 - idx)[None, :] * log_g[:, None])
    xi = jnp.exp((idx + 1)[None, :] * log_g[:, None])
    chunk_decay = jnp.exp(RET_CHUNK * log_g)

    scores = jnp.einsum('bhnqd,bhnkd->bhnqk', qc, kc) * decay[None, :, None]
    inner = jnp.einsum('bhnqk,bhnke->bhnqe', scores, vc)
    kv = jnp.einsum('bhnkd,bhnke->nbhde', kc * zeta[None, :, None, :, None], vc)

    def step(state, kv_n):
        return chunk_decay[None, :, None, None] * state + kv_n, state

    _, state_prev = lax.scan(step, jnp.zeros_like(kv[0]), kv)
    cross = jnp.einsum('bhnqd,nbhde->bhnqe', qc, state_prev) * xi[None, :, None, :, None]

    o = (inner + cross).astype(jnp.float32).transpose(0, 2, 3, 1, 4).reshape(b, s, RET_HEADS, RET_DV)
    mu = jnp.mean(o, axis=-1, keepdims=True)
    var = jnp.mean(jnp.square(o - mu), axis=-1, keepdims=True)
    o = ((o - mu) * lax.rsqrt(var + EPS)).reshape(b, s, V_WIDTH).astype(g.dtype)
    return (jax.nn.silu(g) * o) @ w_out


def cross_attn(hn, mn, w_q, w_kv, w_o):
    b, s, d = hn.shape
    m = mn.shape[1]
    q = (hn @ w_q).reshape(b, s, XA_HEADS, XA_HEAD_DIM)
    k, v = jnp.split(mn @ w_kv, 2, axis=-1)
    k = k.reshape(b, m, XA_HEADS, XA_HEAD_DIM)
    v = v.reshape(b, m, XA_HEADS, XA_HEAD_DIM)
    scores = jnp.einsum('bshd,bmhd->bhsm', q, k).astype(jnp.float32) * (XA_HEAD_DIM ** -0.5)
    p = jax.nn.softmax(scores, axis=-1).astype(v.dtype)
    o = jnp.einsum('bhsm,bmhd->bshd', p, v).reshape(b, s, d)
    return o @ w_o


def hier_moe(xn, w_group, b_group, w_router, b_router, w_gate, w_up, w_down):
    b, s, d = xn.shape
    t = b * s
    xf = xn.reshape(t, d)
    grp_prob = jax.nn.softmax((xf @ w_group + b_group).astype(jnp.float32), axis=-1)
    p_g, g_idx = lax.top_k(grp_prob, 1)
    exp_logits = (xf @ w_router + b_router).astype(jnp.float32).reshape(t, N_GROUPS, EXPERTS_PER_GROUP)
    sel = jnp.take_along_axis(exp_logits, g_idx[:, :, None], axis=1)[:, 0]
    p_e, e_local = lax.top_k(jax.nn.softmax(sel, axis=-1), TOP_K)
    weights = p_g * p_e / jnp.sum(p_e, axis=-1, keepdims=True)
    expert_id = g_idx * EXPERTS_PER_GROUP + e_local

    m = t * TOP_K
    flat_e = expert_id.reshape(-1)
    flat_w = weights.reshape(-1)
    flat_tok = jnp.repeat(jnp.arange(t, dtype=jnp.int32), TOP_K)
    order = jnp.argsort(flat_e)
    sorted_e = flat_e[order]
    counts = jnp.bincount(flat_e, length=N_EXPERTS)
    starts = jnp.cumsum(counts) - counts
    padded = (counts + EXPERT_BLOCK - 1) // EXPERT_BLOCK * EXPERT_BLOCK
    padded_ends = jnp.cumsum(padded)
    padded_starts = padded_ends - padded
    dest = padded_starts[sorted_e] + jnp.arange(m) - starts[sorted_e]
    n_rows = -(-(m + N_EXPERTS * (EXPERT_BLOCK - 1)) // EXPERT_BLOCK) * EXPERT_BLOCK
    n_blocks = n_rows // EXPERT_BLOCK
    row_tok = jnp.zeros((n_rows,), jnp.int32).at[dest].set(flat_tok[order])
    row_w = jnp.zeros((n_rows,), jnp.float32).at[dest].set(flat_w[order])
    block_e = jnp.minimum(jnp.searchsorted(padded_ends, jnp.arange(n_blocks) * EXPERT_BLOCK, side='right'),
                          N_EXPERTS - 1)
    xs = xf[row_tok].reshape(n_blocks, EXPERT_BLOCK, d)

    def expert_block(args):
        xb, e = args
        hid = jax.nn.silu(xb @ w_gate[e]) * (xb @ w_up[e])
        return hid @ w_down[e]

    ys = lax.map(expert_block, (xs, block_e)).reshape(n_rows, d)
    out = jnp.zeros((t, d), xn.dtype).at[row_tok].add((ys * row_w[:, None]).astype(xn.dtype))
    return out.reshape(b, s, d)


def _w(key, shape, fan_in):
    return jax.random.normal(key, shape, jnp.float32) * (fan_in ** -0.5)


def _gain(key, shape):
    return 1.0 + 0.01 * jax.random.normal(key, shape, jnp.float32)


def setup_inputs(seed: int = 0) -> dict:
    key = jax.random.key(seed)
    ks = jax.random.split(key, 22)
    L, D = DEPTH, D_MODEL
    return {
        "x": jax.random.normal(ks[0], (BATCH, SEQ, D), jnp.float32),
        "mem": jax.random.normal(ks[1], (BATCH, MEM_LEN, D), jnp.float32),
        "mix_norm_g": _gain(ks[2], (L, D)),
        "w_in": _w(ks[3], (L, D, IN_WIDTH), D),
        "conv_w": _w(ks[4], (L, CONV_K, CONV_WIDTH), CONV_K),
        "w_conv_out": _w(ks[5], (L, CONV_WIDTH, D), CONV_WIDTH),
        "w_ret_out": _w(ks[6], (L, V_WIDTH, D), V_WIDTH),
        "w_mix_out": _w(ks[7], (L, D, D), D),
        "xa_norm_g": _gain(ks[8], (L, D)),
        "mem_norm_g": _gain(ks[9], (L, D)),
        "w_xa_q": _w(ks[10], (L, D, D), D),
        "w_xa_kv": _w(ks[11], (L, D, 2 * D), D),
        "w_xa_o": _w(ks[12], (L, D, D), D),
        "moe_norm_g": _gain(ks[13], (L, D)),
        "w_group": _w(ks[14], (L, D, N_GROUPS), D),
        "b_group": 0.01 * jax.random.normal(ks[15], (L, N_GROUPS), jnp.float32),
        "w_router": _w(ks[16], (L, D, N_EXPERTS), D),
        "b_router": 0.01 * jax.random.normal(ks[17], (L, N_EXPERTS), jnp.float32),
        "w_gate": _w(ks[18], (L, N_EXPERTS, D, EXPERT_HIDDEN), D),
        "w_up": _w(ks[19], (L, N_EXPERTS, D, EXPERT_HIDDEN), D),
        "w_down": _w(ks[20], (L, N_EXPERTS, EXPERT_HIDDEN, D), EXPERT_HIDDEN),
        "final_norm_g": _gain(ks[21], (D,)),
    }


def reference(x, mem, mix_norm_g, w_in, conv_w, w_conv_out, w_ret_out, w_mix_out,
              xa_norm_g, mem_norm_g, w_xa_q, w_xa_kv, w_xa_o, moe_norm_g,
              w_group, b_group, w_router, b_router, w_gate, w_up, w_down, final_norm_g):
    h = x
    for l in range(DEPTH):
        xn = rmsnorm(h, mix_norm_g[l])
        xin, bg, cg, q, k, v, g, gate_c, gate_r = jnp.split(xn @ w_in[l], SPLIT_POINTS, axis=-1)
        y_conv = short_conv_branch(xin, bg, cg, conv_w[l], w_conv_out[l])
        y_ret = retention_branch(q, k, v, g, w_ret_out[l])
        merged = jax.nn.sigmoid(gate_c) * y_conv + jax.nn.sigmoid(gate_r) * y_ret
        h = h + merged @ w_mix_out[l]
        h = h + cross_attn(rmsnorm(h, xa_norm_g[l]), rmsnorm(mem, mem_norm_g[l]),
                           w_xa_q[l], w_xa_kv[l], w_xa_o[l])
        h = h + hier_moe(rmsnorm(h, moe_norm_g[l]), w_group[l], b_group[l], w_router[l], b_router[l],
                         w_gate[l], w_up[l], w_down[l])
    return rmsnorm(h, final_norm_g)
```

```cpp
#include <hip/hip_runtime.h>
#include <cstdio>
#include <cstdint>

typedef unsigned short bf16;
#define DEVI __device__ __forceinline__

constexpr int DM = 1024, NB = 4, SEQ = 4096, T = NB * SEQ;
constexpr int PROJ_LD = 6656;
constexpr int C_XIN = 0, C_BG = 512, C_CG = 1024, C_Q = 1536, C_K = 2048, C_V = 2560, C_G = 3584, C_GC = 4608, C_GR = 5632;
constexpr int RH = 8, RDK = 64, RDV = 128, RCH = 128;
constexpr int MEML = 256, XH = 4, XHD = 256;
constexpr int NE = 32, EH = 512;
constexpr int XS_ROWS = 40960;
constexpr float EPS = 1e-6f;
constexpr float QSCALE = 0.0625f * 1.4426950408889634f;

constexpr size_t MiB = 1u << 20;
constexpr size_t WS_CTL = 0;
constexpr size_t WS_ROPE = 1 * MiB;
constexpr size_t WS_WCAT = 2 * MiB;
constexpr size_t WS_WMIX = 5 * MiB;
constexpr size_t WS_WQ = 7 * MiB;
constexpr size_t WS_WKV = 9 * MiB;
constexpr size_t WS_WO = 13 * MiB;
constexpr size_t WS_WRT = 15 * MiB;
constexpr size_t WS_SSQ1 = 16 * MiB;
constexpr size_t WS_SSQ2 = 17 * MiB;
constexpr size_t WS_RS2 = 18 * MiB;
constexpr size_t WS_LID = 19 * MiB;
constexpr size_t WS_LW = 21 * MiB;
constexpr size_t WS_RID = 23 * MiB;
constexpr size_t WS_RW = WS_RID + 256 * 1024;
constexpr size_t WS_RRS = WS_RW + 256 * 1024;
constexpr size_t WS_MN = 24 * MiB;
constexpr size_t WS_KVM = 26 * MiB;
constexpr size_t WS_E = 30 * MiB;
constexpr size_t WS_WIN = 38 * MiB;
constexpr size_t WS_HID = 38 * MiB;
constexpr size_t WS_XN = 51 * MiB;
constexpr size_t WS_PROJ = 83 * MiB;
constexpr size_t WS_EGU = 83 * MiB;
constexpr size_t WS_ED = 147 * MiB;
constexpr size_t WS_XS = 179 * MiB;
constexpr size_t WS_HB = 259 * MiB;
constexpr size_t WS_END = 291 * MiB;
constexpr int CW_CNT = 64;

DEVI float bf2f(bf16 v) { return __uint_as_float((unsigned)v << 16); }
DEVI bf16 f2bf(float f) { unsigned u = __float_as_uint(f); return (bf16)((u + 0x7fffu + ((u >> 16) & 1u)) >> 16); }
DEVI float sigmoidf_(float x) { return 1.f / (1.f + __expf(-x)); }

__constant__ double c_invfreq[32] = {
    1.0, 0.7498942093324559, 0.5623413251903491, 0.4216965034285822, 0.31622776601683794, 0.23713737056616552,
    0.1778279410038923, 0.1333521432163324, 0.1, 0.07498942093324558, 0.05623413251903491, 0.04216965034285822,
    0.03162277660168379, 0.023713737056616554, 0.01778279410038923, 0.01333521432163324, 0.01, 0.007498942093324558,
    0.005623413251903491, 0.004216965034285823, 0.0031622776601683794, 0.0023713737056616554, 0.0017782794100389228,
    0.001333521432163324, 0.001, 0.0007498942093324559, 0.0005623413251903491, 0.0004216965034285823,
    0.00031622776601683794, 0.00023713737056616554, 0.00017782794100389227, 0.0001333521432163324};

__global__ void k_transpose(const float* __restrict__ W, int K, int N, bf16* WT, int ldwt, int koff, const float* __restrict__ kscale, int mode, size_t wstride, size_t wtstride) {
    W += (size_t)blockIdx.z * wstride; WT += (size_t)blockIdx.z * wtstride;
    const int n = blockIdx.x * 64 + (threadIdx.x & 63), k0 = blockIdx.y * 64 + (threadIdx.x >> 6) * 16;
    if (n >= N) return;
    int r = n;
    if (mode == 1) { if (n >= C_Q && n < C_V) { const int o = n & 63; r = (n & ~63) + 2 * (o & 31) + (o >> 5); } }
    else if (mode == 2) r = (n >> 7) * 256 + (n & 127);
    else if (mode == 3) r = (n >> 7) * 256 + 128 + (n & 127);
    for (int k = k0; k < k0 + 16 && k < K; ++k) {
        float v = W[(size_t)k * N + n]; if (kscale) v *= kscale[k];
        WT[(size_t)r * ldwt + koff + k] = f2bf(v);
    }
}
__global__ void k_zero_bf16(bf16* p, size_t n) { size_t i = (size_t)blockIdx.x * 256 + threadIdx.x; if (i < n) p[i] = 0; }

__global__ void k_rmsnorm_bf16(const float* __restrict__ x, const float* __restrict__ g, bf16* out) {
    const int row = blockIdx.x, t = threadIdx.x;
    const float4 v = ((const float4*)(x + (size_t)row * DM))[t];
    float s = v.x * v.x + v.y * v.y + v.z * v.z + v.w * v.w;
    __shared__ float red[4];
    for (int o = 32; o; o >>= 1) s += __shfl_xor(s, o);
    if ((t & 63) == 0) red[t >> 6] = s;
    __syncthreads();
    const float rstd = rsqrtf((red[0] + red[1] + red[2] + red[3]) * (1.f / DM) + EPS);
    const float4 gg = ((const float4*)g)[t];
    bf16* o = out + (size_t)row * DM + 4 * t;
    o[0] = f2bf(v.x * rstd * gg.x); o[1] = f2bf(v.y * rstd * gg.y); o[2] = f2bf(v.z * rstd * gg.z); o[3] = f2bf(v.w * rstd * gg.w);
}
__global__ void k_rope(float2* tab) {
    const int i = blockIdx.x * 256 + threadIdx.x; if (i >= SEQ * 32) return;
    const int pos = i >> 5, p = i & 31;
    const float ang = (float)pos * (float)c_invfreq[p];
    const double rev = (double)ang * 0.15915494309189535;
    const float fr = (float)(rev - floor(rev));
    tab[i] = make_float2(__builtin_amdgcn_cosf(fr), __builtin_amdgcn_sinf(fr));
}

template <class P> __global__ void __launch_bounds__(256) k_ngemm(P p) {
    __shared__ float As[16][65], Bs[16][65];
    const int mt = blockIdx.y; if (!p.valid(mt)) return;
    const int m0 = mt * 64, n0 = blockIdx.x * 64, tx = threadIdx.x & 15, ty = threadIdx.x >> 4;
    float a1[4][4] = {}, a2[4][4] = {};
    const int lr = threadIdx.x >> 2, lk = (threadIdx.x & 3) * 4;
    for (int seg = 0; seg < 2; ++seg) {
        const int Ks = seg ? p.K2 : p.K1; if (!Ks) continue;
        const bf16* ap = p.a_ptr(seg, m0 + lr); const bf16* bp = p.b_ptr(seg, mt, n0 + lr);
        for (int k0 = 0; k0 < Ks; k0 += 16) {
            const ushort4 av = *(const ushort4*)(ap + k0 + lk), bv = *(const ushort4*)(bp + k0 + lk);
            As[lk + 0][lr] = bf2f(av.x); As[lk + 1][lr] = bf2f(av.y); As[lk + 2][lr] = bf2f(av.z); As[lk + 3][lr] = bf2f(av.w);
            Bs[lk + 0][lr] = bf2f(bv.x); Bs[lk + 1][lr] = bf2f(bv.y); Bs[lk + 2][lr] = bf2f(bv.z); Bs[lk + 3][lr] = bf2f(bv.w);
            __syncthreads();
#pragma unroll
            for (int k = 0; k < 16; ++k) {
                float a[4], b[4];
#pragma unroll
                for (int i = 0; i < 4; ++i) { a[i] = As[k][ty * 4 + i]; b[i] = Bs[k][tx * 4 + i]; }
#pragma unroll
                for (int i = 0; i < 4; ++i)
#pragma unroll
                    for (int j = 0; j < 4; ++j) { if (seg) a2[i][j] += a[i] * b[j]; else a1[i][j] += a[i] * b[j]; }
            }
            __syncthreads();
        }
    }
#pragma unroll
    for (int i = 0; i < 4; ++i) p.epi(m0 + ty * 4 + i, n0 + tx * 4, a1[i], a2[i]);
}

struct P_inproj {
    int K1, K2; const bf16* xn; const bf16* win; bf16* proj; const float2* rope;
    DEVI const bf16* a_ptr(int, int m) const { return xn + (size_t)m * DM; }
    DEVI const bf16* b_ptr(int, int, int n) const { return win + (size_t)n * DM; }
    DEVI bool valid(int) const { return true; }
    DEVI void epi(int m, int n0, const float* a, const float*) const {
        float v[4] = {a[0], a[1], a[2], a[3]};
        if (n0 >= C_Q && n0 < C_V) {
            const int pos = m & (SEQ - 1), p0 = (n0 & 63) >> 1; const float sc = n0 >= C_K ? 0.125f : 1.f;
#pragma unroll
            for (int j = 0; j < 2; ++j) { const float2 cs = rope[pos * 32 + p0 + j]; const float t1 = v[2 * j], t2 = v[2 * j + 1];
                v[2 * j] = (t1 * cs.x - t2 * cs.y) * sc; v[2 * j + 1] = (t1 * cs.y + t2 * cs.x) * sc; }
        }
        bf16* o = proj + (size_t)m * PROJ_LD + n0;
#pragma unroll
        for (int j = 0; j < 4; ++j) o[j] = f2bf(v[j]);
    }
};
struct P_plain {
    int K1, K2; const bf16* A; const bf16* Bt; bf16* C; int lda, ldb, ldc, pad;
    DEVI const bf16* a_ptr(int, int m) const { return A + (size_t)m * lda; }
    DEVI const bf16* b_ptr(int, int, int n) const { return Bt + (size_t)n * ldb; }
    DEVI bool valid(int) const { return true; }
    DEVI void epi(int m, int n0, const float* a, const float*) const { bf16* o = C + (size_t)m * ldc + n0;
#pragma unroll
        for (int j = 0; j < 4; ++j) o[j] = f2bf(a[j]); }
};
__global__ void k_conv(bf16* proj, const float* __restrict__ cw) {
    const int c = threadIdx.x + (blockIdx.x & 1) * 256, t0 = (blockIdx.x >> 1) * 16, tb = t0 & ~(SEQ - 1);
    const float w0 = cw[c], w1 = cw[512 + c], w2 = cw[1024 + c];
    float u1 = 0.f, u2 = 0.f;
    for (int t = t0 - 2; t < t0 + 16; ++t) {
        float u = 0.f;
        if (t >= tb) { const bf16* r = proj + (size_t)t * PROJ_LD; u = bf2f(r[C_CG + c]) * bf2f(r[C_XIN + c]); }
        if (t >= t0) { bf16* r = proj + (size_t)t * PROJ_LD; r[C_BG + c] = f2bf(bf2f(r[C_BG + c]) * (w0 * u2 + w1 * u1 + w2 * u)); }
        u2 = u1; u1 = u;
    }
}
__global__ void __launch_bounds__(256) k_ret_scan(const bf16* __restrict__ proj, float* OT) {
    const int b = blockIdx.x >> 3, h = blockIdx.x & 7, tid = threadIdx.x, dv = tid & 127, dh = tid >> 7;
    const float gamma = 1.f - exp2f(-5.f - (float)h);
    float st[32];
#pragma unroll
    for (int i = 0; i < 32; ++i) st[i] = 0.f;
    __shared__ float qs[64], ks[64], part[128];
    for (int t = 0; t < SEQ; ++t) {
        const bf16* r = proj + (size_t)(b * SEQ + t) * PROJ_LD;
        if (tid < 64) qs[tid] = bf2f(r[C_Q + h * 64 + tid]); else if (tid < 128) ks[tid - 64] = bf2f(r[C_K + h * 64 + tid - 64]);
        const float v = bf2f(r[C_V + h * 128 + dv]);
        __syncthreads();
        float o = 0.f;
#pragma unroll
        for (int i = 0; i < 32; ++i) { st[i] = gamma * st[i] + ks[dh * 32 + i] * v; o += qs[dh * 32 + i] * st[i]; }
        if (dh) part[dv] = o;
        __syncthreads();
        if (!dh) OT[(size_t)(b * SEQ + t) * DM + h * 128 + dv] = o + part[dv];
    }
}
__global__ void k_ret_gn(bf16* proj, const float* __restrict__ OT) {
    const int row = blockIdx.x, tid = threadIdx.x;
    const float4 v = ((const float4*)(OT + (size_t)row * DM))[tid];
    float s = v.x + v.y + v.z + v.w;
    for (int o = 16; o; o >>= 1) s += __shfl_xor(s, o);
    const float mu = s * (1.f / 128.f);
    const float d0 = v.x - mu, d1 = v.y - mu, d2 = v.z - mu, d3 = v.w - mu;
    float q = d0 * d0 + d1 * d1 + d2 * d2 + d3 * d3;
    for (int o = 16; o; o >>= 1) q += __shfl_xor(q, o);
    const float rs = rsqrtf(q * (1.f / 128.f) + EPS);
    bf16* g = proj + (size_t)row * PROJ_LD + C_G + 4 * tid;
    const float dd[4] = {d0, d1, d2, d3};
#pragma unroll
    for (int j = 0; j < 4; ++j) { const float gv = bf2f(g[j]); g[j] = f2bf(gv * sigmoidf_(gv) * dd[j] * rs); }
}
struct P_merge {
    int K1, K2; const bf16* proj; const bf16* wcat; bf16* mrg;
    DEVI const bf16* a_ptr(int seg, int m) const { return proj + (size_t)m * PROJ_LD + (seg ? C_G : C_BG); }
    DEVI const bf16* b_ptr(int seg, int, int n) const { return wcat + (size_t)n * 1536 + (seg ? 512 : 0); }
    DEVI bool valid(int) const { return true; }
    DEVI void epi(int m, int n0, const float* a1, const float* a2) const {
        const bf16* r = proj + (size_t)m * PROJ_LD; bf16* o = mrg + (size_t)m * DM + n0;
#pragma unroll
        for (int j = 0; j < 4; ++j) o[j] = f2bf(sigmoidf_(bf2f(r[C_GC + n0 + j])) * a1[j] + sigmoidf_(bf2f(r[C_GR + n0 + j])) * a2[j]);
    }
};
struct P_resid {
    int K1, K2; const bf16* A; const bf16* Bt; const float* base; float* H; bf16* HB;
    DEVI const bf16* a_ptr(int, int m) const { return A + (size_t)m * DM; }
    DEVI const bf16* b_ptr(int, int, int n) const { return Bt + (size_t)n * DM; }
    DEVI bool valid(int) const { return true; }
    DEVI void epi(int m, int n0, const float* a, const float*) const {
        const size_t off = (size_t)m * DM + n0;
#pragma unroll
        for (int j = 0; j < 4; ++j) { const float v = base[off + j] + a[j]; H[off + j] = v; HB[off + j] = f2bf(v); }
    }
};
__global__ void k_rowssq(const float* __restrict__ H, float* ssq) {
    const int row = blockIdx.x, t = threadIdx.x;
    const float4 v = ((const float4*)(H + (size_t)row * DM))[t];
    float s = v.x * v.x + v.y * v.y + v.z * v.z + v.w * v.w;
    __shared__ float red[4];
    for (int o = 32; o; o >>= 1) s += __shfl_xor(s, o);
    if ((t & 63) == 0) red[t >> 6] = s;
    __syncthreads();
    if (t < 16) ssq[(size_t)row * 16 + t] = t ? 0.f : red[0] + red[1] + red[2] + red[3];
}
DEVI float rstd_from_ssq(const float* ssq, int row) {
    const float4* p = (const float4*)(ssq + (size_t)row * 16); float s = 0.f;
#pragma unroll
    for (int i = 0; i < 4; ++i) { const float4 v = p[i]; s += (v.x + v.y) + (v.z + v.w); }
    return rsqrtf(s * (1.f / DM) + EPS);
}
struct P_q {
    int K1, K2; const bf16* A; const bf16* Bt; const float* ssq; bf16* Q;
    DEVI const bf16* a_ptr(int, int m) const { return A + (size_t)m * DM; }
    DEVI const bf16* b_ptr(int, int, int n) const { return Bt + (size_t)n * DM; }
    DEVI bool valid(int) const { return true; }
    DEVI void epi(int m, int n0, const float* a, const float*) const { const float s = rstd_from_ssq(ssq, m) * QSCALE; bf16* o = Q + (size_t)m * DM + n0;
#pragma unroll
        for (int j = 0; j < 4; ++j) o[j] = f2bf(a[j] * s); }
};
__global__ void __launch_bounds__(256) k_xattn(bf16* Q, const bf16* __restrict__ kvm) {
    const int tok = blockIdx.x >> 2, h = blockIdx.x & 3, b = tok >> 12, j = threadIdx.x;
    __shared__ float qs[256], ps[256], red[8];
    bf16* qrow = Q + (size_t)tok * DM + h * XHD;
    qs[j] = bf2f(qrow[j]);
    __syncthreads();
    const bf16* kr = kvm + (size_t)(b * MEML + j) * 2048 + h * XHD;
    float s = 0.f;
    for (int d = 0; d < XHD; d += 4) { const ushort4 kv = *(const ushort4*)(kr + d); s += qs[d] * bf2f(kv.x) + qs[d + 1] * bf2f(kv.y) + qs[d + 2] * bf2f(kv.z) + qs[d + 3] * bf2f(kv.w); }
    float mx = s;
    for (int o = 32; o; o >>= 1) mx = fmaxf(mx, __shfl_xor(mx, o));
    if ((j & 63) == 0) red[j >> 6] = mx;
    __syncthreads();
    mx = fmaxf(fmaxf(red[0], red[1]), fmaxf(red[2], red[3]));
    const float p = exp2f(s - mx);
    ps[j] = p;
    float sm = p;
    for (int o = 32; o; o >>= 1) sm += __shfl_xor(sm, o);
    if ((j & 63) == 0) red[4 + (j >> 6)] = sm;
    __syncthreads();
    sm = red[4] + red[5] + red[6] + red[7];
    float o = 0.f;
    const bf16* vb = kvm + (size_t)(b * MEML) * 2048 + 1024 + h * XHD + j;
    for (int m = 0; m < MEML; ++m) o += ps[m] * bf2f(vb[(size_t)m * 2048]);
    qrow[j] = f2bf(o / sm);
}
DEVI float dot1024(const bf16* a, const bf16* w) {
    float s = 0.f;
    for (int k = 0; k < DM; k += 4) { const ushort4 av = *(const ushort4*)(a + k), wv = *(const ushort4*)(w + k); s += bf2f(av.x) * bf2f(wv.x) + bf2f(av.y) * bf2f(wv.y) + bf2f(av.z) * bf2f(wv.z) + bf2f(av.w) * bf2f(wv.w); }
    return s;
}
__global__ void k_route(const bf16* __restrict__ HB, const bf16* __restrict__ wrt, const float* __restrict__ ssq, const float* __restrict__ bg, const float* __restrict__ br,
                        float* rs2, unsigned* cnt, int* lid, float* lw) {
    const int tok = blockIdx.x * 64 + threadIdx.x;
    const float rs = rstd_from_ssq(ssq, tok); rs2[tok] = rs;
    const bf16* a = HB + (size_t)tok * DM;
    int gi = 0; float gm = -3.0e38f, gs = 0.f;
    {   float l4[4];
#pragma unroll
        for (int n = 0; n < 4; ++n) l4[n] = dot1024(a, wrt + (size_t)n * DM) * rs + bg[n];
#pragma unroll
        for (int n = 0; n < 4; ++n) if (l4[n] > gm) { gm = l4[n]; gi = n; }
#pragma unroll
        for (int n = 0; n < 4; ++n) gs += __expf(l4[n] - gm);
    }
    const float pg = 1.f / gs;
    float le[8];
#pragma unroll
    for (int n = 0; n < 8; ++n) le[n] = dot1024(a, wrt + (size_t)(4 + gi * 8 + n) * DM) * rs + br[gi * 8 + n];
    int e1 = 0; float m1 = -3.0e38f;
#pragma unroll
    for (int n = 0; n < 8; ++n) if (le[n] > m1) { m1 = le[n]; e1 = n; }
    int e2 = 0; float m2 = -3.0e38f;
#pragma unroll
    for (int n = 0; n < 8; ++n) if (n != e1 && le[n] > m2) { m2 = le[n]; e2 = n; }
    const float x2 = __expf(m2 - m1), w1 = pg / (1.f + x2), w2 = pg * x2 / (1.f + x2);
    const int E1 = gi * 8 + e1, E2 = gi * 8 + e2;
    const unsigned p1 = atomicAdd(&cnt[E1], 1u), p2 = atomicAdd(&cnt[E2], 1u);
    lid[E1 * 16384 + p1] = tok * 2; lw[E1 * 16384 + p1] = w1;
    lid[E2 * 16384 + p2] = tok * 2 + 1; lw[E2 * 16384 + p2] = w2;
}
DEVI int tile_expert(const unsigned* cnt, int tile, int& first_tile) {
    int ts = 0;
    for (int e = 0; e < NE; ++e) { const int nt = ((int)cnt[e] + 255) >> 8; if (tile < ts + nt) { first_tile = ts; return e; } ts += nt; }
    first_tile = ts; return -1;
}
__global__ void k_gather(const bf16* __restrict__ HB, const unsigned* __restrict__ cnt, const int* __restrict__ lid, const float* __restrict__ lw, const float* __restrict__ rs2,
                         bf16* XS, int* rid, float* rw, float* rrs) {
    const int row = blockIdx.x; int ft; const int e = tile_expert(cnt, row >> 8, ft);
    if (e < 0) return;
    const int pos = row - ft * 256; const bool real = pos < (int)cnt[e];
    const int id = real ? lid[e * 16384 + pos] : -1; const int tok = real ? (id >> 1) : 0;
    if (threadIdx.x == 0) { rid[row] = id; rw[row] = real ? lw[e * 16384 + pos] : 0.f; rrs[row] = rs2[tok]; }
    ((uint2*)(XS + (size_t)row * DM))[threadIdx.x] = ((const uint2*)(HB + (size_t)tok * DM))[threadIdx.x];
}
struct P_gu {
    int K1, K2; const bf16* XS; const bf16* egu; const unsigned* cnt; const float* rrs; bf16* HID;
    DEVI const bf16* a_ptr(int, int m) const { return XS + (size_t)m * DM; }
    DEVI const bf16* b_ptr(int seg, int mt, int n) const { int ft; const int e = tile_expert(cnt, mt >> 2, ft); return egu + ((size_t)e * 1024 + (n >> 7) * 256 + seg * 128 + (n & 127)) * DM; }
    DEVI bool valid(int mt) const { int ft; return tile_expert(cnt, mt >> 2, ft) >= 0; }
    DEVI void epi(int m, int n0, const float* a1, const float* a2) const { const float rs = rrs[m]; bf16* o = HID + (size_t)m * EH + n0;
#pragma unroll
        for (int j = 0; j < 4; ++j) { const float g = a1[j] * rs, u = a2[j] * rs; o[j] = f2bf(g * sigmoidf_(g) * u); } }
};
struct P_down {
    int K1, K2; const bf16* HID; const bf16* ed; const unsigned* cnt; const int* rid; const float* rw; bf16* YB;
    DEVI const bf16* a_ptr(int, int m) const { return HID + (size_t)m * EH; }
    DEVI const bf16* b_ptr(int, int mt, int n) const { int ft; const int e = tile_expert(cnt, mt >> 2, ft); return ed + ((size_t)e * 1024 + n) * EH; }
    DEVI bool valid(int mt) const { int ft; return tile_expert(cnt, mt >> 2, ft) >= 0; }
    DEVI void epi(int m, int n0, const float* a, const float*) const { const int id = rid[m]; if (id < 0) return; const float w = rw[m]; bf16* o = YB + (size_t)id * DM + n0;
#pragma unroll
        for (int j = 0; j < 4; ++j) o[j] = f2bf(a[j] * w); }
};
__global__ void k_final(float* H, const bf16* __restrict__ YB, const float* __restrict__ g) {
    const int row = blockIdx.x, t = threadIdx.x;
    float4 v = ((const float4*)(H + (size_t)row * DM))[t];
    const ushort4 y0 = ((const ushort4*)(YB + (size_t)(2 * row) * DM))[t], y1 = ((const ushort4*)(YB + (size_t)(2 * row + 1) * DM))[t];
    v.x += bf2f(y0.x) + bf2f(y1.x); v.y += bf2f(y0.y) + bf2f(y1.y); v.z += bf2f(y0.z) + bf2f(y1.z); v.w += bf2f(y0.w) + bf2f(y1.w);
    float s = v.x * v.x + v.y * v.y + v.z * v.z + v.w * v.w;
    __shared__ float red[4];
    for (int o = 32; o; o >>= 1) s += __shfl_xor(s, o);
    if ((t & 63) == 0) red[t >> 6] = s;
    __syncthreads();
    const float rstd = rsqrtf((red[0] + red[1] + red[2] + red[3]) * (1.f / DM) + EPS);
    const float4 gg = ((const float4*)g)[t];
    ((float4*)(H + (size_t)row * DM))[t] = make_float4(v.x * rstd * gg.x, v.y * rstd * gg.y, v.z * rstd * gg.z, v.w * rstd * gg.w);
}

extern "C" void kernel_launch(void* const* d_in, const int* in_sizes, int n_in, void* d_out, int out_size, void* d_ws, size_t ws_size, hipStream_t stream) {
    if (n_in != 22 || out_size != T * DM || ws_size < WS_END) { fprintf(stderr, "kernel_launch: unexpected shapes (n_in %d out %d ws %zu)\n", n_in, out_size, ws_size); return; }
    const float* x = (const float*)d_in[0]; const float* mem = (const float*)d_in[1]; const float* mix_g = (const float*)d_in[2]; const float* w_in = (const float*)d_in[3];
    const float* conv_w = (const float*)d_in[4]; const float* w_conv_out = (const float*)d_in[5]; const float* w_ret_out = (const float*)d_in[6]; const float* w_mix_out = (const float*)d_in[7];
    const float* xa_g = (const float*)d_in[8]; const float* mem_g = (const float*)d_in[9]; const float* w_xa_q = (const float*)d_in[10]; const float* w_xa_kv = (const float*)d_in[11];
    const float* w_xa_o = (const float*)d_in[12]; const float* moe_g = (const float*)d_in[13]; const float* w_group = (const float*)d_in[14]; const float* b_group = (const float*)d_in[15];
    const float* w_router = (const float*)d_in[16]; const float* b_router = (const float*)d_in[17]; const float* w_gate = (const float*)d_in[18]; const float* w_up = (const float*)d_in[19];
    const float* w_down = (const float*)d_in[20]; const float* final_g = (const float*)d_in[21];
    char* ws = (char*)d_ws; float* H = (float*)d_out;
    unsigned* ctl = (unsigned*)(ws + WS_CTL); float2* rope = (float2*)(ws + WS_ROPE);
    bf16 *wcat = (bf16*)(ws + WS_WCAT), *wmix = (bf16*)(ws + WS_WMIX), *wq = (bf16*)(ws + WS_WQ), *wkv = (bf16*)(ws + WS_WKV), *wo = (bf16*)(ws + WS_WO), *wrt = (bf16*)(ws + WS_WRT);
    float *ssq1 = (float*)(ws + WS_SSQ1), *ssq2 = (float*)(ws + WS_SSQ2), *rs2 = (float*)(ws + WS_RS2), *lw = (float*)(ws + WS_LW), *rw = (float*)(ws + WS_RW), *rrs = (float*)(ws + WS_RRS);
    int *lid = (int*)(ws + WS_LID), *rid = (int*)(ws + WS_RID);
    bf16 *mn = (bf16*)(ws + WS_MN), *kvm = (bf16*)(ws + WS_KVM), *win = (bf16*)(ws + WS_WIN), *hid = (bf16*)(ws + WS_HID), *xn = (bf16*)(ws + WS_XN), *proj = (bf16*)(ws + WS_PROJ);
    bf16 *egu = (bf16*)(ws + WS_EGU), *ed = (bf16*)(ws + WS_ED), *xs = (bf16*)(ws + WS_XS), *hb = (bf16*)(ws + WS_HB);
    unsigned* cnt = ctl + CW_CNT;

    hipMemsetAsync(ws + WS_CTL, 0, 1 * MiB, stream);
    k_transpose<<<dim3(PROJ_LD / 64, 16, 1), 256, 0, stream>>>(w_in, DM, PROJ_LD, win, DM, 0, nullptr, 1, 0, 0);
    k_transpose<<<dim3(16, 8, 1), 256, 0, stream>>>(w_conv_out, 512, DM, wcat, 1536, 0, nullptr, 0, 0, 0);
    k_transpose<<<dim3(16, 16, 1), 256, 0, stream>>>(w_ret_out, DM, DM, wcat, 1536, 512, nullptr, 0, 0, 0);
    k_transpose<<<dim3(16, 16, 1), 256, 0, stream>>>(w_mix_out, DM, DM, wmix, DM, 0, nullptr, 0, 0, 0);
    k_transpose<<<dim3(16, 16, 1), 256, 0, stream>>>(w_xa_q, DM, DM, wq, DM, 0, xa_g, 0, 0, 0);
    k_transpose<<<dim3(32, 16, 1), 256, 0, stream>>>(w_xa_kv, DM, 2048, wkv, DM, 0, nullptr, 0, 0, 0);
    k_transpose<<<dim3(16, 16, 1), 256, 0, stream>>>(w_xa_o, DM, DM, wo, DM, 0, nullptr, 0, 0, 0);
    k_zero_bf16<<<(48 * DM + 255) / 256, 256, 0, stream>>>(wrt, 48 * DM);
    k_transpose<<<dim3(1, 16, 1), 256, 0, stream>>>(w_group, DM, 4, wrt, DM, 0, moe_g, 0, 0, 0);
    k_transpose<<<dim3(1, 16, 1), 256, 0, stream>>>(w_router, DM, 32, wrt + 4 * DM, DM, 0, moe_g, 0, 0, 0);
    k_rmsnorm_bf16<<<T, 256, 0, stream>>>(x, mix_g, xn);
    k_rmsnorm_bf16<<<NB * MEML, 256, 0, stream>>>(mem, mem_g, mn);
    k_rope<<<SEQ * 32 / 256, 256, 0, stream>>>(rope);
    { P_inproj p{DM, 0, xn, win, proj, rope}; k_ngemm<<<dim3(PROJ_LD / 64, T / 64), 256, 0, stream>>>(p); }
    { P_plain p{DM, 0, mn, wkv, kvm, DM, DM, 2048, 0}; k_ngemm<<<dim3(2048 / 64, NB * MEML / 64), 256, 0, stream>>>(p); }
    k_conv<<<2 * (T / 16), 256, 0, stream>>>(proj, conv_w);
    k_ret_scan<<<NB * RH, 256, 0, stream>>>(proj, H);
    k_ret_gn<<<T, 256, 0, stream>>>(proj, H);
    { P_merge p{512, 1024, proj, wcat, xn}; k_ngemm<<<dim3(DM / 64, T / 64), 256, 0, stream>>>(p); }
    { P_resid p{DM, 0, xn, wmix, x, H, hb}; k_ngemm<<<dim3(DM / 64, T / 64), 256, 0, stream>>>(p); }
    k_rowssq<<<T, 256, 0, stream>>>(H, ssq1);
    k_transpose<<<dim3(8, 16, NE), 256, 0, stream>>>(w_gate, DM, EH, egu, DM, 0, moe_g, 2, (size_t)DM * EH, (size_t)1024 * DM);
    k_transpose<<<dim3(8, 16, NE), 256, 0, stream>>>(w_up, DM, EH, egu, DM, 0, moe_g, 3, (size_t)DM * EH, (size_t)1024 * DM);
    k_transpose<<<dim3(16, 8, NE), 256, 0, stream>>>(w_down, EH, DM, ed, EH, 0, nullptr, 0, (size_t)EH * DM, (size_t)1024 * EH);
    { P_q p{DM, 0, hb, wq, ssq1, xn}; k_ngemm<<<dim3(DM / 64, T / 64), 256, 0, stream>>>(p); }
    k_xattn<<<T * XH, 256, 0, stream>>>(xn, kvm);
    { P_resid p{DM, 0, xn, wo, H, H, hb}; k_ngemm<<<dim3(DM / 64, T / 64), 256, 0, stream>>>(p); }
    k_rowssq<<<T, 256, 0, stream>>>(H, ssq2);
    k_route<<<T / 64, 64, 0, stream>>>(hb, wrt, ssq2, b_group, b_router, rs2, cnt, lid, lw);
    k_gather<<<XS_ROWS, 256, 0, stream>>>(hb, cnt, lid, lw, rs2, xs, rid, rw, rrs);
    { P_gu p{DM, DM, xs, egu, cnt, rrs, hid}; k_ngemm<<<dim3(EH / 64, XS_ROWS / 64), 256, 0, stream>>>(p); }
    { P_down p{EH, 0, hid, ed, cnt, rid, rw, xs}; k_ngemm<<<dim3(DM / 64, XS_ROWS / 64), 256, 0, stream>>>(p); }
    k_final<<<T, 256, 0, stream>>>(H, xs, final_g);
}
```

```cpp
#include <hip/hip_runtime.h>
#include <cstdio>
#include <cstdint>

typedef unsigned short bf16;
#define DEVI __device__ __forceinline__

constexpr int DM = 1024, NB = 4, SEQ = 4096, T = NB * SEQ;
constexpr int PROJ_LD = 6656;
constexpr int C_XIN = 0, C_BG = 512, C_CG = 1024, C_Q = 1536, C_K = 2048, C_V = 2560, C_G = 3584, C_GC = 4608, C_GR = 5632;
constexpr int RH = 8, RDK = 64, RDV = 128, RCH = 128;
constexpr int MEML = 256, XH = 4, XHD = 256;
constexpr int NE = 32, EH = 512;
constexpr int XS_ROWS = 40960;
constexpr float EPS = 1e-6f;
constexpr float QSCALE = 0.0625f * 1.4426950408889634f;

constexpr size_t MiB = 1u << 20;
constexpr size_t WS_CTL = 0;
constexpr size_t WS_ROPE = 1 * MiB;
constexpr size_t WS_WCAT = 2 * MiB;
constexpr size_t WS_WMIX = 5 * MiB;
constexpr size_t WS_WQ = 7 * MiB;
constexpr size_t WS_WKV = 9 * MiB;
constexpr size_t WS_WO = 13 * MiB;
constexpr size_t WS_WRT = 15 * MiB;
constexpr size_t WS_SSQ1 = 16 * MiB;
constexpr size_t WS_SSQ2 = 17 * MiB;
constexpr size_t WS_RS2 = 18 * MiB;
constexpr size_t WS_LID = 19 * MiB;
constexpr size_t WS_LW = 21 * MiB;
constexpr size_t WS_RID = 23 * MiB;
constexpr size_t WS_RW = WS_RID + 256 * 1024;
constexpr size_t WS_RRS = WS_RW + 256 * 1024;
constexpr size_t WS_MN = 24 * MiB;
constexpr size_t WS_KVM = 26 * MiB;
constexpr size_t WS_E = 30 * MiB;
constexpr size_t WS_WIN = 38 * MiB;
constexpr size_t WS_HID = 38 * MiB;
constexpr size_t WS_XN = 51 * MiB;
constexpr size_t WS_PROJ = 83 * MiB;
constexpr size_t WS_EGU = 83 * MiB;
constexpr size_t WS_ED = 147 * MiB;
constexpr size_t WS_XS = 179 * MiB;
constexpr size_t WS_HB = 259 * MiB;
constexpr size_t WS_END = 291 * MiB;
constexpr int CW_CNT = 64;

DEVI float bf2f(bf16 v) { return __uint_as_float((unsigned)v << 16); }
DEVI bf16 f2bf(float f) { unsigned u = __float_as_uint(f); return (bf16)((u + 0x7fffu + ((u >> 16) & 1u)) >> 16); }
DEVI float sigmoidf_(float x) { return 1.f / (1.f + __expf(-x)); }

__constant__ double c_invfreq[32] = {
    1.0, 0.7498942093324559, 0.5623413251903491, 0.4216965034285822, 0.31622776601683794, 0.23713737056616552,
    0.1778279410038923, 0.1333521432163324, 0.1, 0.07498942093324558, 0.05623413251903491, 0.04216965034285822,
    0.03162277660168379, 0.023713737056616554, 0.01778279410038923, 0.01333521432163324, 0.01, 0.007498942093324558,
    0.005623413251903491, 0.004216965034285823, 0.0031622776601683794, 0.0023713737056616554, 0.0017782794100389228,
    0.001333521432163324, 0.001, 0.0007498942093324559, 0.0005623413251903491, 0.0004216965034285823,
    0.00031622776601683794, 0.00023713737056616554, 0.00017782794100389227, 0.0001333521432163324};

__global__ void k_transpose(const float* __restrict__ W, int K, int N, bf16* WT, int ldwt, int koff, const float* __restrict__ kscale, int mode, size_t wstride, size_t wtstride) {
    W += (size_t)blockIdx.z * wstride; WT += (size_t)blockIdx.z * wtstride;
    const int n = blockIdx.x * 64 + (threadIdx.x & 63), k0 = blockIdx.y * 64 + (threadIdx.x >> 6) * 16;
    if (n >= N) return;
    int r = n;
    if (mode == 1) { if (n >= C_Q && n < C_V) { const int o = n & 63; r = (n & ~63) + 2 * (o & 31) + (o >> 5); } }
    else if (mode == 2) r = (n >> 7) * 256 + (n & 127);
    else if (mode == 3) r = (n >> 7) * 256 + 128 + (n & 127);
    for (int k = k0; k < k0 + 16 && k < K; ++k) {
        float v = W[(size_t)k * N + n]; if (kscale) v *= kscale[k];
        WT[(size_t)r * ldwt + koff + k] = f2bf(v);
    }
}
__global__ void k_zero_bf16(bf16* p, size_t n) { size_t i = (size_t)blockIdx.x * 256 + threadIdx.x; if (i < n) p[i] = 0; }

__global__ void k_rmsnorm_bf16(const float* __restrict__ x, const float* __restrict__ g, bf16* out) {
    const int row = blockIdx.x, t = threadIdx.x;
    const float4 v = ((const float4*)(x + (size_t)row * DM))[t];
    float s = v.x * v.x + v.y * v.y + v.z * v.z + v.w * v.w;
    __shared__ float red[4];
    for (int o = 32; o; o >>= 1) s += __shfl_xor(s, o);
    if ((t & 63) == 0) red[t >> 6] = s;
    __syncthreads();
    const float rstd = rsqrtf((red[0] + red[1] + red[2] + red[3]) * (1.f / DM) + EPS);
    const float4 gg = ((const float4*)g)[t];
    bf16* o = out + (size_t)row * DM + 4 * t;
    o[0] = f2bf(v.x * rstd * gg.x); o[1] = f2bf(v.y * rstd * gg.y); o[2] = f2bf(v.z * rstd * gg.z); o[3] = f2bf(v.w * rstd * gg.w);
}
__global__ void k_rope(float2* tab) {
    const int i = blockIdx.x * 256 + threadIdx.x; if (i >= SEQ * 32) return;
    const int pos = i >> 5, p = i & 31;
    const float ang = (float)pos * (float)c_invfreq[p];
    const double rev = (double)ang * 0.15915494309189535;
    const float fr = (float)(rev - floor(rev));
    tab[i] = make_float2(__builtin_amdgcn_cosf(fr), __builtin_amdgcn_sinf(fr));
}

template <class P> __global__ void __launch_bounds__(256) k_ngemm(P p) {
    __shared__ float As[16][65], Bs[16][65];
    const int mt = blockIdx.y; if (!p.valid(mt)) return;
    const int m0 = mt * 64, n0 = blockIdx.x * 64, tx = threadIdx.x & 15, ty = threadIdx.x >> 4;
    float a1[4][4] = {}, a2[4][4] = {};
    const int lr = threadIdx.x >> 2, lk = (threadIdx.x & 3) * 4;
    for (int seg = 0; seg < 2; ++seg) {
        const int Ks = seg ? p.K2 : p.K1; if (!Ks) continue;
        const bf16* ap = p.a_ptr(seg, m0 + lr); const bf16* bp = p.b_ptr(seg, mt, n0 + lr);
        for (int k0 = 0; k0 < Ks; k0 += 16) {
            const ushort4 av = *(const ushort4*)(ap + k0 + lk), bv = *(const ushort4*)(bp + k0 + lk);
            As[lk + 0][lr] = bf2f(av.x); As[lk + 1][lr] = bf2f(av.y); As[lk + 2][lr] = bf2f(av.z); As[lk + 3][lr] = bf2f(av.w);
            Bs[lk + 0][lr] = bf2f(bv.x); Bs[lk + 1][lr] = bf2f(bv.y); Bs[lk + 2][lr] = bf2f(bv.z); Bs[lk + 3][lr] = bf2f(bv.w);
            __syncthreads();
#pragma unroll
            for (int k = 0; k < 16; ++k) {
                float a[4], b[4];
#pragma unroll
                for (int i = 0; i < 4; ++i) { a[i] = As[k][ty * 4 + i]; b[i] = Bs[k][tx * 4 + i]; }
#pragma unroll
                for (int i = 0; i < 4; ++i)
#pragma unroll
                    for (int j = 0; j < 4; ++j) { if (seg) a2[i][j] += a[i] * b[j]; else a1[i][j] += a[i] * b[j]; }
            }
            __syncthreads();
        }
    }
#pragma unroll
    for (int i = 0; i < 4; ++i) p.epi(m0 + ty * 4 + i, n0 + tx * 4, a1[i], a2[i]);
}

struct P_inproj {
    int K1, K2; const bf16* xn; const bf16* win; bf16* proj; const float2* rope;
    DEVI const bf16* a_ptr(int, int m) const { return xn + (size_t)m * DM; }
    DEVI const bf16* b_ptr(int, int, int n) const { return win + (size_t)n * DM; }
    DEVI bool valid(int) const { return true; }
    DEVI void epi(int m, int n0, const float* a, const float*) const {
        float v[4] = {a[0], a[1], a[2], a[3]};
        if (n0 >= C_Q && n0 < C_V) {
            const int pos = m & (SEQ - 1), p0 = (n0 & 63) >> 1; const float sc = n0 >= C_K ? 0.125f : 1.f;
#pragma unroll
            for (int j = 0; j < 2; ++j) { const float2 cs = rope[pos * 32 + p0 + j]; const float t1 = v[2 * j], t2 = v[2 * j + 1];
                v[2 * j] = (t1 * cs.x - t2 * cs.y) * sc; v[2 * j + 1] = (t1 * cs.y + t2 * cs.x) * sc; }
        }
        bf16* o = proj + (size_t)m * PROJ_LD + n0;
#pragma unroll
        for (int j = 0; j < 4; ++j) o[j] = f2bf(v[j]);
    }
};
struct P_plain {
    int K1, K2; const bf16* A; const bf16* Bt; bf16* C; int lda, ldb, ldc, pad;
    DEVI const bf16* a_ptr(int, int m) const { return A + (size_t)m * lda; }
    DEVI const bf16* b_ptr(int, int, int n) const { return Bt + (size_t)n * ldb; }
    DEVI bool valid(int) const { return true; }
    DEVI void epi(int m, int n0, const float* a, const float*) const { bf16* o = C + (size_t)m * ldc + n0;
#pragma unroll
        for (int j = 0; j < 4; ++j) o[j] = f2bf(a[j]); }
};
__global__ void k_conv(bf16* proj, const float* __restrict__ cw) {
    const int c = threadIdx.x + (blockIdx.x & 1) * 256, t0 = (blockIdx.x >> 1) * 16, tb = t0 & ~(SEQ - 1);
    const float w0 = cw[c], w1 = cw[512 + c], w2 = cw[1024 + c];
    float u1 = 0.f, u2 = 0.f;
    for (int t = t0 - 2; t < t0 + 16; ++t) {
        float u = 0.f;
        if (t >= tb) { const bf16* r = proj + (size_t)t * PROJ_LD; u = bf2f(r[C_CG + c]) * bf2f(r[C_XIN + c]); }
        if (t >= t0) { bf16* r = proj + (size_t)t * PROJ_LD; r[C_BG + c] = f2bf(bf2f(r[C_BG + c]) * (w0 * u2 + w1 * u1 + w2 * u)); }
        u2 = u1; u1 = u;
    }
}
__global__ void __launch_bounds__(256) k_ret_scan(const bf16* __restrict__ proj, float* OT) {
    const int b = blockIdx.x >> 3, h = blockIdx.x & 7, tid = threadIdx.x, dv = tid & 127, dh = tid >> 7;
    const float gamma = 1.f - exp2f(-5.f - (float)h);
    float st[32];
#pragma unroll
    for (int i = 0; i < 32; ++i) st[i] = 0.f;
    __shared__ float qs[64], ks[64], part[128];
    for (int t = 0; t < SEQ; ++t) {
        const bf16* r = proj + (size_t)(b * SEQ + t) * PROJ_LD;
        if (tid < 64) qs[tid] = bf2f(r[C_Q + h * 64 + tid]); else if (tid < 128) ks[tid - 64] = bf2f(r[C_K + h * 64 + tid - 64]);
        const float v = bf2f(r[C_V + h * 128 + dv]);
        __syncthreads();
        float o = 0.f;
#pragma unroll
        for (int i = 0; i < 32; ++i) { st[i] = gamma * st[i] + ks[dh * 32 + i] * v; o += qs[dh * 32 + i] * st[i]; }
        if (dh) part[dv] = o;
        __syncthreads();
        if (!dh) OT[(size_t)(b * SEQ + t) * DM + h * 128 + dv] = o + part[dv];
    }
}
__global__ void k_ret_gn(bf16* proj, const float* __restrict__ OT) {
    const int row = blockIdx.x, tid = threadIdx.x;
    const float4 v = ((const float4*)(OT + (size_t)row * DM))[tid];
    float s = v.x + v.y + v.z + v.w;
    for (int o = 16; o; o >>= 1) s += __shfl_xor(s, o);
    const float mu = s * (1.f / 128.f);
    const float d0 = v.x - mu, d1 = v.y - mu, d2 = v.z - mu, d3 = v.w - mu;
    float q = d0 * d0 + d1 * d1 + d2 * d2 + d3 * d3;
    for (int o = 16; o; o >>= 1) q += __shfl_xor(q, o);
    const float rs = rsqrtf(q * (1.f / 128.f) + EPS);
    bf16* g = proj + (size_t)row * PROJ_LD + C_G + 4 * tid;
    const float dd[4] = {d0, d1, d2, d3};
#pragma unroll
    for (int j = 0; j < 4; ++j) { const float gv = bf2f(g[j]); g[j] = f2bf(gv * sigmoidf_(gv) * dd[j] * rs); }
}
struct P_merge {
    int K1, K2; const bf16* proj; const bf16* wcat; bf16* mrg;
    DEVI const bf16* a_ptr(int seg, int m) const { return proj + (size_t)m * PROJ_LD + (seg ? C_G : C_BG); }
    DEVI const bf16* b_ptr(int seg, int, int n) const { return wcat + (size_t)n * 1536 + (seg ? 512 : 0); }
    DEVI bool valid(int) const { return true; }
    DEVI void epi(int m, int n0, const float* a1, const float* a2) const {
        const bf16* r = proj + (size_t)m * PROJ_LD; bf16* o = mrg + (size_t)m * DM + n0;
#pragma unroll
        for (int j = 0; j < 4; ++j) o[j] = f2bf(sigmoidf_(bf2f(r[C_GC + n0 + j])) * a1[j] + sigmoidf_(bf2f(r[C_GR + n0 + j])) * a2[j]);
    }
};
struct P_resid {
    int K1, K2; const bf16* A; const bf16* Bt; const float* base; float* H; bf16* HB;
    DEVI const bf16* a_ptr(int, int m) const { return A + (size_t)m * DM; }
    DEVI const bf16* b_ptr(int, int, int n) const { return Bt + (size_t)n * DM; }
    DEVI bool valid(int) const { return true; }
    DEVI void epi(int m, int n0, const float* a, const float*) const {
        const size_t off = (size_t)m * DM + n0;
#pragma unroll
        for (int j = 0; j < 4; ++j) { const float v = base[off + j] + a[j]; H[off + j] = v; HB[off + j] = f2bf(v); }
    }
};
__global__ void k_rowssq(const float* __restrict__ H, float* ssq) {
    const int row = blockIdx.x, t = threadIdx.x;
    const float4 v = ((const float4*)(H + (size_t)row * DM))[t];
    float s = v.x * v.x + v.y * v.y + v.z * v.z + v.w * v.w;
    __shared__ float red[4];
    for (int o = 32; o; o >>= 1) s += __shfl_xor(s, o);
    if ((t & 63) == 0) red[t >> 6] = s;
    __syncthreads();
    if (t < 16) ssq[(size_t)row * 16 + t] = t ? 0.f : red[0] + red[1] + red[2] + red[3];
}
DEVI float rstd_from_ssq(const float* ssq, int row) {
    const float4* p = (const float4*)(ssq + (size_t)row * 16); float s = 0.f;
#pragma unroll
    for (int i = 0; i < 4; ++i) { const float4 v = p[i]; s += (v.x + v.y) + (v.z + v.w); }
    return rsqrtf(s * (1.f / DM) + EPS);
}
struct P_q {
    int K1, K2; const bf16* A; const bf16* Bt; const float* ssq; bf16* Q;
    DEVI const bf16* a_ptr(int, int m) const { return A + (size_t)m * DM; }
    DEVI const bf16* b_ptr(int, int, int n) const { return Bt + (size_t)n * DM; }
    DEVI bool valid(int) const { return true; }
    DEVI void epi(int m, int n0, const float* a, const float*) const { const float s = rstd_from_ssq(ssq, m) * QSCALE; bf16* o = Q + (size_t)m * DM + n0;
#pragma unroll
        for (int j = 0; j < 4; ++j) o[j] = f2bf(a[j] * s); }
};
__global__ void __launch_bounds__(256) k_xattn(bf16* Q, const bf16* __restrict__ kvm) {
    const int tok = blockIdx.x >> 2, h = blockIdx.x & 3, b = tok >> 12, j = threadIdx.x;
    __shared__ float qs[256], ps[256], red[8];
    bf16* qrow = Q + (size_t)tok * DM + h * XHD;
    qs[j] = bf2f(qrow[j]);
    __syncthreads();
    const bf16* kr = kvm + (size_t)(b * MEML + j) * 2048 + h * XHD;
    float s = 0.f;
    for (int d = 0; d < XHD; d += 4) { const ushort4 kv = *(const ushort4*)(kr + d); s += qs[d] * bf2f(kv.x) + qs[d + 1] * bf2f(kv.y) + qs[d + 2] * bf2f(kv.z) + qs[d + 3] * bf2f(kv.w); }
    float mx = s;
    for (int o = 32; o; o >>= 1) mx = fmaxf(mx, __shfl_xor(mx, o));
    if ((j & 63) == 0) red[j >> 6] = mx;
    __syncthreads();
    mx = fmaxf(fmaxf(red[0], red[1]), fmaxf(red[2], red[3]));
    const float p = exp2f(s - mx);
    ps[j] = p;
    float sm = p;
    for (int o = 32; o; o >>= 1) sm += __shfl_xor(sm, o);
    if ((j & 63) == 0) red[4 + (j >> 6)] = sm;
    __syncthreads();
    sm = red[4] + red[5] + red[6] + red[7];
    float o = 0.f;
    const bf16* vb = kvm + (size_t)(b * MEML) * 2048 + 1024 + h * XHD + j;
    for (int m = 0; m < MEML; ++m) o += ps[m] * bf2f(vb[(size_t)m * 2048]);
    qrow[j] = f2bf(o / sm);
}
DEVI float dot1024(const bf16* a, const bf16* w) {
    float s = 0.f;
    for (int k = 0; k < DM; k += 4) { const ushort4 av = *(const ushort4*)(a + k), wv = *(const ushort4*)(w + k); s += bf2f(av.x) * bf2f(wv.x) + bf2f(av.y) * bf2f(wv.y) + bf2f(av.z) * bf2f(wv.z) + bf2f(av.w) * bf2f(wv.w); }
    return s;
}
__global__ void k_route(const bf16* __restrict__ HB, const bf16* __restrict__ wrt, const float* __restrict__ ssq, const float* __restrict__ bg, const float* __restrict__ br,
                        float* rs2, unsigned* cnt, int* lid, float* lw) {
    const int tok = blockIdx.x * 64 + threadIdx.x;
    const float rs = rstd_from_ssq(ssq, tok); rs2[tok] = rs;
    const bf16* a = HB + (size_t)tok * DM;
    int gi = 0; float gm = -3.0e38f, gs = 0.f;
    {   float l4[4];
#pragma unroll
        for (int n = 0; n < 4; ++n) l4[n] = dot1024(a, wrt + (size_t)n * DM) * rs + bg[n];
#pragma unroll
        for (int n = 0; n < 4; ++n) if (l4[n] > gm) { gm = l4[n]; gi = n; }
#pragma unroll
        for (int n = 0; n < 4; ++n) gs += __expf(l4[n] - gm);
    }
    const float pg = 1.f / gs;
    float le[8];
#pragma unroll
    for (int n = 0; n < 8; ++n) le[n] = dot1024(a, wrt + (size_t)(4 + gi * 8 + n) * DM) * rs + br[gi * 8 + n];
    int e1 = 0; float m1 = -3.0e38f;
#pragma unroll
    for (int n = 0; n < 8; ++n) if (le[n] > m1) { m1 = le[n]; e1 = n; }
    int e2 = 0; float m2 = -3.0e38f;
#pragma unroll
    for (int n = 0; n < 8; ++n) if (n != e1 && le[n] > m2) { m2 = le[n]; e2 = n; }
    const float x2 = __expf(m2 - m1), w1 = pg / (1.f + x2), w2 = pg * x2 / (1.f + x2);
    const int E1 = gi * 8 + e1, E2 = gi * 8 + e2;
    const unsigned p1 = atomicAdd(&cnt[E1], 1u), p2 = atomicAdd(&cnt[E2], 1u);
    lid[E1 * 16384 + p1] = tok * 2; lw[E1 * 16384 + p1] = w1;
    lid[E2 * 16384 + p2] = tok * 2 + 1; lw[E2 * 16384 + p2] = w2;
}
DEVI int tile_expert(const unsigned* cnt, int tile, int& first_tile) {
    int ts = 0;
    for (int e = 0; e < NE; ++e) { const int nt = ((int)cnt[e] + 255) >> 8; if (tile < ts + nt) { first_tile = ts; return e; } ts += nt; }
    first_tile = ts; return -1;
}
__global__ void k_gather(const bf16* __restrict__ HB, const unsigned* __restrict__ cnt, const int* __restrict__ lid, const float* __restrict__ lw, const float* __restrict__ rs2,
                         bf16* XS, int* rid, float* rw, float* rrs) {
    const int row = blockIdx.x; int ft; const int e = tile_expert(cnt, row >> 8, ft);
    if (e < 0) return;
    const int pos = row - ft * 256; const bool real = pos < (int)cnt[e];
    const int id = real ? lid[e * 16384 + pos] : -1; const int tok = real ? (id >> 1) : 0;
    if (threadIdx.x == 0) { rid[row] = id; rw[row] = real ? lw[e * 16384 + pos] : 0.f; rrs[row] = rs2[tok]; }
    ((uint2*)(XS + (size_t)row * DM))[threadIdx.x] = ((const uint2*)(HB + (size_t)tok * DM))[threadIdx.x];
}
struct P_gu {
    int K1, K2; const bf16* XS; const bf16* egu; const unsigned* cnt; const float* rrs; bf16* HID;
    DEVI const bf16* a_ptr(int, int m) const { return XS + (size_t)m * DM; }
    DEVI const bf16* b_ptr(int seg, int mt, int n) const { int ft; const int e = tile_expert(cnt, mt >> 2, ft); return egu + ((size_t)e * 1024 + (n >> 7) * 256 + seg * 128 + (n & 127)) * DM; }
    DEVI bool valid(int mt) const { int ft; return tile_expert(cnt, mt >> 2, ft) >= 0; }
    DEVI void epi(int m, int n0, const float* a1, const float* a2) const { const float rs = rrs[m]; bf16* o = HID + (size_t)m * EH + n0;
#pragma unroll
        for (int j = 0; j < 4; ++j) { const float g = a1[j] * rs, u = a2[j] * rs; o[j] = f2bf(g * sigmoidf_(g) * u); } }
};
struct P_down {
    int K1, K2; const bf16* HID; const bf16* ed; const unsigned* cnt; const int* rid; const float* rw; bf16* YB;
    DEVI const bf16* a_ptr(int, int m) const { return HID + (size_t)m * EH; }
    DEVI const bf16* b_ptr(int, int mt, int n) const { int ft; const int e = tile_expert(cnt, mt >> 2, ft); return ed + ((size_t)e * 1024 + n) * EH; }
    DEVI bool valid(int mt) const { int ft; return tile_expert(cnt, mt >> 2, ft) >= 0; }
    DEVI void epi(int m, int n0, const float* a, const float*) const { const int id = rid[m]; if (id < 0) return; const float w = rw[m]; bf16* o = YB + (size_t)id * DM + n0;
#pragma unroll
        for (int j = 0; j < 4; ++j) o[j] = f2bf(a[j] * w); }
};
__global__ void k_final(float* H, const bf16* __restrict__ YB, const float* __restrict__ g) {
    const int row = blockIdx.x, t = threadIdx.x;
    float4 v = ((const float4*)(H + (size_t)row * DM))[t];
    const ushort4 y0 = ((const ushort4*)(YB + (size_t)(2 * row) * DM))[t], y1 = ((const ushort4*)(YB + (size_t)(2 * row + 1) * DM))[t];
    v.x += bf2f(y0.x) + bf2f(y1.x); v.y += bf2f(y0.y) + bf2f(y1.y); v.z += bf2f(y0.z) + bf2f(y1.z); v.w += bf2f(y0.w) + bf2f(y1.w);
    float s = v.x * v.x + v.y * v.y + v.z * v.z + v.w * v.w;
    __shared__ float red[4];
    for (int o = 32; o; o >>= 1) s += __shfl_xor(s, o);
    if ((t & 63) == 0) red[t >> 6] = s;
    __syncthreads();
    const float rstd = rsqrtf((red[0] + red[1] + red[2] + red[3]) * (1.f / DM) + EPS);
    const float4 gg = ((const float4*)g)[t];
    ((float4*)(H + (size_t)row * DM))[t] = make_float4(v.x * rstd * gg.x, v.y * rstd * gg.y, v.z * rstd * gg.z, v.w * rstd * gg.w);
}


#define LAS __attribute__((address_space(3)))
#define GAS __attribute__((address_space(1)))
typedef short bf16x8 __attribute__((ext_vector_type(8)));
typedef float f32x4 __attribute__((ext_vector_type(4)));
typedef float f32x2 __attribute__((ext_vector_type(2)));
typedef unsigned u32x4 __attribute__((ext_vector_type(4)));
typedef unsigned u32x2 __attribute__((ext_vector_type(2)));
typedef GAS unsigned gu32;
#define RLX_AGENT __ATOMIC_RELAXED, __HIP_MEMORY_SCOPE_AGENT
#define LDS_WAIT() asm volatile("s_waitcnt lgkmcnt(0)" ::: "memory")
#define VM_WAIT() asm volatile("s_waitcnt vmcnt(0)" ::: "memory")
constexpr int NWAVES = 8, NTHR = 512;
constexpr int RING_BYTES = 131072, LDSCTL_OFF = RING_BYTES, MISC_OFF = LDSCTL_OFF + 320, LDS_BYTES = 147456;
constexpr int CW_BAR = 4096;

#define XB_TMO      128
#define XB_XCNT(j)  (256  + 64 * (j))
#define XB_XSUB(j)  (1280 + 64 * (j))
#define XB_XGEN(j)  (2304 + 64 * (j))
#define XB_TOP      3328
#define XB_TOPGEN   3392
#define XCD_BAR_WORDS 3456
#define XB_SPIN_CAP (1u << 18)

__device__ __forceinline__ unsigned xb_ld(unsigned* p)              { return __hip_atomic_load(p, __ATOMIC_RELAXED, __HIP_MEMORY_SCOPE_AGENT); }
__device__ __forceinline__ unsigned xb_add(unsigned* p, unsigned v) { return __hip_atomic_fetch_add(p, v, __ATOMIC_RELAXED, __HIP_MEMORY_SCOPE_AGENT); }
__device__ __forceinline__ unsigned xb_xcc_id() { return (unsigned)__builtin_amdgcn_s_getreg((3 << 11) | 20) & 0xFu; }
#define XB_SPIN(cond, bar) do { unsigned _sp = 0; while (cond) { __builtin_amdgcn_s_sleep(1); \
    if ((++_sp & 255u) == 0u) { if (xb_ld(&(bar)[XB_TMO])) break; if (_sp > XB_SPIN_CAP) { atomicAdd(&(bar)[XB_TMO], 1u); break; } } } } while (0)

struct XcdBarrier {
    unsigned* bar; unsigned x;
    volatile LAS unsigned* st;
};

__device__ __forceinline__ XcdBarrier xcd_barrier_post(unsigned* bar, volatile LAS unsigned* st) {
    XcdBarrier b; b.bar = bar; b.x = xb_xcc_id(); b.st = st;
    if (threadIdx.x == 0) (void)xb_add(&bar[XB_XCNT(b.x)], 1u);
    return b;
}
__device__ __forceinline__ void xcd_barrier_complete(unsigned* bar, unsigned x, unsigned& nloc, unsigned& nx) {
    const unsigned G = gridDim.x * gridDim.y * gridDim.z;
    unsigned sum, cnt, mine, sp = 0u;
    for (;;) {
        sum = 0u; cnt = 0u; mine = 0u;
#pragma unroll
        for (unsigned j = 0; j < 16; ++j) { const unsigned c = xb_ld(&bar[XB_XCNT(j)]); sum += c; cnt += (c > 0u) ? 1u : 0u; mine = (j == x) ? c : mine; }
        if (sum == G) break;
        __builtin_amdgcn_s_sleep(1);
        if ((++sp & 255u) == 0u) { if (xb_ld(&bar[XB_TMO])) break; if (sp > XB_SPIN_CAP) { atomicAdd(&bar[XB_TMO], 1u); break; } }
    }
    nloc = mine > 0u ? mine : 1u; nx = cnt > 0u ? cnt : 1u;
}

__device__ __forceinline__ void xcd_barrier(const XcdBarrier& b) {
    asm volatile("s_waitcnt vmcnt(0)" ::: "memory");
    __syncthreads();
    if (threadIdx.x == 0) {
        unsigned* bar = b.bar;
        __builtin_amdgcn_s_waitcnt(0);
        unsigned nloc = b.st[0], nx = b.st[1];
        if (nloc == 0u) { xcd_barrier_complete(bar, b.x, nloc, nx); b.st[0] = nloc; b.st[1] = nx; }
        const unsigned old = xb_add(&bar[XB_XSUB(b.x)], 1u);
        const unsigned gen = old / nloc;
        if (old + 1u == (gen + 1u) * nloc) {
            __builtin_amdgcn_fence(__ATOMIC_RELEASE, "agent");
            asm volatile("s_waitcnt vmcnt(0)" ::: "memory");
            const unsigned og = xb_add(&bar[XB_TOP], 1u);
            const unsigned tg = og / nx;
            if (og + 1u == (tg + 1u) * nx) xb_add(&bar[XB_TOPGEN], 1u);
            else XB_SPIN(xb_ld(&bar[XB_TOPGEN]) == tg, bar);
            __builtin_amdgcn_fence(__ATOMIC_ACQUIRE, "agent");
            xb_add(&bar[XB_XGEN(b.x)], 1u);
            asm volatile("s_waitcnt vmcnt(0)" ::: "memory");
        } else {
            XB_SPIN(xb_ld(&bar[XB_XGEN(b.x)]) == gen, bar);
            __builtin_amdgcn_fence(__ATOMIC_ACQUIRE, "agent");
            asm volatile("s_waitcnt vmcnt(0)" ::: "memory");
        }
    }
    __syncthreads();
}


constexpr int BM = 256, BK = 64, HALF = 128, HTB = HALF * BK * 2, NXCD = 8, WGM = 8;
DEVI int lds_byte(int r, int c) { const int st = (r >> 4) * 2 + (c >> 5), rr = r & 15, cc = c & 31, ob = rr * 64 + cc * 2; return st * 1024 + (ob ^ (((ob >> 9) & 1) << 5)); }
DEVI void stage_rc(int b, int& R, int& C) { const int st = b / 1024, sb = b % 1024, swz = sb ^ (((sb >> 9) & 1) << 5); R = (st >> 1) * 16 + swz / 64; C = (st & 1) * 32 + (swz % 64) / 2; }
DEVI int perm32(int rho) { const int n = rho >> 4, i = rho & 15; return 8 * (i >> 2) + 4 * n + (i & 3); }
DEVI unsigned cvt_pk_bf16(float lo, float hi) { unsigned r; asm volatile("v_cvt_pk_bf16_f32 %0, %1, %2" : "=v"(r) : "v"(lo), "v"(hi)); return r; }
DEVI u32x4 pack8(const f32x4 a, const f32x4 b) { u32x4 w; w.x = cvt_pk_bf16(a[0], a[1]); w.y = cvt_pk_bf16(a[2], a[3]); w.z = cvt_pk_bf16(b[0], b[1]); w.w = cvt_pk_bf16(b[2], b[3]); return w; }
DEVI float bflo(unsigned w) { return __uint_as_float(w << 16); }
DEVI float bfhi(unsigned w) { return __uint_as_float(w & 0xffff0000u); }

struct Unit { int pm, pn, e; };
DEVI bool tile_order(int L, int nM, int nN, int& pm, int& pn) {
    const int nwg = nM * nN; if (L >= nwg) return false;
    int wgid = L; { const int q = nwg / NXCD, r = nwg % NXCD, xcd = wgid % NXCD, off = wgid / NXCD; wgid = (xcd < r ? xcd * (q + 1) : r * (q + 1) + (xcd - r) * q) + off; }
    const int nig = WGM * nN, gid = wgid / nig, fm = gid * WGM, gsz = (nM - fm) < WGM ? (nM - fm) : WGM;
    pm = fm + ((wgid % nig) % gsz); pn = (wgid % nig) / gsz; return true;
}

template <class Epi, class Sched, int JT>
DEVI void gemm_phase(LAS unsigned char* lds, const Sched& S, const Epi& E, const int lda, const int ldb, const int nt, const int jumpA) {
    const int tid = threadIdx.x, wid = __builtin_amdgcn_readfirstlane(tid >> 6), lane = tid & 63, wr = wid >> 2, wc = wid & 3, fr = lane & 15, fq = lane >> 4;
    unsigned voffA[2], voffB[2];
#pragma unroll
    for (int i = 0; i < 2; ++i) { int R, C; stage_rc(tid * 16 + i * 8192, R, C); const int Rb = (R & ~31) + perm32(R & 31);
        voffA[i] = (unsigned)(R * lda + C) * 2u; voffB[i] = (unsigned)(Rb * ldb + C) * 2u; }
    const size_t kstep = (size_t)(BK * 2);
    const size_t hstepA = (size_t)HALF * lda * 2, hstepB = (size_t)HALF * ldb * 2;
    const unsigned ldsw = (unsigned)wid * 1024u;
    const int aoff = lds_byte(wr * 64 + fr, fq * 8), boff = lds_byte(wc * 32 + fr, fq * 8);
#define PG8_SA(b, h) (((b) * 2 + (h)) * HTB)
#define PG8_SB(b, h) ((4 + (b) * 2 + (h)) * HTB)
#define PG8_STAGE(bufoff, gbase, voff) do { _Pragma("unroll") for (int _i = 0; _i < 2; ++_i) \
        __builtin_amdgcn_global_load_lds((const unsigned*)((const char*)(gbase) + (voff)[_i]), (LAS unsigned*)(lds + (bufoff) + ldsw + _i * 8192), 16, 0, 0); } while (0)
#define PG8_LDA(dst, b, h) do { _Pragma("unroll") for (int m = 0; m < 4; ++m) _Pragma("unroll") for (int k = 0; k < 2; ++k) dst[m][k] = *(const LAS bf16x8*)(lds + PG8_SA(b, h) + aoff + m * 2048 + k * 1024); } while (0)
#define PG8_LDB(dst, b, h) do { _Pragma("unroll") for (int n = 0; n < 2; ++n) _Pragma("unroll") for (int k = 0; k < 2; ++k) dst[n][k] = *(const LAS bf16x8*)(lds + PG8_SB(b, h) + boff + n * 2048 + k * 1024); } while (0)
#define PG8_MMA(ai, bj, At, Bt) do { __builtin_amdgcn_s_setprio(1); _Pragma("unroll") for (int m = 0; m < 4; ++m) _Pragma("unroll") for (int n = 0; n < 2; ++n) _Pragma("unroll") for (int k = 0; k < 2; ++k) \
        acc[ai][bj][m][n] = __builtin_amdgcn_mfma_f32_16x16x32_bf16(Bt[n][k], At[m][k], acc[ai][bj][m][n], 0, 0, 0); __builtin_amdgcn_s_setprio(0); } while (0)
#define PG8_WAIT_V(n) asm volatile("s_waitcnt vmcnt(" #n ")" ::: "memory")
#define PG8_WAIT_L(n) asm volatile("s_waitcnt lgkmcnt(" #n ")" ::: "memory")
#define PG8_BAR __builtin_amdgcn_s_barrier()
#define PG8_SCHED __builtin_amdgcn_sched_barrier(0)
#define PG8_AK(t) ((size_t)(t) * kstep + ((JT > 0 && (t) >= JT) ? (size_t)jumpA : (size_t)0))
#define PG8_KBODY(t) do { \
            const bool last = (t == nt - 2); \
            const char* a1 = cA + PG8_AK(t + 1); \
            const char* a2 = last ? nA : cA + PG8_AK(t + 2); const char* b2 = last ? nB : cB + (size_t)(t + 2) * kstep; \
            const char* a3 = last ? nA + kstep : cA + PG8_AK(t + 3); const char* b3 = b2 + kstep; \
            PG8_LDB(B0, 0, 0); PG8_LDB(B1, 0, 1); PG8_SCHED; PG8_LDA(At, 0, 0); PG8_STAGE(PG8_SA(1, 1), a1 + hstepA, voffA); \
            PG8_WAIT_V(8); PG8_WAIT_L(0); PG8_BAR; PG8_MMA(0, 0, At, B0); PG8_MMA(0, 1, At, B1); PG8_BAR; PG8_SCHED; \
            PG8_LDA(At, 0, 1); PG8_STAGE(PG8_SB(0, 0), b2, voffB); PG8_STAGE(PG8_SB(0, 1), b2 + hstepB, voffB); PG8_STAGE(PG8_SA(0, 0), a2, voffA); \
            PG8_WAIT_V(8); PG8_WAIT_L(0); PG8_BAR; PG8_MMA(1, 0, At, B0); PG8_MMA(1, 1, At, B1); PG8_BAR; PG8_SCHED; \
            PG8_LDB(B0, 1, 0); PG8_LDB(B1, 1, 1); PG8_SCHED; PG8_LDA(At, 1, 0); PG8_STAGE(PG8_SA(0, 1), a2 + hstepA, voffA); \
            PG8_WAIT_V(8); PG8_WAIT_L(0); PG8_BAR; PG8_MMA(0, 0, At, B0); PG8_MMA(0, 1, At, B1); PG8_BAR; PG8_SCHED; \
            PG8_LDA(At, 1, 1); PG8_STAGE(PG8_SB(1, 0), b3, voffB); PG8_STAGE(PG8_SB(1, 1), b3 + hstepB, voffB); PG8_STAGE(PG8_SA(1, 0), a3, voffA); \
            PG8_WAIT_V(8); PG8_WAIT_L(0); PG8_BAR; PG8_MMA(1, 0, At, B0); PG8_MMA(1, 1, At, B1); PG8_BAR; PG8_SCHED; \
        } while (0)
    Unit cur, nxt; int ui = 0;
    if (!S.next(0, cur)) return;
    f32x4 acc[2][2][4][2];
#pragma unroll
    for (int a = 0; a < 2; ++a)
#pragma unroll
        for (int b = 0; b < 2; ++b)
#pragma unroll
            for (int m = 0; m < 4; ++m)
#pragma unroll
                for (int n = 0; n < 2; ++n) acc[a][b][m][n] = (f32x4){0.f, 0.f, 0.f, 0.f};
    bf16x8 At[4][2], B0[2][2], B1[2][2];
    const char* cA = S.abase(cur); const char* cB = S.bbase(cur);
    PG8_STAGE(PG8_SB(0, 0), cB, voffB); PG8_STAGE(PG8_SB(0, 1), cB + hstepB, voffB); PG8_STAGE(PG8_SA(0, 0), cA, voffA); PG8_STAGE(PG8_SA(0, 1), cA + hstepA, voffA);
    if (wr == 1) PG8_BAR;
    PG8_WAIT_V(2); PG8_BAR;
    PG8_STAGE(PG8_SB(1, 0), cB + kstep, voffB); PG8_STAGE(PG8_SA(1, 0), cA + kstep, voffA); PG8_STAGE(PG8_SB(1, 1), cB + hstepB + kstep, voffB);
    PG8_WAIT_V(6); PG8_BAR;
    for (;;) {
        const bool has_next = S.next(ui + 1, nxt);
        const char* nA = has_next ? S.abase(nxt) : cA; const char* nB = has_next ? S.bbase(nxt) : cB;
        if constexpr (JT > 0) {
            for (int t = 0; t < JT; t += 2) PG8_KBODY(t);
            E.mid(acc, cur, wr, wc, fr, fq);
            for (int t = JT; t < nt; t += 2) PG8_KBODY(t);
        } else {
            for (int t = 0; t < nt; t += 2) PG8_KBODY(t);
        }
        if (wr == 0) PG8_BAR;
        E(acc, cur, wr, wc, fr, fq);
        if (!has_next) break;
#pragma unroll
        for (int a = 0; a < 2; ++a)
#pragma unroll
            for (int b = 0; b < 2; ++b)
#pragma unroll
                for (int m = 0; m < 4; ++m)
#pragma unroll
                    for (int n = 0; n < 2; ++n) acc[a][b][m][n] = (f32x4){0.f, 0.f, 0.f, 0.f};
        cur = nxt; cA = nA; cB = nB; ++ui;
        if (wr == 1) PG8_BAR;
    }
    PG8_WAIT_V(0);
    PG8_BAR;
#undef PG8_SA
#undef PG8_SB
#undef PG8_STAGE
#undef PG8_LDA
#undef PG8_LDB
#undef PG8_MMA
#undef PG8_WAIT_V
#undef PG8_WAIT_L
#undef PG8_BAR
#undef PG8_SCHED
#undef PG8_AK
#undef PG8_KBODY
}

struct SchedInproj {
    int G, c; const char *xn, *mn, *win, *wkv;
    DEVI bool next(int i, Unit& u) const {
        const int L = i * G + c;
        if (L < 64 * 26) { u.e = 0; return tile_order(L, 64, 26, u.pm, u.pn); }
        const int r = L - 64 * 26; if (r >= 32) return false;
        u.e = 1; u.pm = r & 3; u.pn = r >> 2; return true;
    }
    DEVI const char* abase(const Unit& u) const { return (u.e ? mn : xn) + (size_t)u.pm * (256 * DM * 2); }
    DEVI const char* bbase(const Unit& u) const { return (u.e ? wkv : win) + (size_t)u.pn * (256 * DM * 2); }
};
struct SchedSimple {
    int G, c; const char *A, *B; int lda, ldb;
    DEVI bool next(int i, Unit& u) const { u.e = 0; return tile_order(i * G + c, 64, 4, u.pm, u.pn); }
    DEVI const char* abase(const Unit& u) const { return A + (size_t)u.pm * 256 * lda * 2; }
    DEVI const char* bbase(const Unit& u) const { return B + (size_t)u.pn * 256 * ldb * 2; }
};
struct SchedMoe {
    int G, c, ntile; const unsigned* cnt; const char *A, *B; int lda, ldb;
    DEVI bool next(int i, Unit& u) const { if (!tile_order(i * G + c, ntile, 4, u.pm, u.pn)) return false; int ft; u.e = tile_expert(cnt, u.pm, ft); return true; }
    DEVI const char* abase(const Unit& u) const { return A + (size_t)u.pm * 256 * lda * 2; }
    DEVI const char* bbase(const Unit& u) const { return B + ((size_t)u.e * 1024 + u.pn * 256) * ldb * 2; }
};
DEVI int moe_ntiles(const unsigned* cnt) { int ts = 0; for (int e = 0; e < NE; ++e) ts += ((int)cnt[e] + 255) >> 8; return ts; }

typedef f32x4 Acc[2][2][4][2];
#define EPI_FENCE() asm volatile("" ::: "memory")
#define ROT2(V, I, C, J) do { const float t1_ = V[I], t2_ = V[I + 1]; V[I] = (t1_ * C[J] - t2_ * C[J + 1]) * sc; V[I + 1] = (t1_ * C[J + 1] + t2_ * C[J]) * sc; } while (0)
DEVI unsigned launder(unsigned x) { asm volatile("" : "+v"(x)); return x; }
#define ROWOFF(ai, m, ld, esz) ((unsigned)(((ai) * 128 + (m) * 16) * (ld) * (esz)))
struct EpiProj {
    bf16* proj; bf16* kvm; const float2* rope;
    DEVI void mid(Acc&, const Unit&, int, int, int, int) const {}
    DEVI void operator()(const Acc& acc, const Unit& u, int wr, int wc, int fr, int fq) const {
        const int row0 = u.pm * 256 + wr * 64 + fr, cl = wc * 32 + 8 * fq;
        if (u.e) {
            const unsigned lo = launder((unsigned)(row0 * 2048 + u.pn * 256 + cl) * 2u); char* base = (char*)kvm;
#pragma unroll
            for (int ai = 0; ai < 2; ++ai)
#pragma unroll
                for (int m = 0; m < 4; ++m) {
#pragma unroll
                    for (int bj = 0; bj < 2; ++bj) *(u32x4*)(base + lo + ROWOFF(ai, m, 2048, 2) + bj * 256) = pack8(acc[ai][bj][m][0], acc[ai][bj][m][1]); }
        } else {
            const bool rot = (u.pn >= 6) && (u.pn < 10); const float sc = (u.pn >= 8) ? 0.125f : 1.f;
            const unsigned lo = launder((unsigned)(row0 * PROJ_LD + u.pn * 256 + cl) * 2u); char* base = (char*)proj;
            const unsigned ro = launder((unsigned)((row0 & (SEQ - 1)) * 32 + ((cl & 63) >> 1)) * 8u); const char* rbase = (const char*)rope;
#pragma unroll
            for (int ai = 0; ai < 2; ++ai)
#pragma unroll
                for (int m = 0; m < 4; ++m) {
                    f32x4 c01 = (f32x4){1.f, 0.f, 1.f, 0.f}, c23 = c01;
                    if (rot) { const f32x4* tp = (const f32x4*)(rbase + ro + ROWOFF(ai, m, 32, 8)); c01 = tp[0]; c23 = tp[1]; }
#pragma unroll
                    for (int bj = 0; bj < 2; ++bj) { f32x4 v0 = acc[ai][bj][m][0], v1 = acc[ai][bj][m][1];
                        if (rot) { ROT2(v0, 0, c01, 0); ROT2(v0, 2, c01, 2); ROT2(v1, 0, c23, 0); ROT2(v1, 2, c23, 2); }
                        *(u32x4*)(base + lo + ROWOFF(ai, m, PROJ_LD, 2) + bj * 256) = pack8(v0, v1); }
                    if (m & 1) EPI_FENCE(); }
        }
    }
};
DEVI float gate_ratio(float gr, float gc) { return (1.f + __expf(-gr)) * __builtin_amdgcn_rcpf(1.f + __expf(-gc)); }
struct EpiMerge {
    const bf16* proj; bf16* mrg;
    DEVI void mid(Acc& acc, const Unit& u, int wr, int wc, int fr, int fq) const {
        const int row0 = u.pm * 256 + wr * 64 + fr, cl = wc * 32 + 8 * fq;
        const unsigned lo = launder((unsigned)(row0 * PROJ_LD + u.pn * 256 + cl) * 2u); const char* base = (const char*)proj;
#pragma unroll
        for (int ai = 0; ai < 2; ++ai)
#pragma unroll
            for (int m = 0; m < 4; ++m) { const char* rp = base + lo + ROWOFF(ai, m, PROJ_LD, 2);
#pragma unroll
                for (int bj = 0; bj < 2; ++bj) { const u32x4 gc = *(const u32x4*)(rp + C_GC * 2 + bj * 256), gr = *(const u32x4*)(rp + C_GR * 2 + bj * 256);
#pragma unroll
                    for (int q = 0; q < 2; ++q) { acc[ai][bj][m][0][2 * q] *= gate_ratio(bflo(gr[q]), bflo(gc[q])); acc[ai][bj][m][0][2 * q + 1] *= gate_ratio(bfhi(gr[q]), bfhi(gc[q]));
                        acc[ai][bj][m][1][2 * q] *= gate_ratio(bflo(gr[2 + q]), bflo(gc[2 + q])); acc[ai][bj][m][1][2 * q + 1] *= gate_ratio(bfhi(gr[2 + q]), bfhi(gc[2 + q])); } }
                EPI_FENCE(); }
    }
    DEVI void operator()(const Acc& acc, const Unit& u, int wr, int wc, int fr, int fq) const {
        const int row0 = u.pm * 256 + wr * 64 + fr, cl = wc * 32 + 8 * fq;
        const unsigned lo = launder((unsigned)(row0 * PROJ_LD + u.pn * 256 + cl) * 2u); const char* base = (const char*)proj;
        const unsigned oo = launder((unsigned)(row0 * DM + u.pn * 256 + cl) * 2u); char* ob = (char*)mrg;
#pragma unroll
        for (int ai = 0; ai < 2; ++ai)
#pragma unroll
            for (int m = 0; m < 4; ++m) { const char* rp = base + lo + ROWOFF(ai, m, PROJ_LD, 2); char* op = ob + oo + ROWOFF(ai, m, DM, 2);
#pragma unroll
                for (int bj = 0; bj < 2; ++bj) { const u32x4 gr = *(const u32x4*)(rp + C_GR * 2 + bj * 256); f32x4 v0 = acc[ai][bj][m][0], v1 = acc[ai][bj][m][1];
#pragma unroll
                    for (int q = 0; q < 2; ++q) { v0[2 * q] *= sigmoidf_(bflo(gr[q])); v0[2 * q + 1] *= sigmoidf_(bfhi(gr[q])); v1[2 * q] *= sigmoidf_(bflo(gr[2 + q])); v1[2 * q + 1] *= sigmoidf_(bfhi(gr[2 + q])); }
                    *(u32x4*)(op + bj * 256) = pack8(v0, v1); }
                EPI_FENCE(); }
    }
};
struct EpiResid {
    const float* base; float* H; bf16* HB; float* ssq;
    DEVI void mid(Acc&, const Unit&, int, int, int, int) const {}
    DEVI void operator()(const Acc& acc, const Unit& u, int wr, int wc, int fr, int fq) const {
        const int row0 = u.pm * 256 + wr * 64 + fr, cl = wc * 32 + 8 * fq;
        const unsigned eo = launder((unsigned)(row0 * DM + u.pn * 256 + cl)); const unsigned so = launder((unsigned)(row0 * 16 + u.pn * 4 + wc) * 4u);
        const char* bb = (const char*)base; char* hb_ = (char*)H; char* hbb = (char*)HB; char* sb = (char*)ssq;
#pragma unroll
        for (int ai = 0; ai < 2; ++ai)
#pragma unroll
            for (int m = 0; m < 4; ++m) { const unsigned o4 = eo * 4u + ROWOFF(ai, m, DM, 4), o2 = eo * 2u + ROWOFF(ai, m, DM, 2); float ss = 0.f;
#pragma unroll
                for (int bj = 0; bj < 2; ++bj) { const f32x4 v0 = *(const f32x4*)(bb + o4 + bj * 512) + acc[ai][bj][m][0], v1 = *(const f32x4*)(bb + o4 + bj * 512 + 16) + acc[ai][bj][m][1];
                    *(f32x4*)(hb_ + o4 + bj * 512) = v0; *(f32x4*)(hb_ + o4 + bj * 512 + 16) = v1; *(u32x4*)(hbb + o2 + bj * 256) = pack8(v0, v1);
                    ss += (v0[0] * v0[0] + v0[1] * v0[1]) + (v0[2] * v0[2] + v0[3] * v0[3]) + (v1[0] * v1[0] + v1[1] * v1[1]) + (v1[2] * v1[2] + v1[3] * v1[3]); }
                ss += __shfl_xor(ss, 16); ss += __shfl_xor(ss, 32);
                if (fq == 0) *(float*)(sb + so + ROWOFF(ai, m, 16, 4)) = ss;
                EPI_FENCE(); }
    }
};
struct EpiQ {
    const float* ssq; bf16* Q;
    DEVI void mid(Acc&, const Unit&, int, int, int, int) const {}
    DEVI void operator()(const Acc& acc, const Unit& u, int wr, int wc, int fr, int fq) const {
        const int row0 = u.pm * 256 + wr * 64 + fr, cl = wc * 32 + 8 * fq;
        const unsigned oo = launder((unsigned)(row0 * DM + u.pn * 256 + cl) * 2u); const unsigned so = launder((unsigned)(row0 * 16) * 4u); char* ob = (char*)Q; const char* sb = (const char*)ssq;
#pragma unroll
        for (int ai = 0; ai < 2; ++ai)
#pragma unroll
            for (int m = 0; m < 4; ++m) { const f32x4* p = (const f32x4*)(sb + so + ROWOFF(ai, m, 16, 4)); float t = 0.f;
#pragma unroll
                for (int i = 0; i < 4; ++i) { const f32x4 v = p[i]; t += (v[0] + v[1]) + (v[2] + v[3]); }
                const float s = rsqrtf(t * (1.f / DM) + EPS) * QSCALE; char* op = ob + oo + ROWOFF(ai, m, DM, 2);
#pragma unroll
                for (int bj = 0; bj < 2; ++bj) *(u32x4*)(op + bj * 256) = pack8(acc[ai][bj][m][0] * s, acc[ai][bj][m][1] * s);
                if (m & 1) EPI_FENCE(); }
    }
};
struct EpiGU {
    const float* rrs; bf16* HID;
    DEVI void mid(Acc&, const Unit&, int, int, int, int) const {}
    DEVI void operator()(const Acc& acc, const Unit& u, int wr, int wc, int fr, int fq) const {
        const int row0 = u.pm * 256 + wr * 64 + fr, cl = wc * 32 + 8 * fq;
        const unsigned oo = launder((unsigned)(row0 * EH + u.pn * 128 + cl) * 2u); const unsigned so = launder((unsigned)row0 * 4u); char* ob = (char*)HID; const char* sb = (const char*)rrs;
#pragma unroll
        for (int ai = 0; ai < 2; ++ai)
#pragma unroll
            for (int m = 0; m < 4; ++m) { const float rs = *(const float*)(sb + so + ROWOFF(ai, m, 1, 4)); f32x4 h[2];
#pragma unroll
                for (int n = 0; n < 2; ++n)
#pragma unroll
                    for (int q = 0; q < 4; ++q) { const float g = acc[ai][0][m][n][q] * rs, up = acc[ai][1][m][n][q] * rs; h[n][q] = g * sigmoidf_(g) * up; }
                *(u32x4*)(ob + oo + ROWOFF(ai, m, EH, 2)) = pack8(h[0], h[1]);
                if (m & 1) EPI_FENCE(); }
    }
};
struct EpiDown {
    const int* rid; const float* rw; bf16* YB;
    DEVI void mid(Acc&, const Unit&, int, int, int, int) const {}
    DEVI void operator()(const Acc& acc, const Unit& u, int wr, int wc, int fr, int fq) const {
        const int row0 = u.pm * 256 + wr * 64 + fr, cl = wc * 32 + 8 * fq;
        const unsigned so = launder((unsigned)row0 * 4u); const unsigned co = launder((unsigned)(u.pn * 256 + cl) * 2u); const char* ib = (const char*)rid; const char* wb = (const char*)rw; char* ob = (char*)YB;
#pragma unroll
        for (int ai = 0; ai < 2; ++ai)
#pragma unroll
            for (int m = 0; m < 4; ++m) { const int id = *(const int*)(ib + so + ROWOFF(ai, m, 1, 4)); const float w = *(const float*)(wb + so + ROWOFF(ai, m, 1, 4));
                if (id >= 0) { char* op = ob + (size_t)id * (DM * 2) + co;
#pragma unroll
                    for (int bj = 0; bj < 2; ++bj) *(u32x4*)(op + bj * 256) = pack8(acc[ai][bj][m][0] * w, acc[ai][bj][m][1] * w); }
                if (m & 1) EPI_FENCE(); }
    }
};

struct Args { const float* in[22]; float* out; unsigned char* ws; int ph_lo, ph_hi; };
struct Frame {
    LAS unsigned char* lds; int tid, lane, wave, vcu, G;
    DEVI int gw() const { return vcu * NWAVES + wave; }
    DEVI int ngw() const { return G * NWAVES; }
};
DEVI float wave_sum(float v) {
#pragma unroll
    for (int o = 1; o < 64; o <<= 1) v += __shfl_xor(v, o);
    return v;
}
DEVI unsigned pk2(float lo, float hi) { return (unsigned)f2bf(lo) | ((unsigned)f2bf(hi) << 16); }
DEVI int wt_rowmap(int n, int mode) {
    if (mode == 1) { if (n >= C_Q && n < C_V) { const int o = n & 63; return (n & ~63) + 2 * (o & 31) + (o >> 5); } return n; }
    if (mode == 2) return (n >> 7) * 256 + (n & 127);
    if (mode == 3) return (n >> 7) * 256 + 128 + (n & 127);
    return n;
}
DEVI void transpose_item(const float* W, int K, int N, bf16* WT, int ldwt, int koff, const float* kscale, int mode, LAS float* scr, int item, int lane) {
    const int nblk = N / 32, kb = item / nblk, nb = item % nblk, k0 = 64 * kb, n0 = 32 * nb;
#pragma unroll 8
    for (int i = 0; i < 32; ++i) { const int kk = 2 * i + (lane >> 5); float v = W[(size_t)(k0 + kk) * N + n0 + (lane & 31)]; if (kscale) v *= kscale[k0 + kk]; scr[kk * 33 + (lane & 31)] = v; }
    LDS_WAIT(); asm volatile("" ::: "memory");
    const int c = lane & 7;
#pragma unroll
    for (int j = 0; j < 4; ++j) { const int n = (lane >> 3) + 8 * j; const LAS float* s = scr + (8 * c) * 33 + n;
        u32x4 o; o.x = pk2(s[0 * 33], s[1 * 33]); o.y = pk2(s[2 * 33], s[3 * 33]); o.z = pk2(s[4 * 33], s[5 * 33]); o.w = pk2(s[6 * 33], s[7 * 33]);
        *(u32x4*)(WT + (size_t)wt_rowmap(n0 + n, mode) * ldwt + koff + k0 + 8 * c) = o; }
    LDS_WAIT(); asm volatile("" ::: "memory");
}
DEVI void rms_row_to_bf16(const float* xrow, const float* g, bf16* orow, int lane) {
    const f32x4* xr = (const f32x4*)xrow + lane; const f32x4* gr = (const f32x4*)g + lane;
    f32x4 v[4]; float s = 0.f;
#pragma unroll
    for (int j = 0; j < 4; ++j) { v[j] = xr[64 * j]; s += (v[j].x * v[j].x + v[j].y * v[j].y) + (v[j].z * v[j].z + v[j].w * v[j].w); }
    const float rstd = rsqrtf(wave_sum(s) * (1.f / DM) + EPS);
    unsigned long long* o8 = (unsigned long long*)orow + lane;
#pragma unroll
    for (int j = 0; j < 4; ++j) { const f32x4 gg = gr[64 * j]; o8[64 * j] = (unsigned long long)pk2(v[j].x * rstd * gg.x, v[j].y * rstd * gg.y) | ((unsigned long long)pk2(v[j].z * rstd * gg.z, v[j].w * rstd * gg.w) << 32); }
}

DEVI void p0_prologue(Frame& F, const Args& a, unsigned char* ws) {
    LAS float* scr = (LAS float*)(F.lds + F.wave * 16384);
    const int gw = F.gw(), NGW = F.ngw();
    const float* w_in = a.in[3]; const float* w_conv_out = a.in[5]; const float* w_ret_out = a.in[6]; const float* w_mix_out = a.in[7];
    const float* xa_g = a.in[8]; const float* w_xa_q = a.in[10]; const float* w_xa_kv = a.in[11]; const float* w_xa_o = a.in[12]; const float* moe_g = a.in[13];
    bf16 *win = (bf16*)(ws + WS_WIN), *wcat = (bf16*)(ws + WS_WCAT), *wmix = (bf16*)(ws + WS_WMIX), *wq = (bf16*)(ws + WS_WQ), *wkv = (bf16*)(ws + WS_WKV), *wo = (bf16*)(ws + WS_WO), *wrt = (bf16*)(ws + WS_WRT);
    constexpr int I_IN = 16 * 208, I_C = 8 * 32, I_S = 16 * 32, I_KV = 16 * 64;
    constexpr int NITEMS = I_IN + I_C + 4 * I_S + I_KV;
    for (int it = gw; it < NITEMS; it += NGW) {
        int r = it;
        if (r < I_IN) { transpose_item(w_in, DM, PROJ_LD, win, DM, 0, nullptr, 1, scr, r, F.lane); continue; } r -= I_IN;
        if (r < I_C) { transpose_item(w_conv_out, 512, DM, wcat, 1536, 0, nullptr, 0, scr, r, F.lane); continue; } r -= I_C;
        if (r < I_S) { transpose_item(w_ret_out, DM, DM, wcat, 1536, 512, nullptr, 0, scr, r, F.lane); continue; } r -= I_S;
        if (r < I_S) { transpose_item(w_mix_out, DM, DM, wmix, DM, 0, nullptr, 0, scr, r, F.lane); continue; } r -= I_S;
        if (r < I_S) { transpose_item(w_xa_q, DM, DM, wq, DM, 0, xa_g, 0, scr, r, F.lane); continue; } r -= I_S;
        if (r < I_S) { transpose_item(w_xa_o, DM, DM, wo, DM, 0, nullptr, 0, scr, r, F.lane); continue; } r -= I_S;
        transpose_item(w_xa_kv, DM, 2048, wkv, DM, 0, nullptr, 0, scr, r, F.lane);
    }
    const int gt = F.vcu * NTHR + F.tid, NGT = F.G * NTHR;
    {   const float* w_group = a.in[14]; const float* w_router = a.in[16];
        for (int i = gt; i < 48 * DM; i += NGT) { const int n = i >> 10, k = i & 1023; float v = 0.f;
            if (n < 4) v = w_group[k * 4 + n] * moe_g[k]; else if (n < 36) v = w_router[k * 32 + (n - 4)] * moe_g[k];
            wrt[i] = f2bf(v); } }
    {   float2* rope = (float2*)(ws + WS_ROPE);
        for (int i = gt; i < SEQ * 32; i += NGT) { const int pos = i >> 5, p = i & 31;
            const float ang = (float)pos * (float)c_invfreq[p]; const double rev = (double)ang * 0.15915494309189535; const float fr = (float)(rev - floor(rev));
            rope[i] = make_float2(__builtin_amdgcn_cosf(fr), __builtin_amdgcn_sinf(fr)); } }
    const float* x = a.in[0]; const float* mem = a.in[1]; bf16* xn = (bf16*)(ws + WS_XN); bf16* mn = (bf16*)(ws + WS_MN);
    for (int m = gw; m < T; m += NGW) rms_row_to_bf16(x + (size_t)m * DM, a.in[2], xn + (size_t)m * DM, F.lane);
    for (int m = gw; m < NB * MEML; m += NGW) rms_row_to_bf16(mem + (size_t)m * DM, a.in[9], mn + (size_t)m * DM, F.lane);
}
DEVI void p9_route(Frame& F, const Args& a, unsigned char* ws) {
    const bf16* HB = (const bf16*)(ws + WS_HB); const bf16* wrt = (const bf16*)(ws + WS_WRT); const float* ssq = (const float*)(ws + WS_SSQ2);
    const float* bg = a.in[15]; const float* br = a.in[17]; float* rs2 = (float*)(ws + WS_RS2); unsigned* cnt = (unsigned*)(ws + WS_CTL) + CW_CNT; int* lid = (int*)(ws + WS_LID); float* lw = (float*)(ws + WS_LW);
    const int gw = F.gw(), NGW = F.ngw(), lane = F.lane, fr = lane & 15, fq = lane >> 4;
    {
        LAS float* scr = (LAS float*)(F.lds + F.wave * 16384);
        const float* w_gate = a.in[18]; const float* w_up = a.in[19]; const float* w_down = a.in[20]; const float* moe_g = a.in[13];
        bf16* egu = (bf16*)(ws + WS_EGU); bf16* ed = (bf16*)(ws + WS_ED);
        for (int it = gw; it < 3 * NE * 256; it += NGW) { const int ty = it / (NE * 256), r = it % (NE * 256), e = r >> 8, li = r & 255;
            if (ty == 0) transpose_item(w_gate + (size_t)e * DM * EH, DM, EH, egu + (size_t)e * 1024 * DM, DM, 0, moe_g, 2, scr, li, lane);
            else if (ty == 1) transpose_item(w_up + (size_t)e * DM * EH, DM, EH, egu + (size_t)e * 1024 * DM, DM, 0, moe_g, 3, scr, li, lane);
            else transpose_item(w_down + (size_t)e * EH * DM, EH, DM, ed + (size_t)e * 1024 * EH, EH, 0, nullptr, 0, scr, li, lane); }
    }
    LAS float* lg = (LAS float*)(F.lds + F.wave * 16384);
    for (int task = gw; task < T / 16; task += NGW) {
        const int tok0 = task * 16;
        f32x4 acc[3]; acc[0] = acc[1] = acc[2] = (f32x4){0.f, 0.f, 0.f, 0.f};
        const bf16* ap = HB + (size_t)(tok0 + fr) * DM + 8 * fq; const bf16* bp = wrt + (size_t)fr * DM + 8 * fq;
#pragma unroll 4
        for (int ks = 0; ks < 32; ++ks) { const bf16x8 av = *(const bf16x8*)(ap + 32 * ks);
#pragma unroll
            for (int nb = 0; nb < 3; ++nb) { const bf16x8 bv = *(const bf16x8*)(bp + (size_t)nb * 16 * DM + 32 * ks); acc[nb] = __builtin_amdgcn_mfma_f32_16x16x32_bf16(av, bv, acc[nb], 0, 0, 0); } }
#pragma unroll
        for (int nb = 0; nb < 3; ++nb)
#pragma unroll
            for (int r = 0; r < 4; ++r) lg[(4 * fq + r) * 49 + 16 * nb + fr] = acc[nb][r];
        LDS_WAIT(); asm volatile("" ::: "memory");
        if (lane < 16) {
            const int tok = tok0 + lane; const float rs = rstd_from_ssq(ssq, tok); rs2[tok] = rs; const LAS float* l = lg + lane * 49;
            int gi = 0; float gm = -3.0e38f, gs = 0.f; float l4[4];
#pragma unroll
            for (int n = 0; n < 4; ++n) l4[n] = l[n] * rs + bg[n];
#pragma unroll
            for (int n = 0; n < 4; ++n) if (l4[n] > gm) { gm = l4[n]; gi = n; }
#pragma unroll
            for (int n = 0; n < 4; ++n) gs += __expf(l4[n] - gm);
            const float pg = 1.f / gs; float le[8];
#pragma unroll
            for (int n = 0; n < 8; ++n) le[n] = l[4 + gi * 8 + n] * rs + br[gi * 8 + n];
            int e1 = 0; float m1 = -3.0e38f;
#pragma unroll
            for (int n = 0; n < 8; ++n) if (le[n] > m1) { m1 = le[n]; e1 = n; }
            int e2 = 0; float m2 = -3.0e38f;
#pragma unroll
            for (int n = 0; n < 8; ++n) if (n != e1 && le[n] > m2) { m2 = le[n]; e2 = n; }
            const float x2 = __expf(m2 - m1), w1 = pg / (1.f + x2), w2 = pg * x2 / (1.f + x2);
            const int E1 = gi * 8 + e1, E2 = gi * 8 + e2;
            const unsigned p1 = atomicAdd(&cnt[E1], 1u), p2 = atomicAdd(&cnt[E2], 1u);
            lid[E1 * 16384 + p1] = tok * 2; lw[E1 * 16384 + p1] = w1;
            lid[E2 * 16384 + p2] = tok * 2 + 1; lw[E2 * 16384 + p2] = w2;
        }
        LDS_WAIT(); asm volatile("" ::: "memory");
    }
}
DEVI void p10_gather(Frame& F, unsigned char* ws) {
    const bf16* HB = (const bf16*)(ws + WS_HB); const unsigned* cnt = (const unsigned*)(ws + WS_CTL) + CW_CNT; const int* lid = (const int*)(ws + WS_LID); const float* lw = (const float*)(ws + WS_LW);
    const float* rs2 = (const float*)(ws + WS_RS2); bf16* XS = (bf16*)(ws + WS_XS); int* rid = (int*)(ws + WS_RID); float* rw = (float*)(ws + WS_RW); float* rrs = (float*)(ws + WS_RRS);
    const int rows = moe_ntiles(cnt) * 256;
    for (int row = F.gw(); row < rows; row += F.ngw()) {
        int ft; const int e = tile_expert(cnt, row >> 8, ft); const int pos = row - ft * 256; const bool real = pos < (int)cnt[e];
        const int id = real ? lid[e * 16384 + pos] : -1; const int tok = real ? (id >> 1) : 0;
        if (F.lane == 0) { rid[row] = id; rw[row] = real ? lw[e * 16384 + pos] : 0.f; rrs[row] = rs2[tok]; }
        const u32x4* s = (const u32x4*)(HB + (size_t)tok * DM); u32x4* d = (u32x4*)(XS + (size_t)row * DM);
        const u32x4 v0 = s[F.lane], v1 = s[F.lane + 64]; d[F.lane] = v0; d[F.lane + 64] = v1;
    }
}
DEVI void p13_final(Frame& F, const Args& a, unsigned char* ws) {
    float* H = a.out; const bf16* YB = (const bf16*)(ws + WS_XS); const f32x4* g4 = (const f32x4*)a.in[21];
    for (int row = F.gw(); row < T; row += F.ngw()) {
        f32x4* hr = (f32x4*)(H + (size_t)row * DM); const u32x2* y0 = (const u32x2*)(YB + (size_t)(2 * row) * DM); const u32x2* y1 = (const u32x2*)(YB + (size_t)(2 * row + 1) * DM);
        f32x4 v[4]; float s = 0.f;
#pragma unroll
        for (int j = 0; j < 4; ++j) { const int i = F.lane + 64 * j; v[j] = hr[i]; const u32x2 a0 = y0[i], a1 = y1[i];
            v[j].x += bflo(a0.x) + bflo(a1.x); v[j].y += bfhi(a0.x) + bfhi(a1.x); v[j].z += bflo(a0.y) + bflo(a1.y); v[j].w += bfhi(a0.y) + bfhi(a1.y);
            s += (v[j].x * v[j].x + v[j].y * v[j].y) + (v[j].z * v[j].z + v[j].w * v[j].w); }
        const float rstd = rsqrtf(wave_sum(s) * (1.f / DM) + EPS);
#pragma unroll
        for (int j = 0; j < 4; ++j) { const int i = F.lane + 64 * j; hr[i] = v[j] * rstd * g4[i]; }
    }
}


typedef short v4i16_t __attribute__((ext_vector_type(4)));
DEVI bf16x8 tr_frag(const LAS unsigned char* p0, const LAS unsigned char* p1) {
    const v4i16_t a = __builtin_amdgcn_ds_read_tr16_b64_v4i16((LAS v4i16_t*)p0), b = __builtin_amdgcn_ds_read_tr16_b64_v4i16((LAS v4i16_t*)p1);
    return (bf16x8){a[0], a[1], a[2], a[3], b[0], b[1], b[2], b[3]};
}
DEVI bf16x8 pack_frag(const f32x4 a, const f32x4 b) { const u32x4 w = pack8(a, b); return __builtin_bit_cast(bf16x8, w); }
#define MFMA16(a, b, c) __builtin_amdgcn_mfma_f32_16x16x32_bf16((a), (b), (c), 0, 0, 0)
constexpr int RT_QP = 160, RT_VP = 288, RT_SP = 144;
constexpr int RT_Q = 0, RT_K = 128 * RT_QP, RT_V = 2 * 128 * RT_QP, RT_S = RT_V + 128 * RT_VP, RT_END = RT_S + 128 * RT_SP;
static_assert(RT_END <= RING_BYTES, "retention LDS");
template <bool OUT> DEVI void ret_unit(Frame& F, int un, bf16* proj, float* Eg) {
    const int b = un >> 6, h = (un >> 3) & 7, grp = un & 7, lane = F.lane, w = F.wave, fr = lane & 15, fq = lane >> 4, tid = F.tid;
    const float lg2 = __log2f(1.f - exp2f(-5.f - (float)h)), cd = exp2f(128.f * lg2);
    LAS unsigned char* L = F.lds;
    f32x4 sb[4];
#pragma unroll
    for (int db = 0; db < 4; ++db) sb[db] = (f32x4){0.f, 0.f, 0.f, 0.f};
    if (OUT) {
        const float cd4 = cd * cd * cd * cd;
        for (int gp = 0; gp < grp; ++gp) { const float* e = Eg + (size_t)(un - grp + gp) * 8192 + 16 * w + fr;
#pragma unroll
            for (int db = 0; db < 4; ++db)
#pragma unroll
                for (int r = 0; r < 4; ++r) sb[db][r] = sb[db][r] * cd4 + e[(16 * db + 4 * fq + r) * 128]; }
    }
    const int q4 = (lane & 15) >> 2, p4 = lane & 3;
    for (int n = 0; n < 4; ++n) {
        const size_t t0 = (size_t)b * SEQ + (size_t)(grp * 4 + n) * 128;
#pragma unroll
        for (int i = 0; i < 2; ++i) { const int idx = tid + 512 * i, row = idx >> 3, c = idx & 7; const bf16* g = proj + (t0 + row) * PROJ_LD + h * 64 + c * 8;
            const u32x4 kv = *(const u32x4*)(g + C_K); const float z = exp2f((float)(127 - row) * lg2);
            u32x4 kw; kw.x = cvt_pk_bf16(bflo(kv.x) * z, bfhi(kv.x) * z); kw.y = cvt_pk_bf16(bflo(kv.y) * z, bfhi(kv.y) * z); kw.z = cvt_pk_bf16(bflo(kv.z) * z, bfhi(kv.z) * z); kw.w = cvt_pk_bf16(bflo(kv.w) * z, bfhi(kv.w) * z);
            *(LAS u32x4*)(L + RT_K + row * RT_QP + c * 16) = kw;
            if (OUT) *(LAS u32x4*)(L + RT_Q + row * RT_QP + c * 16) = *(const u32x4*)(g + C_Q); }
#pragma unroll
        for (int i = 0; i < 4; ++i) { const int idx = tid + 512 * i, row = idx >> 4, c = idx & 15;
            *(LAS u32x4*)(L + RT_V + row * RT_VP + c * 16) = *(const u32x4*)(proj + (t0 + row) * PROJ_LD + C_V + h * 128 + c * 8); }
#pragma unroll
        for (int db = 0; db < 4; ++db) { sb[db] = sb[db] * cd;
            if (OUT) { u32x2 wv; wv.x = cvt_pk_bf16(sb[db][0], sb[db][1]); wv.y = cvt_pk_bf16(sb[db][2], sb[db][3]); *(LAS u32x2*)(L + RT_S + (16 * w + fr) * RT_SP + (16 * db + 4 * fq) * 2) = wv; } }
        __syncthreads();
        if (OUT) {
            bf16x8 qf[2];
#pragma unroll
            for (int ks = 0; ks < 2; ++ks) qf[ks] = *(const LAS bf16x8*)(L + RT_Q + (16 * w + fr) * RT_QP + 64 * ks + 16 * fq);
            f32x4 o[8];
#pragma unroll
            for (int d = 0; d < 8; ++d) o[d] = (f32x4){0.f, 0.f, 0.f, 0.f};
#pragma unroll
            for (int ks = 0; ks < 2; ++ks)
#pragma unroll
                for (int d = 0; d < 8; ++d) { const bf16x8 sf = *(const LAS bf16x8*)(L + RT_S + (16 * d + fr) * RT_SP + 64 * ks + 16 * fq); o[d] = MFMA16(qf[ks], sf, o[d]); }
            for (int s = 0; 2 * s <= w; ++s) {
                f32x4 st[2];
#pragma unroll
                for (int hh = 0; hh < 2; ++hh) { const int kb = 2 * s + hh; st[hh] = (f32x4){0.f, 0.f, 0.f, 0.f};
                    if (kb <= w) {
#pragma unroll
                        for (int ks = 0; ks < 2; ++ks) { const bf16x8 kf = *(const LAS bf16x8*)(L + RT_K + (16 * kb + fr) * RT_QP + 64 * ks + 16 * fq); st[hh] = MFMA16(kf, qf[ks], st[hh]); }
                        if (kb == w) {
#pragma unroll
                            for (int r = 0; r < 4; ++r) if (4 * fq + r > fr) st[hh][r] = 0.f; }
                    } }
                const bf16x8 pa = pack_frag(st[0], st[1]);
                const LAS unsigned char* vb = L + RT_V + (32 * s + 4 * fq + q4) * RT_VP + 8 * p4;
#pragma unroll
                for (int d = 0; d < 8; ++d) { const bf16x8 vf = tr_frag(vb + 32 * d, vb + 16 * RT_VP + 32 * d); o[d] = MFMA16(pa, vf, o[d]); }
            }
#pragma unroll
            for (int r = 0; r < 4; ++r) { const int i = 16 * w + 4 * fq + r; const float rho = exp2f((float)(i - 127) * lg2); float s1 = 0.f;
#pragma unroll
                for (int d = 0; d < 8; ++d) { o[d][r] *= rho; s1 += o[d][r]; }
                s1 += __shfl_xor(s1, 1); s1 += __shfl_xor(s1, 2); s1 += __shfl_xor(s1, 4); s1 += __shfl_xor(s1, 8);
                const float mu = s1 * (1.f / 128.f); float s2 = 0.f;
#pragma unroll
                for (int d = 0; d < 8; ++d) { const float dd = o[d][r] - mu; s2 += dd * dd; }
                s2 += __shfl_xor(s2, 1); s2 += __shfl_xor(s2, 2); s2 += __shfl_xor(s2, 4); s2 += __shfl_xor(s2, 8);
                const float rs = rsqrtf(s2 * (1.f / 128.f) + EPS);
                bf16* gp = proj + (t0 + i) * PROJ_LD + C_G + h * 128 + fr;
#pragma unroll
                for (int d = 0; d < 8; ++d) { const float gv = bf2f(gp[16 * d]); gp[16 * d] = f2bf(gv * sigmoidf_(gv) * (o[d][r] - mu) * rs); } }
        }
        {   const LAS unsigned char* kb_ = L + RT_K + (4 * fq + q4) * RT_QP + 8 * p4; const LAS unsigned char* vb_ = L + RT_V + (4 * fq + q4) * RT_VP + 32 * w + 8 * p4;
#pragma unroll
            for (int ks = 0; ks < 4; ++ks) { const bf16x8 vf = tr_frag(vb_ + 32 * ks * RT_VP, vb_ + (32 * ks + 16) * RT_VP);
#pragma unroll
                for (int db = 0; db < 4; ++db) { const bf16x8 kf = tr_frag(kb_ + 32 * ks * RT_QP + 32 * db, kb_ + (32 * ks + 16) * RT_QP + 32 * db); sb[db] = MFMA16(kf, vf, sb[db]); } }
        }
        __syncthreads();
    }
    if (!OUT) { float* e = Eg + (size_t)un * 8192 + 16 * w + fr;
#pragma unroll
        for (int db = 0; db < 4; ++db)
#pragma unroll
            for (int r = 0; r < 4; ++r) e[(16 * db + 4 * fq + r) * 128] = sb[db][r]; }
}
DEVI void conv_rows(Frame& F, bf16* proj, const float* cw) {
    const int lane = F.lane; float w0[8], w1[8], w2[8];
#pragma unroll
    for (int j = 0; j < 8; ++j) { w0[j] = cw[8 * lane + j]; w1[j] = cw[512 + 8 * lane + j]; w2[j] = cw[1024 + 8 * lane + j]; }
    for (int blk = F.gw(); blk < T / 8; blk += F.ngw()) {
        const int t0 = blk * 8, tb = t0 & ~(SEQ - 1); float u1[8], u2[8];
#pragma unroll
        for (int j = 0; j < 8; ++j) { u1[j] = 0.f; u2[j] = 0.f; }
        for (int t = t0 - 2; t < t0 + 8; ++t) {
            float u[8];
#pragma unroll
            for (int j = 0; j < 8; ++j) u[j] = 0.f;
            if (t >= tb) { const bf16* r = proj + (size_t)t * PROJ_LD + 8 * lane; const u32x4 xv = *(const u32x4*)(r + C_XIN), cv = *(const u32x4*)(r + C_CG);
#pragma unroll
                for (int q = 0; q < 4; ++q) { u[2 * q] = bflo(xv[q]) * bflo(cv[q]); u[2 * q + 1] = bfhi(xv[q]) * bfhi(cv[q]); } }
            if (t >= t0) { bf16* r = proj + (size_t)t * PROJ_LD + C_BG + 8 * lane; const u32x4 bv = *(const u32x4*)r; u32x4 ov;
#pragma unroll
                for (int q = 0; q < 4; ++q) { const float a0 = bflo(bv[q]) * (w0[2 * q] * u2[2 * q] + w1[2 * q] * u1[2 * q] + w2[2 * q] * u[2 * q]);
                    const float a1 = bfhi(bv[q]) * (w0[2 * q + 1] * u2[2 * q + 1] + w1[2 * q + 1] * u1[2 * q + 1] + w2[2 * q + 1] * u[2 * q + 1]); ov[q] = cvt_pk_bf16(a0, a1); }
                *(u32x4*)r = ov; }
#pragma unroll
            for (int j = 0; j < 8; ++j) { u2[j] = u1[j]; u1[j] = u[j]; }
        }
    }
}
constexpr int XA_KP = 528, XA_VP = 544, XA_BUF = 64 * XA_VP;
static_assert(2 * XA_BUF <= RING_BYTES, "xattn LDS");
DEVI void xattn_unit(Frame& F, int un, bf16* Q, const bf16* kvm) {
    const int bh = un >> 5, rb = un & 31, b = bh >> 2, h = bh & 3, lane = F.lane, w = F.wave, fr = lane & 15, fq = lane >> 4, tid = F.tid, q4 = (lane & 15) >> 2, p4 = lane & 3;
    const size_t q0 = (size_t)b * SEQ + rb * 128 + 16 * w;
    LAS unsigned char* L = F.lds;
    const bf16* kbase = kvm + (size_t)(b * MEML) * 2048 + h * XHD;
    bf16x8 qf[8];
#pragma unroll
    for (int ks = 0; ks < 8; ++ks) qf[ks] = *(const bf16x8*)(Q + (q0 + fr) * DM + h * XHD + 32 * ks + 8 * fq);
    u32x4 sr[4];
#define XA_LOAD(sl) do { const bf16* src_ = kbase + ((sl) >= 4 ? 1024 : 0) + (size_t)(((sl) & 3) * 64) * 2048; \
        _Pragma("unroll") for (int i = 0; i < 4; ++i) { const int idx = tid + 512 * i, row = idx >> 5, c = idx & 31; sr[i] = *(const u32x4*)(src_ + (size_t)row * 2048 + c * 8); } } while (0)
#define XA_WRITE(sl) do { const int pitch_ = (sl) >= 4 ? XA_VP : XA_KP; LAS unsigned char* dst_ = L + ((sl) & 1) * XA_BUF; \
        _Pragma("unroll") for (int i = 0; i < 4; ++i) { const int idx = tid + 512 * i, row = idx >> 5, c = idx & 31; *(LAS u32x4*)(dst_ + row * pitch_ + c * 16) = sr[i]; } } while (0)
    XA_LOAD(0); XA_WRITE(0);
    __syncthreads();
    f32x4 st[16];
#pragma unroll
    for (int j = 0; j < 4; ++j) {
        XA_LOAD(j + 1);
        const LAS unsigned char* kb_ = L + (j & 1) * XA_BUF + fr * XA_KP + 16 * fq;
#pragma unroll
        for (int kk = 0; kk < 4; ++kk) { f32x4 a = (f32x4){0.f, 0.f, 0.f, 0.f};
#pragma unroll
            for (int ks = 0; ks < 8; ++ks) { const bf16x8 kf = *(const LAS bf16x8*)(kb_ + 16 * kk * XA_KP + 64 * ks); a = MFMA16(kf, qf[ks], a); }
            st[4 * j + kk] = a; }
        XA_WRITE(j + 1);
        __syncthreads();
    }
    float mx = -3.0e38f;
#pragma unroll
    for (int kb = 0; kb < 16; ++kb) mx = fmaxf(fmaxf(fmaxf(mx, st[kb][0]), fmaxf(st[kb][1], st[kb][2])), st[kb][3]);
    mx = fmaxf(mx, __shfl_xor(mx, 16)); mx = fmaxf(mx, __shfl_xor(mx, 32));
    float sm = 0.f;
#pragma unroll
    for (int kb = 0; kb < 16; ++kb)
#pragma unroll
        for (int r = 0; r < 4; ++r) { const float p = exp2f(st[kb][r] - mx); st[kb][r] = p; sm += p; }
    sm += __shfl_xor(sm, 16); sm += __shfl_xor(sm, 32);
    bf16x8 pa[8];
#pragma unroll
    for (int s = 0; s < 8; ++s) pa[s] = pack_frag(st[2 * s], st[2 * s + 1]);
    f32x4 o[16];
#pragma unroll
    for (int d = 0; d < 16; ++d) o[d] = (f32x4){0.f, 0.f, 0.f, 0.f};
#pragma unroll
    for (int j = 4; j < 8; ++j) {
        if (j < 7) XA_LOAD(j + 1);
        const LAS unsigned char* vb_ = L + (j & 1) * XA_BUF + (4 * fq + q4) * XA_VP + 8 * p4;
#pragma unroll
        for (int s2 = 0; s2 < 2; ++s2)
#pragma unroll
            for (int d = 0; d < 16; ++d) { const bf16x8 vf = tr_frag(vb_ + 32 * s2 * XA_VP + 32 * d, vb_ + (32 * s2 + 16) * XA_VP + 32 * d); o[d] = MFMA16(pa[2 * (j - 4) + s2], vf, o[d]); }
        if (j < 7) XA_WRITE(j + 1);
        __syncthreads();
    }
#undef XA_LOAD
#undef XA_WRITE
    const float inv = 1.f / sm;
#pragma unroll
    for (int r = 0; r < 4; ++r) { const float iv = __shfl(inv, 4 * fq + r); bf16* op = Q + (q0 + 4 * fq + r) * DM + h * XHD + fr;
#pragma unroll
        for (int d = 0; d < 16; ++d) op[16 * d] = f2bf(o[d][r] * iv); }
}

constexpr int NPH = 14;
struct ArgsK { Args a; int li, pad; };
__global__ void __launch_bounds__(NTHR, 2) mega(ArgsK ak) {
    extern __shared__ __attribute__((aligned(16))) unsigned char lds_raw[];
    const Args& args = ak.a;
    Frame F; F.lds = (LAS unsigned char*)lds_raw; F.tid = threadIdx.x; F.lane = F.tid & 63; F.wave = __builtin_amdgcn_readfirstlane(F.tid >> 6);
    F.G = gridDim.x; { const int bx = blockIdx.x; F.vcu = (F.G % 8 == 0) ? (bx % 8) * (F.G / 8) + bx / 8 : bx; }
    unsigned char* ws = args.ws; gu32* ctl = (gu32*)(ws + WS_CTL);
    for (int u = F.tid; u < (LDS_BYTES - LDSCTL_OFF) / 4; u += NTHR) ((LAS unsigned*)(F.lds + LDSCTL_OFF))[u] = 0u;
    __syncthreads();
    const int lo = args.ph_lo, hi = args.ph_hi;
    XcdBarrier bar; bar.bar = (unsigned*)(ctl + CW_BAR) + ak.li * XCD_BAR_WORDS; bar.x = 0; bar.st = nullptr;
    if (hi - lo > 1) bar = xcd_barrier_post((unsigned*)(ctl + CW_BAR) + ak.li * XCD_BAR_WORDS, (volatile LAS unsigned*)(F.lds + MISC_OFF) + 8);
#ifndef PH_MASK
#define PH_MASK 0x3fff
#endif
#define IN(k) (((PH_MASK >> (k)) & 1) && lo <= (k) && (k) < hi)
#define SEAM(k) do { if (IN(k) && IN((k) + 1)) xcd_barrier(bar); } while (0)
    const int bx = (int)blockIdx.x;
    bf16* proj = (bf16*)(ws + WS_PROJ); bf16* xn = (bf16*)(ws + WS_XN); bf16* hb = (bf16*)(ws + WS_HB); float* H = args.out;
    float* ssq1 = (float*)(ws + WS_SSQ1); float* ssq2 = (float*)(ws + WS_SSQ2); const unsigned* cnt = (const unsigned*)(ws + WS_CTL) + CW_CNT;

    if (IN(0)) { p0_prologue(F, args, ws); SEAM(0); }
    if (IN(1)) {
        SchedInproj S{F.G, bx, (const char*)xn, (const char*)(ws + WS_MN), (const char*)(ws + WS_WIN), (const char*)(ws + WS_WKV)};
        EpiProj E{proj, (bf16*)(ws + WS_KVM), (const float2*)(ws + WS_ROPE)};
        gemm_phase<EpiProj, SchedInproj, 0>(F.lds, S, E, DM, DM, DM / 64, 0);
        SEAM(1);
    }
    if (IN(2)) {
        conv_rows(F, proj, args.in[4]);
        for (int un = F.vcu; un < 256; un += F.G) ret_unit<false>(F, un, proj, (float*)(ws + WS_E));
        SEAM(2);
    }
    if (IN(3)) { for (int un = F.vcu; un < 256; un += F.G) ret_unit<true>(F, un, proj, (float*)(ws + WS_E)); SEAM(3); }
    if (IN(4)) {
        SchedSimple S{F.G, bx, (const char*)(proj + C_BG), (const char*)(ws + WS_WCAT), PROJ_LD, 1536};
        EpiMerge E{proj, xn};
        gemm_phase<EpiMerge, SchedSimple, 8>(F.lds, S, E, PROJ_LD, 1536, 24, (C_G - C_BG - 512) * 2);
        SEAM(4);
    }
    if (IN(5)) {
        SchedSimple S{F.G, bx, (const char*)xn, (const char*)(ws + WS_WMIX), DM, DM};
        EpiResid E{args.in[0], H, hb, ssq1};
        gemm_phase<EpiResid, SchedSimple, 0>(F.lds, S, E, DM, DM, DM / 64, 0);
        SEAM(5);
    }
    if (IN(6)) {
        SchedSimple S{F.G, bx, (const char*)hb, (const char*)(ws + WS_WQ), DM, DM};
        EpiQ E{ssq1, xn};
        gemm_phase<EpiQ, SchedSimple, 0>(F.lds, S, E, DM, DM, DM / 64, 0);
        SEAM(6);
    }
    if (IN(7)) { for (int un = F.vcu; un < 512; un += F.G) xattn_unit(F, un, xn, (const bf16*)(ws + WS_KVM)); SEAM(7); }
    if (IN(8)) {
        SchedSimple S{F.G, bx, (const char*)xn, (const char*)(ws + WS_WO), DM, DM};
        EpiResid E{H, H, hb, ssq2};
        gemm_phase<EpiResid, SchedSimple, 0>(F.lds, S, E, DM, DM, DM / 64, 0);
        SEAM(8);
    }
    if (IN(9)) { p9_route(F, args, ws); SEAM(9); }
    if (IN(10)) { p10_gather(F, ws); SEAM(10); }
    if (IN(11)) {
        SchedMoe S{F.G, bx, moe_ntiles(cnt), cnt, (const char*)(ws + WS_XS), (const char*)(ws + WS_EGU), DM, DM};
        EpiGU E{(const float*)(ws + WS_RRS), (bf16*)(ws + WS_HID)};
        gemm_phase<EpiGU, SchedMoe, 0>(F.lds, S, E, DM, DM, DM / 64, 0);
        SEAM(11);
    }
    if (IN(12)) {
        SchedMoe S{F.G, bx, moe_ntiles(cnt), cnt, (const char*)(ws + WS_HID), (const char*)(ws + WS_ED), EH, EH};
        EpiDown E{(const int*)(ws + WS_RID), (const float*)(ws + WS_RW), (bf16*)(ws + WS_XS)};
        gemm_phase<EpiDown, SchedMoe, 0>(F.lds, S, E, EH, EH, EH / 64, 0);
        SEAM(12);
    }
    if (IN(13)) { p13_final(F, args, ws); }
#undef IN
#undef SEAM
}

#define MEGA_FUSE 1
static const int USE_MEGA[NPH] = {1, 1, 1, 1, 1, 1, 1, 1, 1, 1, 1, 1, 1, 1};
extern "C" void kernel_launch(void* const* d_in, const int* in_sizes, int n_in, void* d_out, int out_size, void* d_ws, size_t ws_size, hipStream_t stream) {
    if (n_in != 22 || out_size != T * DM || ws_size < WS_END) { fprintf(stderr, "kernel_launch: unexpected shapes (n_in %d out %d ws %zu)\n", n_in, out_size, ws_size); return; }
    static int grid = 0;
    if (grid == 0) {
        int dev = 0, cus = 0;
        if (hipGetDevice(&dev) != hipSuccess || hipDeviceGetAttribute(&cus, hipDeviceAttributeMultiprocessorCount, dev) != hipSuccess) { grid = -1; return; }
        if (hipFuncSetAttribute((const void*)mega, hipFuncAttributeMaxDynamicSharedMemorySize, LDS_BYTES) != hipSuccess) { fprintf(stderr, "kernel_launch: hipFuncSetAttribute failed\n"); grid = -1; return; }
        grid = cus;
        if (grid != 256) fprintf(stderr, "kernel_launch: %d CUs (built for 256)\n", grid);
    }
    if (grid < 0) return;
    const float* x = (const float*)d_in[0]; const float* mem = (const float*)d_in[1]; const float* mix_g = (const float*)d_in[2]; const float* w_in = (const float*)d_in[3];
    const float* conv_w = (const float*)d_in[4]; const float* w_conv_out = (const float*)d_in[5]; const float* w_ret_out = (const float*)d_in[6]; const float* w_mix_out = (const float*)d_in[7];
    const float* xa_g = (const float*)d_in[8]; const float* mem_g = (const float*)d_in[9]; const float* w_xa_q = (const float*)d_in[10]; const float* w_xa_kv = (const float*)d_in[11];
    const float* w_xa_o = (const float*)d_in[12]; const float* moe_g = (const float*)d_in[13]; const float* w_group = (const float*)d_in[14]; const float* b_group = (const float*)d_in[15];
    const float* w_router = (const float*)d_in[16]; const float* b_router = (const float*)d_in[17]; const float* w_gate = (const float*)d_in[18]; const float* w_up = (const float*)d_in[19];
    const float* w_down = (const float*)d_in[20]; const float* final_g = (const float*)d_in[21];
    char* ws = (char*)d_ws; float* H = (float*)d_out;
    unsigned* ctl = (unsigned*)(ws + WS_CTL); float2* rope = (float2*)(ws + WS_ROPE);
    bf16 *wcat = (bf16*)(ws + WS_WCAT), *wmix = (bf16*)(ws + WS_WMIX), *wq = (bf16*)(ws + WS_WQ), *wkv = (bf16*)(ws + WS_WKV), *wo = (bf16*)(ws + WS_WO), *wrt = (bf16*)(ws + WS_WRT);
    float *ssq1 = (float*)(ws + WS_SSQ1), *ssq2 = (float*)(ws + WS_SSQ2), *rs2 = (float*)(ws + WS_RS2), *lw = (float*)(ws + WS_LW), *rw = (float*)(ws + WS_RW), *rrs = (float*)(ws + WS_RRS);
    int *lid = (int*)(ws + WS_LID), *rid = (int*)(ws + WS_RID);
    bf16 *mn = (bf16*)(ws + WS_MN), *kvm = (bf16*)(ws + WS_KVM), *win = (bf16*)(ws + WS_WIN), *hid = (bf16*)(ws + WS_HID), *xn = (bf16*)(ws + WS_XN), *proj = (bf16*)(ws + WS_PROJ);
    bf16 *egu = (bf16*)(ws + WS_EGU), *ed = (bf16*)(ws + WS_ED), *xs = (bf16*)(ws + WS_XS), *hb = (bf16*)(ws + WS_HB);
    unsigned* cnt = ctl + CW_CNT;
    (void)hipMemsetAsync(ws + WS_CTL, 0, 1 * MiB, stream);
    ArgsK ak{}; for (int i = 0; i < 22; ++i) ak.a.in[i] = (const float*)d_in[i]; ak.a.out = H; ak.a.ws = (unsigned char*)d_ws;
    int nli = 0;
    for (int p = 0; p < NPH; ) {
        if (USE_MEGA[p]) { int q = p; while (q < NPH && USE_MEGA[q]) ++q;
#if !defined(MEGA_FUSE)
            q = p + 1;
#endif
            ak.a.ph_lo = p; ak.a.ph_hi = q; ak.li = nli++; ak.pad = 0;
            hipLaunchKernelGGL(mega, dim3(grid), dim3(NTHR), LDS_BYTES, stream, ak);
            p = q; continue; }
        switch (p) {
        case 0:
            k_transpose<<<dim3(PROJ_LD / 64, 16, 1), 256, 0, stream>>>(w_in, DM, PROJ_LD, win, DM, 0, nullptr, 1, 0, 0);
            k_transpose<<<dim3(16, 8, 1), 256, 0, stream>>>(w_conv_out, 512, DM, wcat, 1536, 0, nullptr, 0, 0, 0);
            k_transpose<<<dim3(16, 16, 1), 256, 0, stream>>>(w_ret_out, DM, DM, wcat, 1536, 512, nullptr, 0, 0, 0);
            k_transpose<<<dim3(16, 16, 1), 256, 0, stream>>>(w_mix_out, DM, DM, wmix, DM, 0, nullptr, 0, 0, 0);
            k_transpose<<<dim3(16, 16, 1), 256, 0, stream>>>(w_xa_q, DM, DM, wq, DM, 0, xa_g, 0, 0, 0);
            k_transpose<<<dim3(32, 16, 1), 256, 0, stream>>>(w_xa_kv, DM, 2048, wkv, DM, 0, nullptr, 0, 0, 0);
            k_transpose<<<dim3(16, 16, 1), 256, 0, stream>>>(w_xa_o, DM, DM, wo, DM, 0, nullptr, 0, 0, 0);
            k_zero_bf16<<<(48 * DM + 255) / 256, 256, 0, stream>>>(wrt, 48 * DM);
            k_transpose<<<dim3(1, 16, 1), 256, 0, stream>>>(w_group, DM, 4, wrt, DM, 0, moe_g, 0, 0, 0);
            k_transpose<<<dim3(1, 16, 1), 256, 0, stream>>>(w_router, DM, 32, wrt + 4 * DM, DM, 0, moe_g, 0, 0, 0);
            k_rmsnorm_bf16<<<T, 256, 0, stream>>>(x, mix_g, xn);
            k_rmsnorm_bf16<<<NB * MEML, 256, 0, stream>>>(mem, mem_g, mn);
            k_rope<<<SEQ * 32 / 256, 256, 0, stream>>>(rope);
            break;
        case 1:
            { P_inproj pp{DM, 0, xn, win, proj, rope}; k_ngemm<<<dim3(PROJ_LD / 64, T / 64), 256, 0, stream>>>(pp); }
            { P_plain pp{DM, 0, mn, wkv, kvm, DM, DM, 2048, 0}; k_ngemm<<<dim3(2048 / 64, NB * MEML / 64), 256, 0, stream>>>(pp); }
            break;
        case 2: k_conv<<<2 * (T / 16), 256, 0, stream>>>(proj, conv_w); break;
        case 3: k_ret_scan<<<NB * RH, 256, 0, stream>>>(proj, H); k_ret_gn<<<T, 256, 0, stream>>>(proj, H); break;
        case 4: { P_merge pp{512, 1024, proj, wcat, xn}; k_ngemm<<<dim3(DM / 64, T / 64), 256, 0, stream>>>(pp); } break;
        case 5: { P_resid pp{DM, 0, xn, wmix, x, H, hb}; k_ngemm<<<dim3(DM / 64, T / 64), 256, 0, stream>>>(pp); } k_rowssq<<<T, 256, 0, stream>>>(H, ssq1); break;
        case 6: { P_q pp{DM, 0, hb, wq, ssq1, xn}; k_ngemm<<<dim3(DM / 64, T / 64), 256, 0, stream>>>(pp); } break;
        case 7: k_xattn<<<T * XH, 256, 0, stream>>>(xn, kvm); break;
        case 8: { P_resid pp{DM, 0, xn, wo, H, H, hb}; k_ngemm<<<dim3(DM / 64, T / 64), 256, 0, stream>>>(pp); } k_rowssq<<<T, 256, 0, stream>>>(H, ssq2); break;
        case 9:
            k_transpose<<<dim3(8, 16, NE), 256, 0, stream>>>(w_gate, DM, EH, egu, DM, 0, moe_g, 2, (size_t)DM * EH, (size_t)1024 * DM);
            k_transpose<<<dim3(8, 16, NE), 256, 0, stream>>>(w_up, DM, EH, egu, DM, 0, moe_g, 3, (size_t)DM * EH, (size_t)1024 * DM);
            k_transpose<<<dim3(16, 8, NE), 256, 0, stream>>>(w_down, EH, DM, ed, EH, 0, nullptr, 0, (size_t)EH * DM, (size_t)1024 * EH);
            k_route<<<T / 64, 64, 0, stream>>>(hb, wrt, ssq2, b_group, b_router, rs2, cnt, lid, lw);
            break;
        case 10: k_gather<<<XS_ROWS, 256, 0, stream>>>(hb, cnt, lid, lw, rs2, xs, rid, rw, rrs); break;
        case 11: { P_gu pp{DM, DM, xs, egu, cnt, rrs, hid}; k_ngemm<<<dim3(EH / 64, XS_ROWS / 64), 256, 0, stream>>>(pp); } break;
        case 12: { P_down pp{EH, 0, hid, ed, cnt, rid, rw, xs}; k_ngemm<<<dim3(DM / 64, XS_ROWS / 64), 256, 0, stream>>>(pp); } break;
        case 13: k_final<<<T, 256, 0, stream>>>(H, xs, final_g); break;
        }
        ++p;
    }
}
```

```cpp
#include <hip/hip_runtime.h>
#include <cstdio>
#include <cstdint>

typedef unsigned short bf16;
#define DEVI __device__ __forceinline__

constexpr int DM = 1024, NB = 4, SEQ = 4096, T = NB * SEQ;
constexpr int PROJ_LD = 6656;
constexpr int C_XIN = 0, C_BG = 512, C_CG = 1024, C_Q = 1536, C_K = 2048, C_V = 2560, C_G = 3584, C_GC = 4608, C_GR = 5632;
constexpr int RH = 8, RDK = 64, RDV = 128, RCH = 128;
constexpr int MEML = 256, XH = 4, XHD = 256;
constexpr int NE = 32, EH = 512;
constexpr int XS_ROWS = 40960;
constexpr float EPS = 1e-6f;
constexpr float QSCALE = 0.0625f * 1.4426950408889634f;

constexpr size_t MiB = 1u << 20;
constexpr size_t WS_CTL = 0;
constexpr size_t WS_ROPE = 1 * MiB;
constexpr size_t WS_WCAT = 2 * MiB;
constexpr size_t WS_WMIX = 5 * MiB;
constexpr size_t WS_WQ = 7 * MiB;
constexpr size_t WS_WKV = 9 * MiB;
constexpr size_t WS_WO = 13 * MiB;
constexpr size_t WS_WRT = 15 * MiB;
constexpr size_t WS_SSQ1 = 16 * MiB;
constexpr size_t WS_SSQ2 = 17 * MiB;
constexpr size_t WS_RS2 = 18 * MiB;
constexpr size_t WS_LID = 19 * MiB;
constexpr size_t WS_LW = 21 * MiB;
constexpr size_t WS_RID = 23 * MiB;
constexpr size_t WS_RW = WS_RID + 256 * 1024;
constexpr size_t WS_RRS = WS_RW + 256 * 1024;
constexpr size_t WS_MN = 24 * MiB;
constexpr size_t WS_KVM = 26 * MiB;
constexpr size_t WS_E = 30 * MiB;
constexpr size_t WS_WIN = 38 * MiB;
constexpr size_t WS_HID = 38 * MiB;
constexpr size_t WS_XN = 51 * MiB;
constexpr size_t WS_PROJ = 83 * MiB;
constexpr size_t WS_EGU = 83 * MiB;
constexpr size_t WS_ED = 147 * MiB;
constexpr size_t WS_XS = 179 * MiB;
constexpr size_t WS_HB = 259 * MiB;
constexpr size_t WS_END = 291 * MiB;
constexpr int CW_CNT = 1024, CNT_STRIDE = 32;

DEVI float bf2f(bf16 v) { return __uint_as_float((unsigned)v << 16); }
DEVI bf16 f2bf(float f) { unsigned u = __float_as_uint(f); return (bf16)((u + 0x7fffu + ((u >> 16) & 1u)) >> 16); }
DEVI float sigmoidf_(float x) { return 1.f / (1.f + __expf(-x)); }

__constant__ double c_invfreq[32] = {
    1.0, 0.7498942093324559, 0.5623413251903491, 0.4216965034285822, 0.31622776601683794, 0.23713737056616552,
    0.1778279410038923, 0.1333521432163324, 0.1, 0.07498942093324558, 0.05623413251903491, 0.04216965034285822,
    0.03162277660168379, 0.023713737056616554, 0.01778279410038923, 0.01333521432163324, 0.01, 0.007498942093324558,
    0.005623413251903491, 0.004216965034285823, 0.0031622776601683794, 0.0023713737056616554, 0.0017782794100389228,
    0.001333521432163324, 0.001, 0.0007498942093324559, 0.0005623413251903491, 0.0004216965034285823,
    0.00031622776601683794, 0.00023713737056616554, 0.00017782794100389227, 0.0001333521432163324};

__global__ void k_transpose(const float* __restrict__ W, int K, int N, bf16* WT, int ldwt, int koff, const float* __restrict__ kscale, int mode, size_t wstride, size_t wtstride) {
    W += (size_t)blockIdx.z * wstride; WT += (size_t)blockIdx.z * wtstride;
    const int n = blockIdx.x * 64 + (threadIdx.x & 63), k0 = blockIdx.y * 64 + (threadIdx.x >> 6) * 16;
    if (n >= N) return;
    int r = n;
    if (mode == 1) { if (n >= C_Q && n < C_V) { const int o = n & 63; r = (n & ~63) + 2 * (o & 31) + (o >> 5); } }
    else if (mode == 2) r = (n >> 7) * 256 + (n & 127);
    else if (mode == 3) r = (n >> 7) * 256 + 128 + (n & 127);
    for (int k = k0; k < k0 + 16 && k < K; ++k) {
        float v = W[(size_t)k * N + n]; if (kscale) v *= kscale[k];
        WT[(size_t)r * ldwt + koff + k] = f2bf(v);
    }
}
__global__ void k_zero_bf16(bf16* p, size_t n) { size_t i = (size_t)blockIdx.x * 256 + threadIdx.x; if (i < n) p[i] = 0; }

__global__ void k_rmsnorm_bf16(const float* __restrict__ x, const float* __restrict__ g, bf16* out) {
    const int row = blockIdx.x, t = threadIdx.x;
    const float4 v = ((const float4*)(x + (size_t)row * DM))[t];
    float s = v.x * v.x + v.y * v.y + v.z * v.z + v.w * v.w;
    __shared__ float red[4];
    for (int o = 32; o; o >>= 1) s += __shfl_xor(s, o);
    if ((t & 63) == 0) red[t >> 6] = s;
    __syncthreads();
    const float rstd = rsqrtf((red[0] + red[1] + red[2] + red[3]) * (1.f / DM) + EPS);
    const float4 gg = ((const float4*)g)[t];
    bf16* o = out + (size_t)row * DM + 4 * t;
    o[0] = f2bf(v.x * rstd * gg.x); o[1] = f2bf(v.y * rstd * gg.y); o[2] = f2bf(v.z * rstd * gg.z); o[3] = f2bf(v.w * rstd * gg.w);
}
__global__ void k_rope(float2* tab) {
    const int i = blockIdx.x * 256 + threadIdx.x; if (i >= SEQ * 32) return;
    const int pos = i >> 5, p = i & 31;
    const float ang = (float)pos * (float)c_invfreq[p];
    const double rev = (double)ang * 0.15915494309189535;
    const float fr = (float)(rev - floor(rev));
    tab[i] = make_float2(__builtin_amdgcn_cosf(fr), __builtin_amdgcn_sinf(fr));
}

template <class P> __global__ void __launch_bounds__(256) k_ngemm(P p) {
    __shared__ float As[16][65], Bs[16][65];
    const int mt = blockIdx.y; if (!p.valid(mt)) return;
    const int m0 = mt * 64, n0 = blockIdx.x * 64, tx = threadIdx.x & 15, ty = threadIdx.x >> 4;
    float a1[4][4] = {}, a2[4][4] = {};
    const int lr = threadIdx.x >> 2, lk = (threadIdx.x & 3) * 4;
    for (int seg = 0; seg < 2; ++seg) {
        const int Ks = seg ? p.K2 : p.K1; if (!Ks) continue;
        const bf16* ap = p.a_ptr(seg, m0 + lr); const bf16* bp = p.b_ptr(seg, mt, n0 + lr);
        for (int k0 = 0; k0 < Ks; k0 += 16) {
            const ushort4 av = *(const ushort4*)(ap + k0 + lk), bv = *(const ushort4*)(bp + k0 + lk);
            As[lk + 0][lr] = bf2f(av.x); As[lk + 1][lr] = bf2f(av.y); As[lk + 2][lr] = bf2f(av.z); As[lk + 3][lr] = bf2f(av.w);
            Bs[lk + 0][lr] = bf2f(bv.x); Bs[lk + 1][lr] = bf2f(bv.y); Bs[lk + 2][lr] = bf2f(bv.z); Bs[lk + 3][lr] = bf2f(bv.w);
            __syncthreads();
#pragma unroll
            for (int k = 0; k < 16; ++k) {
                float a[4], b[4];
#pragma unroll
                for (int i = 0; i < 4; ++i) { a[i] = As[k][ty * 4 + i]; b[i] = Bs[k][tx * 4 + i]; }
#pragma unroll
                for (int i = 0; i < 4; ++i)
#pragma unroll
                    for (int j = 0; j < 4; ++j) { if (seg) a2[i][j] += a[i] * b[j]; else a1[i][j] += a[i] * b[j]; }
            }
            __syncthreads();
        }
    }
#pragma unroll
    for (int i = 0; i < 4; ++i) p.epi(m0 + ty * 4 + i, n0 + tx * 4, a1[i], a2[i]);
}

struct P_inproj {
    int K1, K2; const bf16* xn; const bf16* win; bf16* proj; const float2* rope;
    DEVI const bf16* a_ptr(int, int m) const { return xn + (size_t)m * DM; }
    DEVI const bf16* b_ptr(int, int, int n) const { return win + (size_t)n * DM; }
    DEVI bool valid(int) const { return true; }
    DEVI void epi(int m, int n0, const float* a, const float*) const {
        float v[4] = {a[0], a[1], a[2], a[3]};
        if (n0 >= C_Q && n0 < C_V) {
            const int pos = m & (SEQ - 1), p0 = (n0 & 63) >> 1; const float sc = n0 >= C_K ? 0.125f : 1.f;
#pragma unroll
            for (int j = 0; j < 2; ++j) { const float2 cs = rope[pos * 32 + p0 + j]; const float t1 = v[2 * j], t2 = v[2 * j + 1];
                v[2 * j] = (t1 * cs.x - t2 * cs.y) * sc; v[2 * j + 1] = (t1 * cs.y + t2 * cs.x) * sc; }
        }
        bf16* o = proj + (size_t)m * PROJ_LD + n0;
#pragma unroll
        for (int j = 0; j < 4; ++j) o[j] = f2bf(v[j]);
    }
};
struct P_plain {
    int K1, K2; const bf16* A; const bf16* Bt; bf16* C; int lda, ldb, ldc, pad;
    DEVI const bf16* a_ptr(int, int m) const { return A + (size_t)m * lda; }
    DEVI const bf16* b_ptr(int, int, int n) const { return Bt + (size_t)n * ldb; }
    DEVI bool valid(int) const { return true; }
    DEVI void epi(int m, int n0, const float* a, const float*) const { bf16* o = C + (size_t)m * ldc + n0;
#pragma unroll
        for (int j = 0; j < 4; ++j) o[j] = f2bf(a[j]); }
};
__global__ void k_conv(bf16* proj, const float* __restrict__ cw) {
    const int c = threadIdx.x + (blockIdx.x & 1) * 256, t0 = (blockIdx.x >> 1) * 16, tb = t0 & ~(SEQ - 1);
    const float w0 = cw[c], w1 = cw[512 + c], w2 = cw[1024 + c];
    float u1 = 0.f, u2 = 0.f;
    for (int t = t0 - 2; t < t0 + 16; ++t) {
        float u = 0.f;
        if (t >= tb) { const bf16* r = proj + (size_t)t * PROJ_LD; u = bf2f(r[C_CG + c]) * bf2f(r[C_XIN + c]); }
        if (t >= t0) { bf16* r = proj + (size_t)t * PROJ_LD; r[C_BG + c] = f2bf(bf2f(r[C_BG + c]) * (w0 * u2 + w1 * u1 + w2 * u)); }
        u2 = u1; u1 = u;
    }
}
__global__ void __launch_bounds__(256) k_ret_scan(const bf16* __restrict__ proj, float* OT) {
    const int b = blockIdx.x >> 3, h = blockIdx.x & 7, tid = threadIdx.x, dv = tid & 127, dh = tid >> 7;
    const float gamma = 1.f - exp2f(-5.f - (float)h);
    float st[32];
#pragma unroll
    for (int i = 0; i < 32; ++i) st[i] = 0.f;
    __shared__ float qs[64], ks[64], part[128];
    for (int t = 0; t < SEQ; ++t) {
        const bf16* r = proj + (size_t)(b * SEQ + t) * PROJ_LD;
        if (tid < 64) qs[tid] = bf2f(r[C_Q + h * 64 + tid]); else if (tid < 128) ks[tid - 64] = bf2f(r[C_K + h * 64 + tid - 64]);
        const float v = bf2f(r[C_V + h * 128 + dv]);
        __syncthreads();
        float o = 0.f;
#pragma unroll
        for (int i = 0; i < 32; ++i) { st[i] = gamma * st[i] + ks[dh * 32 + i] * v; o += qs[dh * 32 + i] * st[i]; }
        if (dh) part[dv] = o;
        __syncthreads();
        if (!dh) OT[(size_t)(b * SEQ + t) * DM + h * 128 + dv] = o + part[dv];
    }
}
__global__ void k_ret_gn(bf16* proj, const float* __restrict__ OT) {
    const int row = blockIdx.x, tid = threadIdx.x;
    const float4 v = ((const float4*)(OT + (size_t)row * DM))[tid];
    float s = v.x + v.y + v.z + v.w;
    for (int o = 16; o; o >>= 1) s += __shfl_xor(s, o);
    const float mu = s * (1.f / 128.f);
    const float d0 = v.x - mu, d1 = v.y - mu, d2 = v.z - mu, d3 = v.w - mu;
    float q = d0 * d0 + d1 * d1 + d2 * d2 + d3 * d3;
    for (int o = 16; o; o >>= 1) q += __shfl_xor(q, o);
    const float rs = rsqrtf(q * (1.f / 128.f) + EPS);
    bf16* g = proj + (size_t)row * PROJ_LD + C_G + 4 * tid;
    const float dd[4] = {d0, d1, d2, d3};
#pragma unroll
    for (int j = 0; j < 4; ++j) { const float gv = bf2f(g[j]); g[j] = f2bf(gv * sigmoidf_(gv) * dd[j] * rs); }
}
struct P_merge {
    int K1, K2; const bf16* proj; const bf16* wcat; bf16* mrg;
    DEVI const bf16* a_ptr(int seg, int m) const { return proj + (size_t)m * PROJ_LD + (seg ? C_G : C_BG); }
    DEVI const bf16* b_ptr(int seg, int, int n) const { return wcat + (size_t)n * 1536 + (seg ? 512 : 0); }
    DEVI bool valid(int) const { return true; }
    DEVI void epi(int m, int n0, const float* a1, const float* a2) const {
        const bf16* r = proj + (size_t)m * PROJ_LD; bf16* o = mrg + (size_t)m * DM + n0;
#pragma unroll
        for (int j = 0; j < 4; ++j) o[j] = f2bf(sigmoidf_(bf2f(r[C_GC + n0 + j])) * a1[j] + sigmoidf_(bf2f(r[C_GR + n0 + j])) * a2[j]);
    }
};
struct P_resid {
    int K1, K2; const bf16* A; const bf16* Bt; const float* base; float* H; bf16* HB;
    DEVI const bf16* a_ptr(int, int m) const { return A + (size_t)m * DM; }
    DEVI const bf16* b_ptr(int, int, int n) const { return Bt + (size_t)n * DM; }
    DEVI bool valid(int) const { return true; }
    DEVI void epi(int m, int n0, const float* a, const float*) const {
        const size_t off = (size_t)m * DM + n0;
#pragma unroll
        for (int j = 0; j < 4; ++j) { const float v = base[off + j] + a[j]; H[off + j] = v; HB[off + j] = f2bf(v); }
    }
};
__global__ void k_rowssq(const float* __restrict__ H, float* ssq) {
    const int row = blockIdx.x, t = threadIdx.x;
    const float4 v = ((const float4*)(H + (size_t)row * DM))[t];
    float s = v.x * v.x + v.y * v.y + v.z * v.z + v.w * v.w;
    __shared__ float red[4];
    for (int o = 32; o; o >>= 1) s += __shfl_xor(s, o);
    if ((t & 63) == 0) red[t >> 6] = s;
    __syncthreads();
    if (t < 16) ssq[(size_t)row * 16 + t] = t ? 0.f : red[0] + red[1] + red[2] + red[3];
}
DEVI float rstd_from_ssq(const float* ssq, int row) {
    const float4* p = (const float4*)(ssq + (size_t)row * 16); float s = 0.f;
#pragma unroll
    for (int i = 0; i < 4; ++i) { const float4 v = p[i]; s += (v.x + v.y) + (v.z + v.w); }
    return rsqrtf(s * (1.f / DM) + EPS);
}
struct P_q {
    int K1, K2; const bf16* A; const bf16* Bt; const float* ssq; bf16* Q;
    DEVI const bf16* a_ptr(int, int m) const { return A + (size_t)m * DM; }
    DEVI const bf16* b_ptr(int, int, int n) const { return Bt + (size_t)n * DM; }
    DEVI bool valid(int) const { return true; }
    DEVI void epi(int m, int n0, const float* a, const float*) const { const float s = rstd_from_ssq(ssq, m) * QSCALE; bf16* o = Q + (size_t)m * DM + n0;
#pragma unroll
        for (int j = 0; j < 4; ++j) o[j] = f2bf(a[j] * s); }
};
__global__ void __launch_bounds__(256) k_xattn(bf16* Q, const bf16* __restrict__ kvm) {
    const int tok = blockIdx.x >> 2, h = blockIdx.x & 3, b = tok >> 12, j = threadIdx.x;
    __shared__ float qs[256], ps[256], red[8];
    bf16* qrow = Q + (size_t)tok * DM + h * XHD;
    qs[j] = bf2f(qrow[j]);
    __syncthreads();
    const bf16* kr = kvm + (size_t)(b * MEML + j) * 2048 + h * XHD;
    float s = 0.f;
    for (int d = 0; d < XHD; d += 4) { const ushort4 kv = *(const ushort4*)(kr + d); s += qs[d] * bf2f(kv.x) + qs[d + 1] * bf2f(kv.y) + qs[d + 2] * bf2f(kv.z) + qs[d + 3] * bf2f(kv.w); }
    float mx = s;
    for (int o = 32; o; o >>= 1) mx = fmaxf(mx, __shfl_xor(mx, o));
    if ((j & 63) == 0) red[j >> 6] = mx;
    __syncthreads();
    mx = fmaxf(fmaxf(red[0], red[1]), fmaxf(red[2], red[3]));
    const float p = exp2f(s - mx);
    ps[j] = p;
    float sm = p;
    for (int o = 32; o; o >>= 1) sm += __shfl_xor(sm, o);
    if ((j & 63) == 0) red[4 + (j >> 6)] = sm;
    __syncthreads();
    sm = red[4] + red[5] + red[6] + red[7];
    float o = 0.f;
    const bf16* vb = kvm + (size_t)(b * MEML) * 2048 + 1024 + h * XHD + j;
    for (int m = 0; m < MEML; ++m) o += ps[m] * bf2f(vb[(size_t)m * 2048]);
    qrow[j] = f2bf(o / sm);
}
DEVI float dot1024(const bf16* a, const bf16* w) {
    float s = 0.f;
    for (int k = 0; k < DM; k += 4) { const ushort4 av = *(const ushort4*)(a + k), wv = *(const ushort4*)(w + k); s += bf2f(av.x) * bf2f(wv.x) + bf2f(av.y) * bf2f(wv.y) + bf2f(av.z) * bf2f(wv.z) + bf2f(av.w) * bf2f(wv.w); }
    return s;
}
__global__ void k_route(const bf16* __restrict__ HB, const bf16* __restrict__ wrt, const float* __restrict__ ssq, const float* __restrict__ bg, const float* __restrict__ br,
                        float* rs2, unsigned* cnt, int* lid, float* lw) {
    const int tok = blockIdx.x * 64 + threadIdx.x;
    const float rs = rstd_from_ssq(ssq, tok); rs2[tok] = rs;
    const bf16* a = HB + (size_t)tok * DM;
    int gi = 0; float gm = -3.0e38f, gs = 0.f;
    {   float l4[4];
#pragma unroll
        for (int n = 0; n < 4; ++n) l4[n] = dot1024(a, wrt + (size_t)n * DM) * rs + bg[n];
#pragma unroll
        for (int n = 0; n < 4; ++n) if (l4[n] > gm) { gm = l4[n]; gi = n; }
#pragma unroll
        for (int n = 0; n < 4; ++n) gs += __expf(l4[n] - gm);
    }
    const float pg = 1.f / gs;
    float le[8];
#pragma unroll
    for (int n = 0; n < 8; ++n) le[n] = dot1024(a, wrt + (size_t)(4 + gi * 8 + n) * DM) * rs + br[gi * 8 + n];
    int e1 = 0; float m1 = -3.0e38f;
#pragma unroll
    for (int n = 0; n < 8; ++n) if (le[n] > m1) { m1 = le[n]; e1 = n; }
    int e2 = 0; float m2 = -3.0e38f;
#pragma unroll
    for (int n = 0; n < 8; ++n) if (n != e1 && le[n] > m2) { m2 = le[n]; e2 = n; }
    const float x2 = __expf(m2 - m1), w1 = pg / (1.f + x2), w2 = pg * x2 / (1.f + x2);
    const int E1 = gi * 8 + e1, E2 = gi * 8 + e2;
    const unsigned p1 = atomicAdd(&cnt[E1 * CNT_STRIDE], 1u), p2 = atomicAdd(&cnt[E2 * CNT_STRIDE], 1u);
    lid[E1 * 16384 + p1] = tok * 2; lw[E1 * 16384 + p1] = w1;
    lid[E2 * 16384 + p2] = tok * 2 + 1; lw[E2 * 16384 + p2] = w2;
}
DEVI int tile_expert(const unsigned* cnt, int tile, int& first_tile) {
    int ts = 0;
    for (int e = 0; e < NE; ++e) { const int nt = ((int)cnt[e * CNT_STRIDE] + 255) >> 8; if (tile < ts + nt) { first_tile = ts; return e; } ts += nt; }
    first_tile = ts; return -1;
}
__global__ void k_gather(const bf16* __restrict__ HB, const unsigned* __restrict__ cnt, const int* __restrict__ lid, const float* __restrict__ lw, const float* __restrict__ rs2,
                         bf16* XS, int* rid, float* rw, float* rrs) {
    const int row = blockIdx.x; int ft; const int e = tile_expert(cnt, row >> 8, ft);
    if (e < 0) return;
    const int pos = row - ft * 256; const bool real = pos < (int)cnt[e * CNT_STRIDE];
    const int id = real ? lid[e * 16384 + pos] : -1; const int tok = real ? (id >> 1) : 0;
    if (threadIdx.x == 0) { rid[row] = id; rw[row] = real ? lw[e * 16384 + pos] : 0.f; rrs[row] = rs2[tok]; }
    ((uint2*)(XS + (size_t)row * DM))[threadIdx.x] = ((const uint2*)(HB + (size_t)tok * DM))[threadIdx.x];
}
struct P_gu {
    int K1, K2; const bf16* XS; const bf16* egu; const unsigned* cnt; const float* rrs; bf16* HID;
    DEVI const bf16* a_ptr(int, int m) const { return XS + (size_t)m * DM; }
    DEVI const bf16* b_ptr(int seg, int mt, int n) const { int ft; const int e = tile_expert(cnt, mt >> 2, ft); return egu + ((size_t)e * 1024 + (n >> 7) * 256 + seg * 128 + (n & 127)) * DM; }
    DEVI bool valid(int mt) const { int ft; return tile_expert(cnt, mt >> 2, ft) >= 0; }
    DEVI void epi(int m, int n0, const float* a1, const float* a2) const { const float rs = rrs[m]; bf16* o = HID + (size_t)m * EH + n0;
#pragma unroll
        for (int j = 0; j < 4; ++j) { const float g = a1[j] * rs, u = a2[j] * rs; o[j] = f2bf(g * sigmoidf_(g) * u); } }
};
struct P_down {
    int K1, K2; const bf16* HID; const bf16* ed; const unsigned* cnt; const int* rid; const float* rw; bf16* YB;
    DEVI const bf16* a_ptr(int, int m) const { return HID + (size_t)m * EH; }
    DEVI const bf16* b_ptr(int, int mt, int n) const { int ft; const int e = tile_expert(cnt, mt >> 2, ft); return ed + ((size_t)e * 1024 + n) * EH; }
    DEVI bool valid(int mt) const { int ft; return tile_expert(cnt, mt >> 2, ft) >= 0; }
    DEVI void epi(int m, int n0, const float* a, const float*) const { const int id = rid[m]; if (id < 0) return; const float w = rw[m]; bf16* o = YB + (size_t)id * DM + n0;
#pragma unroll
        for (int j = 0; j < 4; ++j) o[j] = f2bf(a[j] * w); }
};
__global__ void k_final(float* H, const bf16* __restrict__ YB, const float* __restrict__ g) {
    const int row = blockIdx.x, t = threadIdx.x;
    float4 v = ((const float4*)(H + (size_t)row * DM))[t];
    const ushort4 y0 = ((const ushort4*)(YB + (size_t)(2 * row) * DM))[t], y1 = ((const ushort4*)(YB + (size_t)(2 * row + 1) * DM))[t];
    v.x += bf2f(y0.x) + bf2f(y1.x); v.y += bf2f(y0.y) + bf2f(y1.y); v.z += bf2f(y0.z) + bf2f(y1.z); v.w += bf2f(y0.w) + bf2f(y1.w);
    float s = v.x * v.x + v.y * v.y + v.z * v.z + v.w * v.w;
    __shared__ float red[4];
    for (int o = 32; o; o >>= 1) s += __shfl_xor(s, o);
    if ((t & 63) == 0) red[t >> 6] = s;
    __syncthreads();
    const float rstd = rsqrtf((red[0] + red[1] + red[2] + red[3]) * (1.f / DM) + EPS);
    const float4 gg = ((const float4*)g)[t];
    ((float4*)(H + (size_t)row * DM))[t] = make_float4(v.x * rstd * gg.x, v.y * rstd * gg.y, v.z * rstd * gg.z, v.w * rstd * gg.w);
}


#define LAS __attribute__((address_space(3)))
#define GAS __attribute__((address_space(1)))
typedef short bf16x8 __attribute__((ext_vector_type(8)));
typedef float f32x4 __attribute__((ext_vector_type(4)));
typedef float f32x2 __attribute__((ext_vector_type(2)));
typedef unsigned u32x4 __attribute__((ext_vector_type(4)));
typedef unsigned u32x2 __attribute__((ext_vector_type(2)));
typedef GAS unsigned gu32;
#define RLX_AGENT __ATOMIC_RELAXED, __HIP_MEMORY_SCOPE_AGENT
#define LDS_WAIT() asm volatile("s_waitcnt lgkmcnt(0)" ::: "memory")
#define VM_WAIT() asm volatile("s_waitcnt vmcnt(0)" ::: "memory")
constexpr int NWAVES = 8, NTHR = 512;
constexpr int RING_BYTES = 131072, LDSCTL_OFF = RING_BYTES, MISC_OFF = LDSCTL_OFF + 320, LDS_BYTES = 147456;
constexpr int CW_BAR = 4096;

#define XB_TMO      128
#define XB_XCNT(j)  (256  + 64 * (j))
#define XB_XSUB(j)  (1280 + 64 * (j))
#define XB_XGEN(j)  (2304 + 64 * (j))
#define XB_TOP      3328
#define XB_TOPGEN   3392
#define XCD_BAR_WORDS 3456
#define XB_SPIN_CAP (1u << 18)

__device__ __forceinline__ unsigned xb_ld(unsigned* p)              { return __hip_atomic_load(p, __ATOMIC_RELAXED, __HIP_MEMORY_SCOPE_AGENT); }
__device__ __forceinline__ unsigned xb_add(unsigned* p, unsigned v) { return __hip_atomic_fetch_add(p, v, __ATOMIC_RELAXED, __HIP_MEMORY_SCOPE_AGENT); }
__device__ __forceinline__ unsigned xb_xcc_id() { return (unsigned)__builtin_amdgcn_s_getreg((3 << 11) | 20) & 0xFu; }
#define XB_SPIN(cond, bar) do { unsigned _sp = 0; while (cond) { __builtin_amdgcn_s_sleep(1); \
    if ((++_sp & 255u) == 0u) { if (xb_ld(&(bar)[XB_TMO])) break; if (_sp > XB_SPIN_CAP) { atomicAdd(&(bar)[XB_TMO], 1u); break; } } } } while (0)

struct XcdBarrier {
    unsigned* bar; unsigned x;
    volatile LAS unsigned* st;
};

__device__ __forceinline__ XcdBarrier xcd_barrier_post(unsigned* bar, volatile LAS unsigned* st) {
    XcdBarrier b; b.bar = bar; b.x = xb_xcc_id(); b.st = st;
    if (threadIdx.x == 0) (void)xb_add(&bar[XB_XCNT(b.x)], 1u);
    return b;
}
__device__ __forceinline__ void xcd_barrier_complete(unsigned* bar, unsigned x, unsigned& nloc, unsigned& nx) {
    const unsigned G = gridDim.x * gridDim.y * gridDim.z;
    unsigned sum, cnt, mine, sp = 0u;
    for (;;) {
        sum = 0u; cnt = 0u; mine = 0u;
#pragma unroll
        for (unsigned j = 0; j < 16; ++j) { const unsigned c = xb_ld(&bar[XB_XCNT(j)]); sum += c; cnt += (c > 0u) ? 1u : 0u; mine = (j == x) ? c : mine; }
        if (sum == G) break;
        __builtin_amdgcn_s_sleep(1);
        if ((++sp & 255u) == 0u) { if (xb_ld(&bar[XB_TMO])) break; if (sp > XB_SPIN_CAP) { atomicAdd(&bar[XB_TMO], 1u); break; } }
    }
    nloc = mine > 0u ? mine : 1u; nx = cnt > 0u ? cnt : 1u;
}

__device__ __forceinline__ void xcd_barrier(const XcdBarrier& b) {
    asm volatile("s_waitcnt vmcnt(0)" ::: "memory");
    __syncthreads();
    if (threadIdx.x == 0) {
        unsigned* bar = b.bar;
        __builtin_amdgcn_s_waitcnt(0);
        unsigned nloc = b.st[0], nx = b.st[1];
        if (nloc == 0u) { xcd_barrier_complete(bar, b.x, nloc, nx); b.st[0] = nloc; b.st[1] = nx; }
        const unsigned old = xb_add(&bar[XB_XSUB(b.x)], 1u);
        const unsigned gen = old / nloc;
        if (old + 1u == (gen + 1u) * nloc) {
            __builtin_amdgcn_fence(__ATOMIC_RELEASE, "agent");
            asm volatile("s_waitcnt vmcnt(0)" ::: "memory");
            const unsigned og = xb_add(&bar[XB_TOP], 1u);
            const unsigned tg = og / nx;
            if (og + 1u == (tg + 1u) * nx) xb_add(&bar[XB_TOPGEN], 1u);
            else XB_SPIN(xb_ld(&bar[XB_TOPGEN]) == tg, bar);
            __builtin_amdgcn_fence(__ATOMIC_ACQUIRE, "agent");
            xb_add(&bar[XB_XGEN(b.x)], 1u);
            asm volatile("s_waitcnt vmcnt(0)" ::: "memory");
        } else {
            XB_SPIN(xb_ld(&bar[XB_XGEN(b.x)]) == gen, bar);
            __builtin_amdgcn_fence(__ATOMIC_ACQUIRE, "agent");
            asm volatile("s_waitcnt vmcnt(0)" ::: "memory");
        }
    }
    __syncthreads();
}


constexpr int BM = 256, BK = 64, HALF = 128, HTB = HALF * BK * 2, NXCD = 8, WGM = 8;
DEVI int lds_byte(int r, int c) { const int st = (r >> 4) * 2 + (c >> 5), rr = r & 15, cc = c & 31, ob = rr * 64 + cc * 2; return st * 1024 + (ob ^ (((ob >> 9) & 1) << 5)); }
DEVI void stage_rc(int b, int& R, int& C) { const int st = b / 1024, sb = b % 1024, swz = sb ^ (((sb >> 9) & 1) << 5); R = (st >> 1) * 16 + swz / 64; C = (st & 1) * 32 + (swz % 64) / 2; }
DEVI int perm32(int rho) { const int n = rho >> 4, i = rho & 15; return 8 * (i >> 2) + 4 * n + (i & 3); }
DEVI unsigned cvt_pk_bf16(float lo, float hi) { unsigned r; asm volatile("v_cvt_pk_bf16_f32 %0, %1, %2" : "=v"(r) : "v"(lo), "v"(hi)); return r; }
DEVI u32x4 pack8(const f32x4 a, const f32x4 b) { u32x4 w; w.x = cvt_pk_bf16(a[0], a[1]); w.y = cvt_pk_bf16(a[2], a[3]); w.z = cvt_pk_bf16(b[0], b[1]); w.w = cvt_pk_bf16(b[2], b[3]); return w; }
DEVI float bflo(unsigned w) { return __uint_as_float(w << 16); }
DEVI float bfhi(unsigned w) { return __uint_as_float(w & 0xffff0000u); }

struct Unit { int pm, pn, e; };
DEVI bool tile_order(int L, int nM, int nN, int& pm, int& pn) {
    const int nwg = nM * nN; if (L >= nwg) return false;
    int wgid = L; { const int q = nwg / NXCD, r = nwg % NXCD, xcd = wgid % NXCD, off = wgid / NXCD; wgid = (xcd < r ? xcd * (q + 1) : r * (q + 1) + (xcd - r) * q) + off; }
    const int nig = WGM * nN, gid = wgid / nig, fm = gid * WGM, gsz = (nM - fm) < WGM ? (nM - fm) : WGM;
    pm = fm + ((wgid % nig) % gsz); pn = (wgid % nig) / gsz; return true;
}

template <class Epi, class Sched, int JT>
DEVI void gemm_phase(LAS unsigned char* lds, const Sched& S, const Epi& E, const int lda, const int ldb, const int nt, const int jumpA) {
    const int tid = threadIdx.x, wid = __builtin_amdgcn_readfirstlane(tid >> 6), lane = tid & 63, wr = wid >> 2, wc = wid & 3, fr = lane & 15, fq = lane >> 4;
    unsigned voffA[2], voffB[2];
#pragma unroll
    for (int i = 0; i < 2; ++i) { int R, C; stage_rc(tid * 16 + i * 8192, R, C); const int Rb = (R & ~31) + perm32(R & 31);
        voffA[i] = (unsigned)(R * lda + C) * 2u; voffB[i] = (unsigned)(Rb * ldb + C) * 2u; }
    const size_t kstep = (size_t)(BK * 2);
    const size_t hstepA = (size_t)HALF * lda * 2, hstepB = (size_t)HALF * ldb * 2;
    const unsigned ldsw = (unsigned)wid * 1024u;
    const int aoff = lds_byte(wr * 64 + fr, fq * 8), boff = lds_byte(wc * 32 + fr, fq * 8);
#define PG8_SA(b, h) (((b) * 2 + (h)) * HTB)
#define PG8_SB(b, h) ((4 + (b) * 2 + (h)) * HTB)
#define PG8_STAGE(bufoff, gbase, voff) do { _Pragma("unroll") for (int _i = 0; _i < 2; ++_i) \
        __builtin_amdgcn_global_load_lds((const unsigned*)((const char*)(gbase) + (voff)[_i]), (LAS unsigned*)(lds + (bufoff) + ldsw + _i * 8192), 16, 0, 0); } while (0)
#define PG8_LDA(dst, b, h) do { _Pragma("unroll") for (int m = 0; m < 4; ++m) _Pragma("unroll") for (int k = 0; k < 2; ++k) dst[m][k] = *(const LAS bf16x8*)(lds + PG8_SA(b, h) + aoff + m * 2048 + k * 1024); } while (0)
#define PG8_LDB(dst, b, h) do { _Pragma("unroll") for (int n = 0; n < 2; ++n) _Pragma("unroll") for (int k = 0; k < 2; ++k) dst[n][k] = *(const LAS bf16x8*)(lds + PG8_SB(b, h) + boff + n * 2048 + k * 1024); } while (0)
#define PG8_MMA(ai, bj, At, Bt) do { __builtin_amdgcn_s_setprio(1); _Pragma("unroll") for (int m = 0; m < 4; ++m) _Pragma("unroll") for (int n = 0; n < 2; ++n) _Pragma("unroll") for (int k = 0; k < 2; ++k) \
        acc[ai][bj][m][n] = __builtin_amdgcn_mfma_f32_16x16x32_bf16(Bt[n][k], At[m][k], acc[ai][bj][m][n], 0, 0, 0); __builtin_amdgcn_s_setprio(0); } while (0)
#define PG8_WAIT_V(n) asm volatile("s_waitcnt vmcnt(" #n ")" ::: "memory")
#define PG8_WAIT_L(n) asm volatile("s_waitcnt lgkmcnt(" #n ")" ::: "memory")
#define PG8_BAR __builtin_amdgcn_s_barrier()
#define PG8_SCHED __builtin_amdgcn_sched_barrier(0)
#define PG8_AK(t) ((size_t)(t) * kstep + ((JT > 0 && (t) >= JT) ? (size_t)jumpA : (size_t)0))
#define PG8_KBODY(t) do { \
            const bool last = (t == nt - 2); \
            const char* a1 = cA + PG8_AK(t + 1); \
            const char* a2 = last ? nA : cA + PG8_AK(t + 2); const char* b2 = last ? nB : cB + (size_t)(t + 2) * kstep; \
            const char* a3 = last ? nA + kstep : cA + PG8_AK(t + 3); const char* b3 = b2 + kstep; \
            PG8_LDB(B0, 0, 0); PG8_LDB(B1, 0, 1); PG8_SCHED; PG8_LDA(At, 0, 0); PG8_STAGE(PG8_SA(1, 1), a1 + hstepA, voffA); \
            PG8_WAIT_V(8); PG8_WAIT_L(0); PG8_BAR; PG8_MMA(0, 0, At, B0); PG8_MMA(0, 1, At, B1); PG8_BAR; PG8_SCHED; \
            PG8_LDA(At, 0, 1); PG8_STAGE(PG8_SB(0, 0), b2, voffB); PG8_STAGE(PG8_SB(0, 1), b2 + hstepB, voffB); PG8_STAGE(PG8_SA(0, 0), a2, voffA); \
            PG8_WAIT_V(8); PG8_WAIT_L(0); PG8_BAR; PG8_MMA(1, 0, At, B0); PG8_MMA(1, 1, At, B1); PG8_BAR; PG8_SCHED; \
            PG8_LDB(B0, 1, 0); PG8_LDB(B1, 1, 1); PG8_SCHED; PG8_LDA(At, 1, 0); PG8_STAGE(PG8_SA(0, 1), a2 + hstepA, voffA); \
            PG8_WAIT_V(8); PG8_WAIT_L(0); PG8_BAR; PG8_MMA(0, 0, At, B0); PG8_MMA(0, 1, At, B1); PG8_BAR; PG8_SCHED; \
            PG8_LDA(At, 1, 1); PG8_STAGE(PG8_SB(1, 0), b3, voffB); PG8_STAGE(PG8_SB(1, 1), b3 + hstepB, voffB); PG8_STAGE(PG8_SA(1, 0), a3, voffA); \
            PG8_WAIT_V(8); PG8_WAIT_L(0); PG8_BAR; PG8_MMA(1, 0, At, B0); PG8_MMA(1, 1, At, B1); PG8_BAR; PG8_SCHED; \
        } while (0)
    Unit cur, nxt; int ui = 0;
    if (!S.next(0, cur)) return;
    f32x4 acc[2][2][4][2];
#pragma unroll
    for (int a = 0; a < 2; ++a)
#pragma unroll
        for (int b = 0; b < 2; ++b)
#pragma unroll
            for (int m = 0; m < 4; ++m)
#pragma unroll
                for (int n = 0; n < 2; ++n) acc[a][b][m][n] = (f32x4){0.f, 0.f, 0.f, 0.f};
    bf16x8 At[4][2], B0[2][2], B1[2][2];
    const char* cA = S.abase(cur); const char* cB = S.bbase(cur);
    PG8_STAGE(PG8_SB(0, 0), cB, voffB); PG8_STAGE(PG8_SB(0, 1), cB + hstepB, voffB); PG8_STAGE(PG8_SA(0, 0), cA, voffA); PG8_STAGE(PG8_SA(0, 1), cA + hstepA, voffA);
    if (wr == 1) PG8_BAR;
    PG8_WAIT_V(2); PG8_BAR;
    PG8_STAGE(PG8_SB(1, 0), cB + kstep, voffB); PG8_STAGE(PG8_SA(1, 0), cA + kstep, voffA); PG8_STAGE(PG8_SB(1, 1), cB + hstepB + kstep, voffB);
    PG8_WAIT_V(6); PG8_BAR;
    for (;;) {
        const bool has_next = S.next(ui + 1, nxt);
        const char* nA = has_next ? S.abase(nxt) : cA; const char* nB = has_next ? S.bbase(nxt) : cB;
        if constexpr (JT > 0) {
            for (int t = 0; t < JT; t += 2) PG8_KBODY(t);
            E.mid(acc, cur, wr, wc, fr, fq);
            for (int t = JT; t < nt; t += 2) PG8_KBODY(t);
        } else {
            for (int t = 0; t < nt; t += 2) PG8_KBODY(t);
        }
        if (wr == 0) PG8_BAR;
        E(acc, cur, wr, wc, fr, fq);
        if (!has_next) break;
#pragma unroll
        for (int a = 0; a < 2; ++a)
#pragma unroll
            for (int b = 0; b < 2; ++b)
#pragma unroll
                for (int m = 0; m < 4; ++m)
#pragma unroll
                    for (int n = 0; n < 2; ++n) acc[a][b][m][n] = (f32x4){0.f, 0.f, 0.f, 0.f};
        cur = nxt; cA = nA; cB = nB; ++ui;
        if (wr == 1) PG8_BAR;
    }
    PG8_WAIT_V(0);
    PG8_BAR;
#undef PG8_SA
#undef PG8_SB
#undef PG8_STAGE
#undef PG8_LDA
#undef PG8_LDB
#undef PG8_MMA
#undef PG8_WAIT_V
#undef PG8_WAIT_L
#undef PG8_BAR
#undef PG8_SCHED
#undef PG8_AK
#undef PG8_KBODY
}

struct SchedInproj {
    int G, c; const char *xn, *mn, *win, *wkv;
    DEVI bool next(int i, Unit& u) const {
        const int L = i * G + c;
        if (L < 64 * 26) { u.e = 0; return tile_order(L, 64, 26, u.pm, u.pn); }
        const int r = L - 64 * 26; if (r >= 32) return false;
        u.e = 1; u.pm = r & 3; u.pn = r >> 2; return true;
    }
    DEVI const char* abase(const Unit& u) const { return (u.e ? mn : xn) + (size_t)u.pm * (256 * DM * 2); }
    DEVI const char* bbase(const Unit& u) const { return (u.e ? wkv : win) + (size_t)u.pn * (256 * DM * 2); }
};
struct SchedSimple {
    int G, c; const char *A, *B; int lda, ldb;
    DEVI bool next(int i, Unit& u) const { u.e = 0; return tile_order(i * G + c, 64, 4, u.pm, u.pn); }
    DEVI const char* abase(const Unit& u) const { return A + (size_t)u.pm * 256 * lda * 2; }
    DEVI const char* bbase(const Unit& u) const { return B + (size_t)u.pn * 256 * ldb * 2; }
};
struct SchedMoe {
    int G, c, ntile; const unsigned* cnt; const char *A, *B; int lda, ldb;
    DEVI bool next(int i, Unit& u) const { if (!tile_order(i * G + c, ntile, 4, u.pm, u.pn)) return false; int ft; u.e = tile_expert(cnt, u.pm, ft); return true; }
    DEVI const char* abase(const Unit& u) const { return A + (size_t)u.pm * 256 * lda * 2; }
    DEVI const char* bbase(const Unit& u) const { return B + ((size_t)u.e * 1024 + u.pn * 256) * ldb * 2; }
};
DEVI int moe_ntiles(const unsigned* cnt) { int ts = 0; for (int e = 0; e < NE; ++e) ts += ((int)cnt[e * CNT_STRIDE] + 255) >> 8; return ts; }

typedef f32x4 Acc[2][2][4][2];
#define EPI_FENCE() asm volatile("" ::: "memory")
#define ROT2(V, I, C, J) do { const float t1_ = V[I], t2_ = V[I + 1]; V[I] = (t1_ * C[J] - t2_ * C[J + 1]) * sc; V[I + 1] = (t1_ * C[J + 1] + t2_ * C[J]) * sc; } while (0)
DEVI unsigned launder(unsigned x) { asm volatile("" : "+v"(x)); return x; }
#define ROWOFF(ai, m, ld, esz) ((unsigned)(((ai) * 128 + (m) * 16) * (ld) * (esz)))
struct EpiProj {
    bf16* proj; bf16* kvm; const float2* rope;
    DEVI void mid(Acc&, const Unit&, int, int, int, int) const {}
    DEVI void operator()(const Acc& acc, const Unit& u, int wr, int wc, int fr, int fq) const {
        const int row0 = u.pm * 256 + wr * 64 + fr, cl = wc * 32 + 8 * fq;
        if (u.e) {
            const unsigned lo = launder((unsigned)(row0 * 2048 + u.pn * 256 + cl) * 2u); char* base = (char*)kvm;
#pragma unroll
            for (int ai = 0; ai < 2; ++ai)
#pragma unroll
                for (int m = 0; m < 4; ++m) {
#pragma unroll
                    for (int bj = 0; bj < 2; ++bj) *(u32x4*)(base + lo + ROWOFF(ai, m, 2048, 2) + bj * 256) = pack8(acc[ai][bj][m][0], acc[ai][bj][m][1]); }
        } else {
            const bool rot = (u.pn >= 6) && (u.pn < 10), kq = (u.pn >= 8);
            float lgk[2];
#pragma unroll
            for (int bj = 0; bj < 2; ++bj) { const int hh = ((u.pn & 1) * 256 + bj * 128 + cl) >> 6; lgk[bj] = __log2f(1.f - exp2f(-5.f - (float)hh)); }
            const unsigned lo = launder((unsigned)(row0 * PROJ_LD + u.pn * 256 + cl) * 2u); char* base = (char*)proj;
            const unsigned ro = launder((unsigned)((row0 & (SEQ - 1)) * 32 + ((cl & 63) >> 1)) * 8u); const char* rbase = (const char*)rope;
#pragma unroll
            for (int ai = 0; ai < 2; ++ai)
#pragma unroll
                for (int m = 0; m < 4; ++m) {
                    f32x4 c01 = (f32x4){1.f, 0.f, 1.f, 0.f}, c23 = c01;
                    if (rot) { const f32x4* tp = (const f32x4*)(rbase + ro + ROWOFF(ai, m, 32, 8)); c01 = tp[0]; c23 = tp[1]; }
                    const float pe = (float)(127 - ((fr + m * 16) & 127));
#pragma unroll
                    for (int bj = 0; bj < 2; ++bj) { f32x4 v0 = acc[ai][bj][m][0], v1 = acc[ai][bj][m][1];
                        if (rot) { const float e_ = exp2f((pe - (float)(wr * 64)) * (kq ? lgk[bj] : -lgk[bj])); const float sc = kq ? 0.125f * e_ : e_;
                            ROT2(v0, 0, c01, 0); ROT2(v0, 2, c01, 2); ROT2(v1, 0, c23, 0); ROT2(v1, 2, c23, 2); }
                        *(u32x4*)(base + lo + ROWOFF(ai, m, PROJ_LD, 2) + bj * 256) = pack8(v0, v1); }
                    if (m & 1) EPI_FENCE(); }
        }
    }
};
DEVI float gate_ratio(float gr, float gc) { return (1.f + __expf(-gr)) * __builtin_amdgcn_rcpf(1.f + __expf(-gc)); }
struct EpiMerge {
    const bf16* proj; bf16* mrg;
    DEVI void mid(Acc& acc, const Unit& u, int wr, int wc, int fr, int fq) const {
        const int row0 = u.pm * 256 + wr * 64 + fr, cl = wc * 32 + 8 * fq;
        const unsigned lo = launder((unsigned)(row0 * PROJ_LD + u.pn * 256 + cl) * 2u); const char* base = (const char*)proj;
#pragma unroll
        for (int ai = 0; ai < 2; ++ai)
#pragma unroll
            for (int m = 0; m < 4; ++m) { const char* rp = base + lo + ROWOFF(ai, m, PROJ_LD, 2);
#pragma unroll
                for (int bj = 0; bj < 2; ++bj) { const u32x4 gc = *(const u32x4*)(rp + C_GC * 2 + bj * 256), gr = *(const u32x4*)(rp + C_GR * 2 + bj * 256);
#pragma unroll
                    for (int q = 0; q < 2; ++q) { acc[ai][bj][m][0][2 * q] *= gate_ratio(bflo(gr[q]), bflo(gc[q])); acc[ai][bj][m][0][2 * q + 1] *= gate_ratio(bfhi(gr[q]), bfhi(gc[q]));
                        acc[ai][bj][m][1][2 * q] *= gate_ratio(bflo(gr[2 + q]), bflo(gc[2 + q])); acc[ai][bj][m][1][2 * q + 1] *= gate_ratio(bfhi(gr[2 + q]), bfhi(gc[2 + q])); } }
                EPI_FENCE(); }
    }
    DEVI void operator()(const Acc& acc, const Unit& u, int wr, int wc, int fr, int fq) const {
        const int row0 = u.pm * 256 + wr * 64 + fr, cl = wc * 32 + 8 * fq;
        const unsigned lo = launder((unsigned)(row0 * PROJ_LD + u.pn * 256 + cl) * 2u); const char* base = (const char*)proj;
        const unsigned oo = launder((unsigned)(row0 * DM + u.pn * 256 + cl) * 2u); char* ob = (char*)mrg;
#pragma unroll
        for (int ai = 0; ai < 2; ++ai)
#pragma unroll
            for (int m = 0; m < 4; ++m) { const char* rp = base + lo + ROWOFF(ai, m, PROJ_LD, 2); char* op = ob + oo + ROWOFF(ai, m, DM, 2);
#pragma unroll
                for (int bj = 0; bj < 2; ++bj) { const u32x4 gr = *(const u32x4*)(rp + C_GR * 2 + bj * 256); f32x4 v0 = acc[ai][bj][m][0], v1 = acc[ai][bj][m][1];
#pragma unroll
                    for (int q = 0; q < 2; ++q) { v0[2 * q] *= sigmoidf_(bflo(gr[q])); v0[2 * q + 1] *= sigmoidf_(bfhi(gr[q])); v1[2 * q] *= sigmoidf_(bflo(gr[2 + q])); v1[2 * q + 1] *= sigmoidf_(bfhi(gr[2 + q])); }
                    *(u32x4*)(op + bj * 256) = pack8(v0, v1); }
                EPI_FENCE(); }
    }
};
struct EpiResid {
    const float* base; float* H; bf16* HB; float* ssq;
    DEVI void mid(Acc&, const Unit&, int, int, int, int) const {}
    DEVI void operator()(const Acc& acc, const Unit& u, int wr, int wc, int fr, int fq) const {
        const int row0 = u.pm * 256 + wr * 64 + fr, cl = wc * 32 + 8 * fq;
        const unsigned eo = launder((unsigned)(row0 * DM + u.pn * 256 + cl)); const unsigned so = launder((unsigned)(row0 * 16 + u.pn * 4 + wc) * 4u);
        const char* bb = (const char*)base; char* hb_ = (char*)H; char* hbb = (char*)HB; char* sb = (char*)ssq;
#pragma unroll
        for (int ai = 0; ai < 2; ++ai)
#pragma unroll
            for (int m = 0; m < 4; ++m) { const unsigned o4 = eo * 4u + ROWOFF(ai, m, DM, 4), o2 = eo * 2u + ROWOFF(ai, m, DM, 2); float ss = 0.f;
#pragma unroll
                for (int bj = 0; bj < 2; ++bj) { const f32x4 v0 = *(const f32x4*)(bb + o4 + bj * 512) + acc[ai][bj][m][0], v1 = *(const f32x4*)(bb + o4 + bj * 512 + 16) + acc[ai][bj][m][1];
                    *(f32x4*)(hb_ + o4 + bj * 512) = v0; *(f32x4*)(hb_ + o4 + bj * 512 + 16) = v1; *(u32x4*)(hbb + o2 + bj * 256) = pack8(v0, v1);
                    ss += (v0[0] * v0[0] + v0[1] * v0[1]) + (v0[2] * v0[2] + v0[3] * v0[3]) + (v1[0] * v1[0] + v1[1] * v1[1]) + (v1[2] * v1[2] + v1[3] * v1[3]); }
                ss += __shfl_xor(ss, 16); ss += __shfl_xor(ss, 32);
                if (fq == 0) *(float*)(sb + so + ROWOFF(ai, m, 16, 4)) = ss;
                EPI_FENCE(); }
    }
};
struct EpiQ {
    const float* ssq; bf16* Q;
    DEVI void mid(Acc&, const Unit&, int, int, int, int) const {}
    DEVI void operator()(const Acc& acc, const Unit& u, int wr, int wc, int fr, int fq) const {
        const int row0 = u.pm * 256 + wr * 64 + fr, cl = wc * 32 + 8 * fq;
        const unsigned oo = launder((unsigned)(row0 * DM + u.pn * 256 + cl) * 2u); const unsigned so = launder((unsigned)(row0 * 16) * 4u); char* ob = (char*)Q; const char* sb = (const char*)ssq;
#pragma unroll
        for (int ai = 0; ai < 2; ++ai)
#pragma unroll
            for (int m = 0; m < 4; ++m) { const f32x4* p = (const f32x4*)(sb + so + ROWOFF(ai, m, 16, 4)); float t = 0.f;
#pragma unroll
                for (int i = 0; i < 4; ++i) { const f32x4 v = p[i]; t += (v[0] + v[1]) + (v[2] + v[3]); }
                const float s = rsqrtf(t * (1.f / DM) + EPS) * QSCALE; char* op = ob + oo + ROWOFF(ai, m, DM, 2);
#pragma unroll
                for (int bj = 0; bj < 2; ++bj) *(u32x4*)(op + bj * 256) = pack8(acc[ai][bj][m][0] * s, acc[ai][bj][m][1] * s);
                if (m & 1) EPI_FENCE(); }
    }
};
struct EpiGU {
    const float* rrs; bf16* HID;
    DEVI void mid(Acc&, const Unit&, int, int, int, int) const {}
    DEVI void operator()(const Acc& acc, const Unit& u, int wr, int wc, int fr, int fq) const {
        const int row0 = u.pm * 256 + wr * 64 + fr, cl = wc * 32 + 8 * fq;
        const unsigned oo = launder((unsigned)(row0 * EH + u.pn * 128 + cl) * 2u); const unsigned so = launder((unsigned)row0 * 4u); char* ob = (char*)HID; const char* sb = (const char*)rrs;
#pragma unroll
        for (int ai = 0; ai < 2; ++ai)
#pragma unroll
            for (int m = 0; m < 4; ++m) { const float rs = *(const float*)(sb + so + ROWOFF(ai, m, 1, 4)); f32x4 h[2];
#pragma unroll
                for (int n = 0; n < 2; ++n)
#pragma unroll
                    for (int q = 0; q < 4; ++q) { const float g = acc[ai][0][m][n][q] * rs, up = acc[ai][1][m][n][q] * rs; h[n][q] = g * sigmoidf_(g) * up; }
                *(u32x4*)(ob + oo + ROWOFF(ai, m, EH, 2)) = pack8(h[0], h[1]);
                if (m & 1) EPI_FENCE(); }
    }
};
struct EpiDown {
    const int* rid; const float* rw; bf16* YB;
    DEVI void mid(Acc&, const Unit&, int, int, int, int) const {}
    DEVI void operator()(const Acc& acc, const Unit& u, int wr, int wc, int fr, int fq) const {
        const int row0 = u.pm * 256 + wr * 64 + fr, cl = wc * 32 + 8 * fq;
        const unsigned so = launder((unsigned)row0 * 4u); const unsigned co = launder((unsigned)(u.pn * 256 + cl) * 2u); const char* ib = (const char*)rid; const char* wb = (const char*)rw; char* ob = (char*)YB;
#pragma unroll
        for (int ai = 0; ai < 2; ++ai)
#pragma unroll
            for (int m = 0; m < 4; ++m) { const int id = *(const int*)(ib + so + ROWOFF(ai, m, 1, 4)); const float w = *(const float*)(wb + so + ROWOFF(ai, m, 1, 4));
                if (id >= 0) { char* op = ob + (size_t)id * (DM * 2) + co;
#pragma unroll
                    for (int bj = 0; bj < 2; ++bj) *(u32x4*)(op + bj * 256) = pack8(acc[ai][bj][m][0] * w, acc[ai][bj][m][1] * w); }
                if (m & 1) EPI_FENCE(); }
    }
};

struct Args { const float* in[22]; float* out; unsigned char* ws; int ph_lo, ph_hi; };
struct Frame {
    LAS unsigned char* lds; int tid, lane, wave, vcu, G;
    DEVI int gw() const { return vcu * NWAVES + wave; }
    DEVI int ngw() const { return G * NWAVES; }
};
DEVI float wave_sum(float v) {
#pragma unroll
    for (int o = 1; o < 64; o <<= 1) v += __shfl_xor(v, o);
    return v;
}
DEVI unsigned pk2(float lo, float hi) { return (unsigned)f2bf(lo) | ((unsigned)f2bf(hi) << 16); }
DEVI int wt_rowmap(int n, int mode) {
    if (mode == 1) { if (n >= C_Q && n < C_V) { const int o = n & 63; return (n & ~63) + 2 * (o & 31) + (o >> 5); } return n; }
    if (mode == 2) return (n >> 7) * 256 + (n & 127);
    if (mode == 3) return (n >> 7) * 256 + 128 + (n & 127);
    return n;
}
DEVI void transpose_item(const float* W, int K, int N, bf16* WT, int ldwt, int koff, const float* kscale, int mode, LAS float* scr, int item, int lane) {
    const int nblk = N / 32, kb = item / nblk, nb = item % nblk, k0 = 64 * kb, n0 = 32 * nb;
#pragma unroll 8
    for (int i = 0; i < 32; ++i) { const int kk = 2 * i + (lane >> 5); float v = W[(size_t)(k0 + kk) * N + n0 + (lane & 31)]; if (kscale) v *= kscale[k0 + kk]; scr[kk * 33 + (lane & 31)] = v; }
    LDS_WAIT(); asm volatile("" ::: "memory");
    const int c = lane & 7;
#pragma unroll
    for (int j = 0; j < 4; ++j) { const int n = (lane >> 3) + 8 * j; const LAS float* s = scr + (8 * c) * 33 + n;
        u32x4 o; o.x = pk2(s[0 * 33], s[1 * 33]); o.y = pk2(s[2 * 33], s[3 * 33]); o.z = pk2(s[4 * 33], s[5 * 33]); o.w = pk2(s[6 * 33], s[7 * 33]);
        *(u32x4*)(WT + (size_t)wt_rowmap(n0 + n, mode) * ldwt + koff + k0 + 8 * c) = o; }
    LDS_WAIT(); asm volatile("" ::: "memory");
}
DEVI void rms_row_to_bf16(const float* xrow, const float* g, bf16* orow, int lane) {
    const f32x4* xr = (const f32x4*)xrow + lane; const f32x4* gr = (const f32x4*)g + lane;
    f32x4 v[4]; float s = 0.f;
#pragma unroll
    for (int j = 0; j < 4; ++j) { v[j] = xr[64 * j]; s += (v[j].x * v[j].x + v[j].y * v[j].y) + (v[j].z * v[j].z + v[j].w * v[j].w); }
    const float rstd = rsqrtf(wave_sum(s) * (1.f / DM) + EPS);
    unsigned long long* o8 = (unsigned long long*)orow + lane;
#pragma unroll
    for (int j = 0; j < 4; ++j) { const f32x4 gg = gr[64 * j]; o8[64 * j] = (unsigned long long)pk2(v[j].x * rstd * gg.x, v[j].y * rstd * gg.y) | ((unsigned long long)pk2(v[j].z * rstd * gg.z, v[j].w * rstd * gg.w) << 32); }
}

#define MFMA16(a, b, c) __builtin_amdgcn_mfma_f32_16x16x32_bf16((a), (b), (c), 0, 0, 0)
typedef short v4i16_t __attribute__((ext_vector_type(4)));
DEVI bf16x8 tr_frag(const LAS unsigned char* p0, const LAS unsigned char* p1) {
    const v4i16_t a = __builtin_amdgcn_ds_read_tr16_b64_v4i16((LAS v4i16_t*)p0), b = __builtin_amdgcn_ds_read_tr16_b64_v4i16((LAS v4i16_t*)p1);
    return (bf16x8){a[0], a[1], a[2], a[3], b[0], b[1], b[2], b[3]};
}
constexpr int TI_P = 144, TI_BYTES = 64 * TI_P;
DEVI void transpose_item64(const float* W, int K, int N, bf16* WT, int ldwt, int koff, const float* kscale, int mode, LAS unsigned char* scr, int item, int lane) {
    const int nblk = N >> 6, kb = item / nblk, nb = item - kb * nblk, k0 = 64 * kb, n0 = 64 * nb;
    const int kr = lane >> 4, nc = 4 * (lane & 15);
    const float* src = W + (size_t)(k0 + kr) * N + n0 + nc;
#pragma unroll 8
    for (int i = 0; i < 16; ++i) { f32x4 v = *(const f32x4*)(src + (size_t)(4 * i) * N); if (kscale) v = v * kscale[k0 + 4 * i + kr];
        u32x2 w; w.x = cvt_pk_bf16(v[0], v[1]); w.y = cvt_pk_bf16(v[2], v[3]); *(LAS u32x2*)(scr + (4 * i + kr) * TI_P + nc * 2) = w; }
    LDS_WAIT(); asm volatile("" ::: "memory");
    const int g = lane >> 4, q4 = (lane & 15) >> 2, p4 = lane & 3, ii = lane & 15;
    const LAS unsigned char* rb = scr + (8 * g + q4) * TI_P + 8 * p4;
#pragma unroll
    for (int c = 0; c < 4; ++c) { bf16* drow = WT + (size_t)wt_rowmap(n0 + 16 * c + ii, mode) * ldwt + koff + k0 + 8 * g;
#pragma unroll
        for (int kh = 0; kh < 2; ++kh) { const bf16x8 v = tr_frag(rb + 32 * kh * TI_P + 32 * c, rb + (32 * kh + 4) * TI_P + 32 * c); *(bf16x8*)(drow + 32 * kh) = v; } }
    LDS_WAIT(); asm volatile("" ::: "memory");
}

DEVI void p0_prologue(Frame& F, const Args& a, unsigned char* ws) {
    LAS unsigned char* scr = F.lds + F.wave * TI_BYTES;
    const int gw = F.gw(), NGW = F.ngw();
    const float* w_in = a.in[3]; const float* w_conv_out = a.in[5]; const float* w_ret_out = a.in[6]; const float* w_mix_out = a.in[7];
    const float* xa_g = a.in[8]; const float* w_xa_q = a.in[10]; const float* w_xa_kv = a.in[11]; const float* w_xa_o = a.in[12]; const float* moe_g = a.in[13];
    bf16 *win = (bf16*)(ws + WS_WIN), *wcat = (bf16*)(ws + WS_WCAT), *wmix = (bf16*)(ws + WS_WMIX), *wq = (bf16*)(ws + WS_WQ), *wkv = (bf16*)(ws + WS_WKV), *wo = (bf16*)(ws + WS_WO), *wrt = (bf16*)(ws + WS_WRT);
    constexpr int I_IN = 16 * 104, I_C = 8 * 16, I_S = 16 * 16, I_KV = 16 * 32;
    constexpr int NITEMS = I_IN + I_C + 4 * I_S + I_KV;
    for (int it = gw; it < NITEMS; it += NGW) {
        int r = it;
        if (r < I_IN) { transpose_item64(w_in, DM, PROJ_LD, win, DM, 0, nullptr, 1, scr, r, F.lane); continue; } r -= I_IN;
        if (r < I_C) { transpose_item64(w_conv_out, 512, DM, wcat, 1536, 0, nullptr, 0, scr, r, F.lane); continue; } r -= I_C;
        if (r < I_S) { transpose_item64(w_ret_out, DM, DM, wcat, 1536, 512, nullptr, 0, scr, r, F.lane); continue; } r -= I_S;
        if (r < I_S) { transpose_item64(w_mix_out, DM, DM, wmix, DM, 0, nullptr, 0, scr, r, F.lane); continue; } r -= I_S;
        if (r < I_S) { transpose_item64(w_xa_q, DM, DM, wq, DM, 0, xa_g, 0, scr, r, F.lane); continue; } r -= I_S;
        if (r < I_S) { transpose_item64(w_xa_o, DM, DM, wo, DM, 0, nullptr, 0, scr, r, F.lane); continue; } r -= I_S;
        transpose_item64(w_xa_kv, DM, 2048, wkv, DM, 0, nullptr, 0, scr, r, F.lane);
    }
    const int gt = F.vcu * NTHR + F.tid, NGT = F.G * NTHR;
    {   const float* w_group = a.in[14]; const float* w_router = a.in[16];
        for (int i = gt; i < 48 * DM; i += NGT) { const int n = i >> 10, k = i & 1023; float v = 0.f;
            if (n < 4) v = w_group[k * 4 + n] * moe_g[k]; else if (n < 36) v = w_router[k * 32 + (n - 4)] * moe_g[k];
            wrt[i] = f2bf(v); } }
    {   float2* rope = (float2*)(ws + WS_ROPE);
        for (int i = gt; i < SEQ * 32; i += NGT) { const int pos = i >> 5, p = i & 31;
            const float ang = (float)pos * (float)c_invfreq[p]; const double rev = (double)ang * 0.15915494309189535; const float fr = (float)(rev - floor(rev));
            rope[i] = make_float2(__builtin_amdgcn_cosf(fr), __builtin_amdgcn_sinf(fr)); } }
    const float* x = a.in[0]; const float* mem = a.in[1]; bf16* xn = (bf16*)(ws + WS_XN); bf16* mn = (bf16*)(ws + WS_MN);
    for (int m = gw; m < T; m += NGW) rms_row_to_bf16(x + (size_t)m * DM, a.in[2], xn + (size_t)m * DM, F.lane);
    for (int m = gw; m < NB * MEML; m += NGW) rms_row_to_bf16(mem + (size_t)m * DM, a.in[9], mn + (size_t)m * DM, F.lane);
}
DEVI void p9_route(Frame& F, const Args& a, unsigned char* ws, int cntoff = 0) {
    const bf16* HB = (const bf16*)(ws + WS_HB); const bf16* wrt = (const bf16*)(ws + WS_WRT); const float* ssq = (const float*)(ws + WS_SSQ2);
    const float* bg = a.in[15]; const float* br = a.in[17]; float* rs2 = (float*)(ws + WS_RS2); unsigned* cnt = (unsigned*)(ws + WS_CTL) + CW_CNT + cntoff; int* lid = (int*)(ws + WS_LID); float* lw = (float*)(ws + WS_LW);
    const int lane = F.lane, fr = lane & 15, fq = lane >> 4, w = F.wave, tid = F.tid;
    LAS float* lg = (LAS float*)F.lds;
    LAS unsigned* hist = (LAS unsigned*)(F.lds + 2 * 64 * 49 * 4); LAS unsigned* base = hist + 32;
    for (int tb = F.vcu; tb < T / 64; tb += F.G) {
        if (tid < 32) hist[tid] = 0u;
        {   const int tg = w & 3, kh = w >> 2, tok0 = tb * 64 + tg * 16;
            f32x4 acc[3]; acc[0] = acc[1] = acc[2] = (f32x4){0.f, 0.f, 0.f, 0.f};
            const bf16* ap = HB + (size_t)(tok0 + fr) * DM + 512 * kh + 8 * fq; const bf16* bp = wrt + (size_t)fr * DM + 512 * kh + 8 * fq;
#pragma unroll 8
            for (int ks = 0; ks < 16; ++ks) { const bf16x8 av = *(const bf16x8*)(ap + 32 * ks);
#pragma unroll
                for (int nb = 0; nb < 3; ++nb) { const bf16x8 bv = *(const bf16x8*)(bp + (size_t)nb * 16 * DM + 32 * ks); acc[nb] = MFMA16(av, bv, acc[nb]); } }
            LAS float* l = lg + (kh * 64 + tg * 16) * 49;
#pragma unroll
            for (int nb = 0; nb < 3; ++nb)
#pragma unroll
                for (int r = 0; r < 4; ++r) l[(4 * fq + r) * 49 + 16 * nb + fr] = acc[nb][r];
        }
        __syncthreads();
        int E1 = 0, E2 = 0; unsigned r1 = 0, r2 = 0; float w1 = 0.f, w2 = 0.f;
        if (tid < 64) {
            const int tok = tb * 64 + tid; const float rs = rstd_from_ssq(ssq, tok); rs2[tok] = rs; const LAS float* l0 = lg + tid * 49; const LAS float* l1 = l0 + 64 * 49;
            int gi = 0; float gm = -3.0e38f, gs = 0.f; float l4[4];
#pragma unroll
            for (int n = 0; n < 4; ++n) l4[n] = (l0[n] + l1[n]) * rs + bg[n];
#pragma unroll
            for (int n = 0; n < 4; ++n) if (l4[n] > gm) { gm = l4[n]; gi = n; }
#pragma unroll
            for (int n = 0; n < 4; ++n) gs += __expf(l4[n] - gm);
            const float pg = 1.f / gs; float le[8];
#pragma unroll
            for (int n = 0; n < 8; ++n) le[n] = (l0[4 + gi * 8 + n] + l1[4 + gi * 8 + n]) * rs + br[gi * 8 + n];
            int e1 = 0; float m1 = -3.0e38f;
#pragma unroll
            for (int n = 0; n < 8; ++n) if (le[n] > m1) { m1 = le[n]; e1 = n; }
            int e2 = 0; float m2 = -3.0e38f;
#pragma unroll
            for (int n = 0; n < 8; ++n) if (n != e1 && le[n] > m2) { m2 = le[n]; e2 = n; }
            const float x2 = __expf(m2 - m1); w1 = pg / (1.f + x2); w2 = pg * x2 / (1.f + x2);
            E1 = gi * 8 + e1; E2 = gi * 8 + e2;
            r1 = __hip_atomic_fetch_add(hist + E1, 1u, __ATOMIC_RELAXED, __HIP_MEMORY_SCOPE_WORKGROUP); r2 = __hip_atomic_fetch_add(hist + E2, 1u, __ATOMIC_RELAXED, __HIP_MEMORY_SCOPE_WORKGROUP);
        }
        __syncthreads();
        if (tid < 32) { const unsigned hc = hist[tid]; base[tid] = hc ? atomicAdd(&cnt[tid * CNT_STRIDE], hc) : 0u; }
        __syncthreads();
        if (tid < 64) { const int tok = tb * 64 + tid; const unsigned p1 = base[E1] + r1, p2 = base[E2] + r2;
            lid[E1 * 16384 + p1] = tok * 2; lw[E1 * 16384 + p1] = w1; lid[E2 * 16384 + p2] = tok * 2 + 1; lw[E2 * 16384 + p2] = w2; }
        __syncthreads();
    }
    {
        LAS unsigned char* scr = F.lds + F.wave * TI_BYTES;
        const float* w_gate = a.in[18]; const float* w_up = a.in[19]; const float* w_down = a.in[20]; const float* moe_g = a.in[13];
        bf16* egu = (bf16*)(ws + WS_EGU); bf16* ed = (bf16*)(ws + WS_ED);
        for (int it = F.gw(); it < 3 * NE * 128; it += F.ngw()) { const int ty = it / (NE * 128), r = it % (NE * 128), e = r >> 7, li = r & 127;
            if (ty == 0) transpose_item64(w_gate + (size_t)e * DM * EH, DM, EH, egu + (size_t)e * 1024 * DM, DM, 0, moe_g, 2, scr, li, lane);
            else if (ty == 1) transpose_item64(w_up + (size_t)e * DM * EH, DM, EH, egu + (size_t)e * 1024 * DM, DM, 0, moe_g, 3, scr, li, lane);
            else transpose_item64(w_down + (size_t)e * EH * DM, EH, DM, ed + (size_t)e * 1024 * EH, EH, 0, nullptr, 0, scr, li, lane); }
    }
}
DEVI void p10_gather(Frame& F, unsigned char* ws) {
    const bf16* HB = (const bf16*)(ws + WS_HB); const unsigned* cnt = (const unsigned*)(ws + WS_CTL) + CW_CNT; const int* lid = (const int*)(ws + WS_LID); const float* lw = (const float*)(ws + WS_LW);
    const float* rs2 = (const float*)(ws + WS_RS2); bf16* XS = (bf16*)(ws + WS_XS); int* rid = (int*)(ws + WS_RID); float* rw = (float*)(ws + WS_RW); float* rrs = (float*)(ws + WS_RRS);
    const int rows = moe_ntiles(cnt) * 256;
    for (int row = F.gw(); row < rows; row += F.ngw()) {
        int ft; const int e = tile_expert(cnt, row >> 8, ft); const int pos = row - ft * 256; const bool real = pos < (int)cnt[e * CNT_STRIDE];
        const int id = real ? lid[e * 16384 + pos] : -1; const int tok = real ? (id >> 1) : 0;
        if (F.lane == 0) { rid[row] = id; rw[row] = real ? lw[e * 16384 + pos] : 0.f; rrs[row] = rs2[tok]; }
        const u32x4* s = (const u32x4*)(HB + (size_t)tok * DM); u32x4* d = (u32x4*)(XS + (size_t)row * DM);
        const u32x4 v0 = s[F.lane], v1 = s[F.lane + 64]; d[F.lane] = v0; d[F.lane + 64] = v1;
    }
}
DEVI void p13_final(Frame& F, const Args& a, unsigned char* ws) {
    float* H = a.out; const bf16* YB = (const bf16*)(ws + WS_XS); const f32x4* g4 = (const f32x4*)a.in[21];
    for (int row = F.gw(); row < T; row += F.ngw()) {
        f32x4* hr = (f32x4*)(H + (size_t)row * DM); const u32x2* y0 = (const u32x2*)(YB + (size_t)(2 * row) * DM); const u32x2* y1 = (const u32x2*)(YB + (size_t)(2 * row + 1) * DM);
        f32x4 v[4]; float s = 0.f;
#pragma unroll
        for (int j = 0; j < 4; ++j) { const int i = F.lane + 64 * j; v[j] = hr[i]; const u32x2 a0 = y0[i], a1 = y1[i];
            v[j].x += bflo(a0.x) + bflo(a1.x); v[j].y += bfhi(a0.x) + bfhi(a1.x); v[j].z += bflo(a0.y) + bflo(a1.y); v[j].w += bfhi(a0.y) + bfhi(a1.y);
            s += (v[j].x * v[j].x + v[j].y * v[j].y) + (v[j].z * v[j].z + v[j].w * v[j].w); }
        const float rstd = rsqrtf(wave_sum(s) * (1.f / DM) + EPS);
#pragma unroll
        for (int j = 0; j < 4; ++j) { const int i = F.lane + 64 * j; hr[i] = v[j] * rstd * g4[i]; }
    }
}


DEVI bf16x8 pack_frag(const f32x4 a, const f32x4 b) { const u32x4 w = pack8(a, b); return __builtin_bit_cast(bf16x8, w); }
constexpr int RT_QP = 160, RT_VP = 288, RT_SP = 144;
constexpr int RT_Q = 0, RT_K = 128 * RT_QP, RT_V = 2 * 128 * RT_QP, RT_S = RT_V + 128 * RT_VP, RT_O = RT_S + 128 * RT_SP, RT_OP = 272, RT_END = RT_O + 8 * 16 * RT_OP;
static_assert(RT_END <= RING_BYTES, "retention LDS");
template <bool OUT> DEVI void ret_unit(Frame& F, int un, bf16* proj, float* Eg) {
    const int b = un >> 6, h = (un >> 3) & 7, grp = un & 7, lane = F.lane, w = F.wave, fr = lane & 15, fq = lane >> 4, tid = F.tid;
    const float lg2 = __log2f(1.f - exp2f(-5.f - (float)h)), cd = exp2f(128.f * lg2);
    LAS unsigned char* L = F.lds;
    f32x4 sb[4];
#pragma unroll
    for (int db = 0; db < 4; ++db) sb[db] = (f32x4){0.f, 0.f, 0.f, 0.f};
    if (OUT) {
        const float cd4 = cd * cd * cd * cd;
        for (int gp = 0; gp < grp; ++gp) { const float* e = Eg + (size_t)(un - grp + gp) * 8192 + 16 * w + fr;
#pragma unroll
            for (int db = 0; db < 4; ++db)
#pragma unroll
                for (int r = 0; r < 4; ++r) sb[db][r] = sb[db][r] * cd4 + e[(16 * db + 4 * fq + r) * 128]; }
    }
    const int q4 = (lane & 15) >> 2, p4 = lane & 3;
    for (int n = 0; n < 4; ++n) {
        const size_t t0 = (size_t)b * SEQ + (size_t)(grp * 4 + n) * 128;
#pragma unroll
        for (int i = 0; i < 2; ++i) { const int idx = tid + 512 * i, row = idx >> 3, c = idx & 7; const bf16* g = proj + (t0 + row) * PROJ_LD + h * 64 + c * 8;
            *(LAS u32x4*)(L + RT_K + row * RT_QP + c * 16) = *(const u32x4*)(g + C_K);
            if (OUT) *(LAS u32x4*)(L + RT_Q + row * RT_QP + c * 16) = *(const u32x4*)(g + C_Q); }
#pragma unroll
        for (int i = 0; i < 4; ++i) { const int idx = tid + 512 * i, row = idx >> 4, c = idx & 15;
            *(LAS u32x4*)(L + RT_V + row * RT_VP + c * 16) = *(const u32x4*)(proj + (t0 + row) * PROJ_LD + C_V + h * 128 + c * 8); }
        u32x4 gv[4];
        bf16* grow = proj + (t0 + 16 * w + (lane >> 2)) * PROJ_LD + C_G + h * 128 + 32 * (lane & 3);
        if (OUT) {
#pragma unroll
            for (int i = 0; i < 4; ++i) gv[i] = *(const u32x4*)(grow + 8 * i); }
#pragma unroll
        for (int db = 0; db < 4; ++db) { sb[db] = sb[db] * cd;
            if (OUT) { u32x2 wv; wv.x = cvt_pk_bf16(sb[db][0], sb[db][1]); wv.y = cvt_pk_bf16(sb[db][2], sb[db][3]); *(LAS u32x2*)(L + RT_S + (16 * w + fr) * RT_SP + (16 * db + 4 * fq) * 2) = wv; } }
        __syncthreads();
        if (OUT) {
            bf16x8 qf[2];
#pragma unroll
            for (int ks = 0; ks < 2; ++ks) qf[ks] = *(const LAS bf16x8*)(L + RT_Q + (16 * w + fr) * RT_QP + 64 * ks + 16 * fq);
            f32x4 o[8];
#pragma unroll
            for (int d = 0; d < 8; ++d) o[d] = (f32x4){0.f, 0.f, 0.f, 0.f};
#pragma unroll
            for (int ks = 0; ks < 2; ++ks)
#pragma unroll
                for (int d = 0; d < 8; ++d) { const bf16x8 sf = *(const LAS bf16x8*)(L + RT_S + (16 * d + fr) * RT_SP + 64 * ks + 16 * fq); o[d] = MFMA16(qf[ks], sf, o[d]); }
            for (int s = 0; 2 * s <= w; ++s) {
                f32x4 st[2];
#pragma unroll
                for (int hh = 0; hh < 2; ++hh) { const int kb = 2 * s + hh; st[hh] = (f32x4){0.f, 0.f, 0.f, 0.f};
                    if (kb <= w) {
#pragma unroll
                        for (int ks = 0; ks < 2; ++ks) { const bf16x8 kf = *(const LAS bf16x8*)(L + RT_K + (16 * kb + fr) * RT_QP + 64 * ks + 16 * fq); st[hh] = MFMA16(kf, qf[ks], st[hh]); }
                        if (kb == w) {
#pragma unroll
                            for (int r = 0; r < 4; ++r) if (4 * fq + r > fr) st[hh][r] = 0.f; }
                    } }
                const bf16x8 pa = pack_frag(st[0], st[1]);
                const LAS unsigned char* vb = L + RT_V + (32 * s + 4 * fq + q4) * RT_VP + 8 * p4;
#pragma unroll
                for (int d = 0; d < 8; ++d) { const bf16x8 vf = tr_frag(vb + 32 * d, vb + 16 * RT_VP + 32 * d); o[d] = MFMA16(pa, vf, o[d]); }
            }
            LAS unsigned char* ot = L + RT_O + w * (16 * RT_OP);
#pragma unroll
            for (int r = 0; r < 4; ++r) { float s1 = 0.f;
#pragma unroll
                for (int d = 0; d < 8; ++d) s1 += o[d][r];
                s1 += __shfl_xor(s1, 1); s1 += __shfl_xor(s1, 2); s1 += __shfl_xor(s1, 4); s1 += __shfl_xor(s1, 8);
                const float mu = s1 * (1.f / 128.f); float s2 = 0.f;
#pragma unroll
                for (int d = 0; d < 8; ++d) { const float dd = o[d][r] - mu; s2 += dd * dd; }
                s2 += __shfl_xor(s2, 1); s2 += __shfl_xor(s2, 2); s2 += __shfl_xor(s2, 4); s2 += __shfl_xor(s2, 8);
                const float rs = rsqrtf(s2 * (1.f / 128.f) + EPS);
#pragma unroll
                for (int d = 0; d < 8; ++d) *(LAS bf16*)(ot + (4 * fq + r) * RT_OP + (16 * d + fr) * 2) = f2bf((o[d][r] - mu) * rs); }
            LDS_WAIT(); asm volatile("" ::: "memory");
#pragma unroll
            for (int i = 0; i < 4; ++i) { const u32x4 ov = *(const LAS u32x4*)(ot + (lane >> 2) * RT_OP + 64 * (lane & 3) + 16 * i); u32x4 res;
#pragma unroll
                for (int q = 0; q < 4; ++q) { const float g0 = bflo(gv[i][q]), g1 = bfhi(gv[i][q]); res[q] = cvt_pk_bf16(g0 * sigmoidf_(g0) * bflo(ov[q]), g1 * sigmoidf_(g1) * bfhi(ov[q])); }
                *(u32x4*)(grow + 8 * i) = res; }
        }
        {   const LAS unsigned char* kb_ = L + RT_K + (4 * fq + q4) * RT_QP + 8 * p4; const LAS unsigned char* vb_ = L + RT_V + (4 * fq + q4) * RT_VP + 32 * w + 8 * p4;
#pragma unroll
            for (int ks = 0; ks < 4; ++ks) { const bf16x8 vf = tr_frag(vb_ + 32 * ks * RT_VP, vb_ + (32 * ks + 16) * RT_VP);
#pragma unroll
                for (int db = 0; db < 4; ++db) { const bf16x8 kf = tr_frag(kb_ + 32 * ks * RT_QP + 32 * db, kb_ + (32 * ks + 16) * RT_QP + 32 * db); sb[db] = MFMA16(kf, vf, sb[db]); } }
        }
        __syncthreads();
    }
    if (!OUT) { float* e = Eg + (size_t)un * 8192 + 16 * w + fr;
#pragma unroll
        for (int db = 0; db < 4; ++db)
#pragma unroll
            for (int r = 0; r < 4; ++r) e[(16 * db + 4 * fq + r) * 128] = sb[db][r]; }
}
DEVI void conv_rows(Frame& F, bf16* proj, const float* cw, bf16* outb, int ldo) {
    const int lane = F.lane; float w0[8], w1[8], w2[8];
#pragma unroll
    for (int j = 0; j < 8; ++j) { w0[j] = cw[8 * lane + j]; w1[j] = cw[512 + 8 * lane + j]; w2[j] = cw[1024 + 8 * lane + j]; }
    for (int blk = F.gw(); blk < T / 4; blk += F.ngw()) {
        const int t0 = blk * 4, tb = t0 & ~(SEQ - 1); u32x4 xv[6], cv[6], bv[4];
#pragma unroll
        for (int i = 0; i < 6; ++i) { const int t = t0 - 2 + i; const bool ok = t >= tb; const bf16* r = proj + (size_t)(ok ? t : t0) * PROJ_LD + 8 * lane;
            xv[i] = *(const u32x4*)(r + C_XIN); cv[i] = *(const u32x4*)(r + C_CG); if (!ok) { xv[i] = (u32x4){0u, 0u, 0u, 0u}; } }
#pragma unroll
        for (int i = 0; i < 4; ++i) bv[i] = *(const u32x4*)(proj + (size_t)(t0 + i) * PROJ_LD + C_BG + 8 * lane);
        float u[6][8];
#pragma unroll
        for (int i = 0; i < 6; ++i)
#pragma unroll
            for (int q = 0; q < 4; ++q) { u[i][2 * q] = bflo(xv[i][q]) * bflo(cv[i][q]); u[i][2 * q + 1] = bfhi(xv[i][q]) * bfhi(cv[i][q]); }
#pragma unroll
        for (int i = 0; i < 4; ++i) { u32x4 ov;
#pragma unroll
            for (int q = 0; q < 4; ++q) { const float a0 = bflo(bv[i][q]) * (w0[2 * q] * u[i][2 * q] + w1[2 * q] * u[i + 1][2 * q] + w2[2 * q] * u[i + 2][2 * q]);
                const float a1 = bfhi(bv[i][q]) * (w0[2 * q + 1] * u[i][2 * q + 1] + w1[2 * q + 1] * u[i + 1][2 * q + 1] + w2[2 * q + 1] * u[i + 2][2 * q + 1]); ov[q] = cvt_pk_bf16(a0, a1); }
            *(u32x4*)(outb + (size_t)(t0 + i) * ldo + 8 * lane) = ov; }
    }
}
constexpr int XA_KP = 528, XA_VP = 544, XA_BUF = 64 * XA_VP;
static_assert(2 * XA_BUF <= RING_BYTES, "xattn LDS");
DEVI void xattn_unit(Frame& F, int un, const bf16* Q, const bf16* kvm, bf16* O) {
    const int bh = un >> 5, rb = un & 31, b = bh >> 2, h = bh & 3, lane = F.lane, w = F.wave, fr = lane & 15, fq = lane >> 4, tid = F.tid, q4 = (lane & 15) >> 2, p4 = lane & 3;
    const size_t q0 = (size_t)b * SEQ + rb * 128 + 16 * w;
    LAS unsigned char* L = F.lds;
    const bf16* kbase = kvm + (size_t)(b * MEML) * 2048 + h * XHD;
    bf16x8 qf[8];
#pragma unroll
    for (int ks = 0; ks < 8; ++ks) qf[ks] = *(const bf16x8*)(Q + (q0 + fr) * DM + h * XHD + 32 * ks + 8 * fq);
    u32x4 sr[4];
#define XA_LOAD(sl) do { const bf16* src_ = kbase + ((sl) >= 4 ? 1024 : 0) + (size_t)(((sl) & 3) * 64) * 2048; \
        _Pragma("unroll") for (int i = 0; i < 4; ++i) { const int idx = tid + 512 * i, row = idx >> 5, c = idx & 31; sr[i] = *(const u32x4*)(src_ + (size_t)row * 2048 + c * 8); } } while (0)
#define XA_WRITE(sl) do { const int pitch_ = (sl) >= 4 ? XA_VP : XA_KP; LAS unsigned char* dst_ = L + ((sl) & 1) * XA_BUF; \
        _Pragma("unroll") for (int i = 0; i < 4; ++i) { const int idx = tid + 512 * i, row = idx >> 5, c = idx & 31; *(LAS u32x4*)(dst_ + row * pitch_ + c * 16) = sr[i]; } } while (0)
    XA_LOAD(0); XA_WRITE(0);
    __syncthreads();
    f32x4 st[16];
#pragma unroll
    for (int j = 0; j < 4; ++j) {
        XA_LOAD(j + 1);
        const LAS unsigned char* kb_ = L + (j & 1) * XA_BUF + fr * XA_KP + 16 * fq;
#pragma unroll
        for (int kk = 0; kk < 4; ++kk) { f32x4 a = (f32x4){0.f, 0.f, 0.f, 0.f};
#pragma unroll
            for (int ks = 0; ks < 8; ++ks) { const bf16x8 kf = *(const LAS bf16x8*)(kb_ + 16 * kk * XA_KP + 64 * ks); a = MFMA16(kf, qf[ks], a); }
            st[4 * j + kk] = a; }
        XA_WRITE(j + 1);
        __syncthreads();
    }
    float mx = -3.0e38f;
#pragma unroll
    for (int kb = 0; kb < 16; ++kb) mx = fmaxf(fmaxf(fmaxf(mx, st[kb][0]), fmaxf(st[kb][1], st[kb][2])), st[kb][3]);
    mx = fmaxf(mx, __shfl_xor(mx, 16)); mx = fmaxf(mx, __shfl_xor(mx, 32));
    float sm = 0.f;
#pragma unroll
    for (int kb = 0; kb < 16; ++kb)
#pragma unroll
        for (int r = 0; r < 4; ++r) { const float p = exp2f(st[kb][r] - mx); st[kb][r] = p; sm += p; }
    sm += __shfl_xor(sm, 16); sm += __shfl_xor(sm, 32);
    bf16x8 pa[8];
#pragma unroll
    for (int s = 0; s < 8; ++s) pa[s] = pack_frag(st[2 * s], st[2 * s + 1]);
    f32x4 o[16];
#pragma unroll
    for (int d = 0; d < 16; ++d) o[d] = (f32x4){0.f, 0.f, 0.f, 0.f};
#pragma unroll
    for (int j = 4; j < 8; ++j) {
        if (j < 7) XA_LOAD(j + 1);
        const LAS unsigned char* vb_ = L + (j & 1) * XA_BUF + (4 * fq + q4) * XA_VP + 8 * p4;
#pragma unroll
        for (int s2 = 0; s2 < 2; ++s2)
#pragma unroll
            for (int d = 0; d < 16; ++d) { const bf16x8 vf = tr_frag(vb_ + 32 * s2 * XA_VP + 32 * d, vb_ + (32 * s2 + 16) * XA_VP + 32 * d); o[d] = MFMA16(pa[2 * (j - 4) + s2], vf, o[d]); }
        if (j < 7) XA_WRITE(j + 1);
        __syncthreads();
    }
#undef XA_LOAD
#undef XA_WRITE
    const float inv = 1.f / sm;
    LAS unsigned char* ot = L + w * (16 * XA_KP);
#pragma unroll
    for (int r = 0; r < 4; ++r) { const float iv = __shfl(inv, 4 * fq + r);
#pragma unroll
        for (int d = 0; d < 16; ++d) *(LAS bf16*)(ot + (4 * fq + r) * XA_KP + (16 * d + fr) * 2) = f2bf(o[d][r] * iv); }
    LDS_WAIT(); asm volatile("" ::: "memory");
    {   bf16* op = O + (q0 + (lane >> 2)) * DM + h * XHD + 64 * (lane & 3); const LAS unsigned char* rp = ot + (lane >> 2) * XA_KP + 128 * (lane & 3);
#pragma unroll
        for (int i = 0; i < 8; ++i) *(u32x4*)(op + 8 * i) = *(const LAS u32x4*)(rp + 16 * i); }
    __syncthreads();
}

constexpr int NPH = 14;
struct ArgsK { Args a; int li, pad; };
__global__ void __launch_bounds__(NTHR, 2) mega(ArgsK ak) {
    extern __shared__ __attribute__((aligned(16))) unsigned char lds_raw[];
    const Args& args = ak.a;
    Frame F; F.lds = (LAS unsigned char*)lds_raw; F.tid = threadIdx.x; F.lane = F.tid & 63; F.wave = __builtin_amdgcn_readfirstlane(F.tid >> 6);
    F.G = gridDim.x; { const int bx = blockIdx.x; F.vcu = (F.G % 8 == 0) ? (bx % 8) * (F.G / 8) + bx / 8 : bx; }
    unsigned char* ws = args.ws; gu32* ctl = (gu32*)(ws + WS_CTL);
    for (int u = F.tid; u < (LDS_BYTES - LDSCTL_OFF) / 4; u += NTHR) ((LAS unsigned*)(F.lds + LDSCTL_OFF))[u] = 0u;
    __syncthreads();
    const int lo = args.ph_lo, hi = args.ph_hi;
    XcdBarrier bar; bar.bar = (unsigned*)(ctl + CW_BAR) + ak.li * XCD_BAR_WORDS; bar.x = 0; bar.st = nullptr;
    if (hi - lo > 1) bar = xcd_barrier_post((unsigned*)(ctl + CW_BAR) + ak.li * XCD_BAR_WORDS, (volatile LAS unsigned*)(F.lds + MISC_OFF) + 8);
#ifndef PH_MASK
#define PH_MASK 0x3fff
#endif
#define IN(k) (((PH_MASK >> (k)) & 1) && lo <= (k) && (k) < hi)
#define SEAM(k) do { if (IN(k) && IN((k) + 1)) xcd_barrier(bar); } while (0)
#ifndef PROBE_REP
#define PROBE_REP (-1)
#endif
#ifndef PROBE_N
#define PROBE_N 3
#endif
#define REP(k) for (int rep_ = 0; rep_ < ((k) == PROBE_REP ? PROBE_N : 1); ++rep_, ((k) == PROBE_REP && rep_ < PROBE_N ? xcd_barrier(bar) : (void)0))
    const int bx = (int)blockIdx.x;
    bf16* proj = (bf16*)(ws + WS_PROJ); bf16* xn = (bf16*)(ws + WS_XN); bf16* hb = (bf16*)(ws + WS_HB); float* H = args.out;
    float* ssq1 = (float*)(ws + WS_SSQ1); float* ssq2 = (float*)(ws + WS_SSQ2); const unsigned* cnt = (const unsigned*)(ws + WS_CTL) + CW_CNT;

    if (IN(0)) { REP(0) { p0_prologue(F, args, ws); } SEAM(0); }
    if (IN(1)) { REP(1) {
        SchedInproj S{F.G, bx, (const char*)xn, (const char*)(ws + WS_MN), (const char*)(ws + WS_WIN), (const char*)(ws + WS_WKV)};
        EpiProj E{proj, (bf16*)(ws + WS_KVM), (const float2*)(ws + WS_ROPE)};
        gemm_phase<EpiProj, SchedInproj, 0>(F.lds, S, E, DM, DM, DM / 64, 0);
        } SEAM(1);
    }
    if (IN(2)) { REP(2) {
        { const bool dm_ = (PROBE_REP == 2) && rep_ < PROBE_N - 1; conv_rows(F, proj, args.in[4], dm_ ? xn : proj + C_BG, dm_ ? 512 : PROJ_LD); }
        for (int un = F.vcu; un < 256; un += F.G) ret_unit<false>(F, un, proj, (float*)(ws + WS_E));
        } SEAM(2);
    }
    if (IN(3)) { REP(3) { for (int un = F.vcu; un < 256; un += F.G) ret_unit<true>(F, un, proj, (float*)(ws + WS_E)); } SEAM(3); }
    if (IN(4)) { REP(4) {
        SchedSimple S{F.G, bx, (const char*)(proj + C_BG), (const char*)(ws + WS_WCAT), PROJ_LD, 1536};
        EpiMerge E{proj, xn};
        gemm_phase<EpiMerge, SchedSimple, 8>(F.lds, S, E, PROJ_LD, 1536, 24, (C_G - C_BG - 512) * 2);
        } SEAM(4);
    }
    if (IN(5)) { REP(5) {
        SchedSimple S{F.G, bx, (const char*)xn, (const char*)(ws + WS_WMIX), DM, DM};
        EpiResid E{args.in[0], H, hb, ssq1};
        gemm_phase<EpiResid, SchedSimple, 0>(F.lds, S, E, DM, DM, DM / 64, 0);
        } SEAM(5);
    }
    if (IN(6)) { REP(6) {
        SchedSimple S{F.G, bx, (const char*)hb, (const char*)(ws + WS_WQ), DM, DM};
        EpiQ E{ssq1, xn};
        gemm_phase<EpiQ, SchedSimple, 0>(F.lds, S, E, DM, DM, DM / 64, 0);
        } SEAM(6);
    }
    if (IN(7)) { REP(7) { for (int un = F.vcu; un < 512; un += F.G) xattn_unit(F, un, xn, (const bf16*)(ws + WS_KVM), ((PROBE_REP == 7) && rep_ < PROBE_N - 1) ? hb : xn); } SEAM(7); }
    if (IN(8)) { REP(8) {
        SchedSimple S{F.G, bx, (const char*)xn, (const char*)(ws + WS_WO), DM, DM};
        EpiResid E{H, H, hb, ssq2};
        gemm_phase<EpiResid, SchedSimple, 0>(F.lds, S, E, DM, DM, DM / 64, 0);
        } SEAM(8);
    }
    if (IN(9)) { REP(9) { p9_route(F, args, ws, ((PROBE_REP == 9) && rep_ < PROBE_N - 1) ? 1024 * (rep_ + 1) : 0); } SEAM(9); }
    if (IN(10)) { REP(10) { p10_gather(F, ws); } SEAM(10); }
    if (IN(11)) { REP(11) {
        SchedMoe S{F.G, bx, moe_ntiles(cnt), cnt, (const char*)(ws + WS_XS), (const char*)(ws + WS_EGU), DM, DM};
        EpiGU E{(const float*)(ws + WS_RRS), (bf16*)(ws + WS_HID)};
        gemm_phase<EpiGU, SchedMoe, 0>(F.lds, S, E, DM, DM, DM / 64, 0);
        } SEAM(11);
    }
    if (IN(12)) { REP(12) {
        SchedMoe S{F.G, bx, moe_ntiles(cnt), cnt, (const char*)(ws + WS_HID), (const char*)(ws + WS_ED), EH, EH};
        EpiDown E{(const int*)(ws + WS_RID), (const float*)(ws + WS_RW), (bf16*)(ws + WS_XS)};
        gemm_phase<EpiDown, SchedMoe, 0>(F.lds, S, E, EH, EH, EH / 64, 0);
        } SEAM(12);
    }
    if (IN(13)) { REP(13) { p13_final(F, args, ws); } }
#undef IN
#undef SEAM
}

#define MEGA_FUSE 1
static const int USE_MEGA[NPH] = {1, 1, 1, 1, 1, 1, 1, 1, 1, 1, 1, 1, 1, 1};
extern "C" void kernel_launch(void* const* d_in, const int* in_sizes, int n_in, void* d_out, int out_size, void* d_ws, size_t ws_size, hipStream_t stream) {
    if (n_in != 22 || out_size != T * DM || ws_size < WS_END) { fprintf(stderr, "kernel_launch: unexpected shapes (n_in %d out %d ws %zu)\n", n_in, out_size, ws_size); return; }
    static int grid = 0;
    if (grid == 0) {
        int dev = 0, cus = 0;
        if (hipGetDevice(&dev) != hipSuccess || hipDeviceGetAttribute(&cus, hipDeviceAttributeMultiprocessorCount, dev) != hipSuccess) { grid = -1; return; }
        if (hipFuncSetAttribute((const void*)mega, hipFuncAttributeMaxDynamicSharedMemorySize, LDS_BYTES) != hipSuccess) { fprintf(stderr, "kernel_launch: hipFuncSetAttribute failed\n"); grid = -1; return; }
        grid = cus;
        if (grid != 256) fprintf(stderr, "kernel_launch: %d CUs (built for 256)\n", grid);
    }
    if (grid < 0) return;
    const float* x = (const float*)d_in[0]; const float* mem = (const float*)d_in[1]; const float* mix_g = (const float*)d_in[2]; const float* w_in = (const float*)d_in[3];
    const float* conv_w = (const float*)d_in[4]; const float* w_conv_out = (const float*)d_in[5]; const float* w_ret_out = (const float*)d_in[6]; const float* w_mix_out = (const float*)d_in[7];
    const float* xa_g = (const float*)d_in[8]; const float* mem_g = (const float*)d_in[9]; const float* w_xa_q = (const float*)d_in[10]; const float* w_xa_kv = (const float*)d_in[11];
    const float* w_xa_o = (const float*)d_in[12]; const float* moe_g = (const float*)d_in[13]; const float* w_group = (const float*)d_in[14]; const float* b_group = (const float*)d_in[15];
    const float* w_router = (const float*)d_in[16]; const float* b_router = (const float*)d_in[17]; const float* w_gate = (const float*)d_in[18]; const float* w_up = (const float*)d_in[19];
    const float* w_down = (const float*)d_in[20]; const float* final_g = (const float*)d_in[21];
    char* ws = (char*)d_ws; float* H = (float*)d_out;
    unsigned* ctl = (unsigned*)(ws + WS_CTL); float2* rope = (float2*)(ws + WS_ROPE);
    bf16 *wcat = (bf16*)(ws + WS_WCAT), *wmix = (bf16*)(ws + WS_WMIX), *wq = (bf16*)(ws + WS_WQ), *wkv = (bf16*)(ws + WS_WKV), *wo = (bf16*)(ws + WS_WO), *wrt = (bf16*)(ws + WS_WRT);
    float *ssq1 = (float*)(ws + WS_SSQ1), *ssq2 = (float*)(ws + WS_SSQ2), *rs2 = (float*)(ws + WS_RS2), *lw = (float*)(ws + WS_LW), *rw = (float*)(ws + WS_RW), *rrs = (float*)(ws + WS_RRS);
    int *lid = (int*)(ws + WS_LID), *rid = (int*)(ws + WS_RID);
    bf16 *mn = (bf16*)(ws + WS_MN), *kvm = (bf16*)(ws + WS_KVM), *win = (bf16*)(ws + WS_WIN), *hid = (bf16*)(ws + WS_HID), *xn = (bf16*)(ws + WS_XN), *proj = (bf16*)(ws + WS_PROJ);
    bf16 *egu = (bf16*)(ws + WS_EGU), *ed = (bf16*)(ws + WS_ED), *xs = (bf16*)(ws + WS_XS), *hb = (bf16*)(ws + WS_HB);
    unsigned* cnt = ctl + CW_CNT;
    (void)hipMemsetAsync(ws + WS_CTL, 0, 1 * MiB, stream);
    ArgsK ak{}; for (int i = 0; i < 22; ++i) ak.a.in[i] = (const float*)d_in[i]; ak.a.out = H; ak.a.ws = (unsigned char*)d_ws;
    int nli = 0;
#if defined(PROBE_SPLIT)
    {   const int cuts[4][2] = {{0, PROBE_SPLIT + 1}, {PROBE_SPLIT, PROBE_SPLIT + 1}, {PROBE_SPLIT, PROBE_SPLIT + 1}, {PROBE_SPLIT + 1, NPH}};
        for (int i = 0; i < 4; ++i) { ak.a.ph_lo = cuts[i][0]; ak.a.ph_hi = cuts[i][1]; ak.li = nli++; ak.pad = 0; hipLaunchKernelGGL(mega, dim3(grid), dim3(NTHR), LDS_BYTES, stream, ak); }
        return; }
#endif
    for (int p = 0; p < NPH; ) {
        if (USE_MEGA[p]) { int q = p; while (q < NPH && USE_MEGA[q]) ++q;
#if !defined(MEGA_FUSE)
            q = p + 1;
#endif
            ak.a.ph_lo = p; ak.a.ph_hi = q; ak.li = nli++; ak.pad = 0;
            hipLaunchKernelGGL(mega, dim3(grid), dim3(NTHR), LDS_BYTES, stream, ak);
            p = q; continue; }
        switch (p) {
        case 0:
            k_transpose<<<dim3(PROJ_LD / 64, 16, 1), 256, 0, stream>>>(w_in, DM, PROJ_LD, win, DM, 0, nullptr, 1, 0, 0);
            k_transpose<<<dim3(16, 8, 1), 256, 0, stream>>>(w_conv_out, 512, DM, wcat, 1536, 0, nullptr, 0, 0, 0);
            k_transpose<<<dim3(16, 16, 1), 256, 0, stream>>>(w_ret_out, DM, DM, wcat, 1536, 512, nullptr, 0, 0, 0);
            k_transpose<<<dim3(16, 16, 1), 256, 0, stream>>>(w_mix_out, DM, DM, wmix, DM, 0, nullptr, 0, 0, 0);
            k_transpose<<<dim3(16, 16, 1), 256, 0, stream>>>(w_xa_q, DM, DM, wq, DM, 0, xa_g, 0, 0, 0);
            k_transpose<<<dim3(32, 16, 1), 256, 0, stream>>>(w_xa_kv, DM, 2048, wkv, DM, 0, nullptr, 0, 0, 0);
            k_transpose<<<dim3(16, 16, 1), 256, 0, stream>>>(w_xa_o, DM, DM, wo, DM, 0, nullptr, 0, 0, 0);
            k_zero_bf16<<<(48 * DM + 255) / 256, 256, 0, stream>>>(wrt, 48 * DM);
            k_transpose<<<dim3(1, 16, 1), 256, 0, stream>>>(w_group, DM, 4, wrt, DM, 0, moe_g, 0, 0, 0);
            k_transpose<<<dim3(1, 16, 1), 256, 0, stream>>>(w_router, DM, 32, wrt + 4 * DM, DM, 0, moe_g, 0, 0, 0);
            k_rmsnorm_bf16<<<T, 256, 0, stream>>>(x, mix_g, xn);
            k_rmsnorm_bf16<<<NB * MEML, 256, 0, stream>>>(mem, mem_g, mn);
            k_rope<<<SEQ * 32 / 256, 256, 0, stream>>>(rope);
            break;
        case 1:
            { P_inproj pp{DM, 0, xn, win, proj, rope}; k_ngemm<<<dim3(PROJ_LD / 64, T / 64), 256, 0, stream>>>(pp); }
            { P_plain pp{DM, 0, mn, wkv, kvm, DM, DM, 2048, 0}; k_ngemm<<<dim3(2048 / 64, NB * MEML / 64), 256, 0, stream>>>(pp); }
            break;
        case 2: k_conv<<<2 * (T / 16), 256, 0, stream>>>(proj, conv_w); break;
        case 3: k_ret_scan<<<NB * RH, 256, 0, stream>>>(proj, H); k_ret_gn<<<T, 256, 0, stream>>>(proj, H); break;
        case 4: { P_merge pp{512, 1024, proj, wcat, xn}; k_ngemm<<<dim3(DM / 64, T / 64), 256, 0, stream>>>(pp); } break;
        case 5: { P_resid pp{DM, 0, xn, wmix, x, H, hb}; k_ngemm<<<dim3(DM / 64, T / 64), 256, 0, stream>>>(pp); } k_rowssq<<<T, 256, 0, stream>>>(H, ssq1); break;
        case 6: { P_q pp{DM, 0, hb, wq, ssq1, xn}; k_ngemm<<<dim3(DM / 64, T / 64), 256, 0, stream>>>(pp); } break;
        case 7: k_xattn<<<T * XH, 256, 0, stream>>>(xn, kvm); break;
        case 8: { P_resid pp{DM, 0, xn, wo, H, H, hb}; k_ngemm<<<dim3(DM / 64, T / 64), 256, 0, stream>>>(pp); } k_rowssq<<<T, 256, 0, stream>>>(H, ssq2); break;
        case 9:
            k_transpose<<<dim3(8, 16, NE), 256, 0, stream>>>(w_gate, DM, EH, egu, DM, 0, moe_g, 2, (size_t)DM * EH, (size_t)1024 * DM);
            k_transpose<<<dim3(8, 16, NE), 256, 0, stream>>>(w_up, DM, EH, egu, DM, 0, moe_g, 3, (size_t)DM * EH, (size_t)1024 * DM);
            k_transpose<<<dim3(16, 8, NE), 256, 0, stream>>>(w_down, EH, DM, ed, EH, 0, nullptr, 0, (size_t)EH * DM, (size_t)1024 * EH);
            k_route<<<T / 64, 64, 0, stream>>>(hb, wrt, ssq2, b_group, b_router, rs2, cnt, lid, lw);
            break;
        case 10: k_gather<<<XS_ROWS, 256, 0, stream>>>(hb, cnt, lid, lw, rs2, xs, rid, rw, rrs); break;
        case 11: { P_gu pp{DM, DM, xs, egu, cnt, rrs, hid}; k_ngemm<<<dim3(EH / 64, XS_ROWS / 64), 256, 0, stream>>>(pp); } break;
        case 12: { P_down pp{EH, 0, hid, ed, cnt, rid, rw, xs}; k_ngemm<<<dim3(DM / 64, XS_ROWS / 64), 256, 0, stream>>>(pp); } break;
        case 13: k_final<<<T, 256, 0, stream>>>(H, xs, final_g); break;
        }
        ++p;
    }
}
```

```cpp
#include <hip/hip_runtime.h>
#include <cstdio>
#include <cstdint>

typedef unsigned short bf16;
#define DEVI __device__ __forceinline__

constexpr int DM = 1024, NB = 4, SEQ = 4096, T = NB * SEQ;
constexpr int PROJ_LD = 6656;
constexpr int C_XIN = 0, C_BG = 512, C_CG = 1024, C_Q = 1536, C_K = 2048, C_V = 2560, C_G = 3584, C_GC = 4608, C_GR = 5632;
constexpr int RH = 8, RDK = 64, RDV = 128, RCH = 128;
constexpr int MEML = 256, XH = 4, XHD = 256;
constexpr int NE = 32, EH = 512;
constexpr int XS_ROWS = 40960;
constexpr float EPS = 1e-6f;
constexpr float QSCALE = 0.0625f * 1.4426950408889634f;

constexpr size_t MiB = 1u << 20;
constexpr size_t WS_CTL = 0;
constexpr size_t WS_ROPE = 1 * MiB;
constexpr size_t WS_WCAT = 2 * MiB;
constexpr size_t WS_WMIX = 5 * MiB;
constexpr size_t WS_WQ = 7 * MiB;
constexpr size_t WS_WKV = 9 * MiB;
constexpr size_t WS_WO = 13 * MiB;
constexpr size_t WS_WRT = 15 * MiB;
constexpr size_t WS_SSQ1 = 16 * MiB;
constexpr size_t WS_SSQ2 = 17 * MiB;
constexpr size_t WS_RS2 = 18 * MiB;
constexpr size_t WS_LID = 19 * MiB;
constexpr size_t WS_LW = 21 * MiB;
constexpr size_t WS_LRS = 291 * MiB;
constexpr size_t WS_RID = 23 * MiB;
constexpr size_t WS_RW = WS_RID + 256 * 1024;
constexpr size_t WS_RRS = WS_RW + 256 * 1024;
constexpr size_t WS_MN = 24 * MiB;
constexpr size_t WS_KVM = 26 * MiB;
constexpr size_t WS_E = 30 * MiB;
constexpr size_t WS_WIN = 38 * MiB;
constexpr size_t WS_HID = 38 * MiB;
constexpr size_t WS_XN = 51 * MiB;
constexpr size_t WS_PROJ = 83 * MiB;
constexpr size_t WS_EGU = 83 * MiB;
constexpr size_t WS_ED = 147 * MiB;
constexpr size_t WS_XS = 179 * MiB;
constexpr size_t WS_HB = 259 * MiB;
constexpr size_t WS_END = 293 * MiB;
constexpr int CW_CNT = 1024, CNT_STRIDE = 32;

DEVI float bf2f(bf16 v) { return __uint_as_float((unsigned)v << 16); }
DEVI bf16 f2bf(float f) { unsigned u = __float_as_uint(f); return (bf16)((u + 0x7fffu + ((u >> 16) & 1u)) >> 16); }
DEVI float sigmoidf_(float x) { return 1.f / (1.f + __expf(-x)); }

__constant__ double c_invfreq[32] = {
    1.0, 0.7498942093324559, 0.5623413251903491, 0.4216965034285822, 0.31622776601683794, 0.23713737056616552,
    0.1778279410038923, 0.1333521432163324, 0.1, 0.07498942093324558, 0.05623413251903491, 0.04216965034285822,
    0.03162277660168379, 0.023713737056616554, 0.01778279410038923, 0.01333521432163324, 0.01, 0.007498942093324558,
    0.005623413251903491, 0.004216965034285823, 0.0031622776601683794, 0.0023713737056616554, 0.0017782794100389228,
    0.001333521432163324, 0.001, 0.0007498942093324559, 0.0005623413251903491, 0.0004216965034285823,
    0.00031622776601683794, 0.00023713737056616554, 0.00017782794100389227, 0.0001333521432163324};

__global__ void k_transpose(const float* __restrict__ W, int K, int N, bf16* WT, int ldwt, int koff, const float* __restrict__ kscale, int mode, size_t wstride, size_t wtstride) {
    W += (size_t)blockIdx.z * wstride; WT += (size_t)blockIdx.z * wtstride;
    const int n = blockIdx.x * 64 + (threadIdx.x & 63), k0 = blockIdx.y * 64 + (threadIdx.x >> 6) * 16;
    if (n >= N) return;
    int r = n;
    if (mode == 1) { if (n >= C_Q && n < C_V) { const int o = n & 63; r = (n & ~63) + 2 * (o & 31) + (o >> 5); } }
    else if (mode == 2) r = (n >> 7) * 256 + (n & 127);
    else if (mode == 3) r = (n >> 7) * 256 + 128 + (n & 127);
    for (int k = k0; k < k0 + 16 && k < K; ++k) {
        float v = W[(size_t)k * N + n]; if (kscale) v *= kscale[k];
        WT[(size_t)r * ldwt + koff + k] = f2bf(v);
    }
}
__global__ void k_zero_bf16(bf16* p, size_t n) { size_t i = (size_t)blockIdx.x * 256 + threadIdx.x; if (i < n) p[i] = 0; }

__global__ void k_rmsnorm_bf16(const float* __restrict__ x, const float* __restrict__ g, bf16* out) {
    const int row = blockIdx.x, t = threadIdx.x;
    const float4 v = ((const float4*)(x + (size_t)row * DM))[t];
    float s = v.x * v.x + v.y * v.y + v.z * v.z + v.w * v.w;
    __shared__ float red[4];
    for (int o = 32; o; o >>= 1) s += __shfl_xor(s, o);
    if ((t & 63) == 0) red[t >> 6] = s;
    __syncthreads();
    const float rstd = rsqrtf((red[0] + red[1] + red[2] + red[3]) * (1.f / DM) + EPS);
    const float4 gg = ((const float4*)g)[t];
    bf16* o = out + (size_t)row * DM + 4 * t;
    o[0] = f2bf(v.x * rstd * gg.x); o[1] = f2bf(v.y * rstd * gg.y); o[2] = f2bf(v.z * rstd * gg.z); o[3] = f2bf(v.w * rstd * gg.w);
}
__global__ void k_rope(float2* tab) {
    const int i = blockIdx.x * 256 + threadIdx.x; if (i >= SEQ * 32) return;
    const int pos = i >> 5, p = i & 31;
    const float ang = (float)pos * (float)c_invfreq[p];
    const double rev = (double)ang * 0.15915494309189535;
    const float fr = (float)(rev - floor(rev));
    tab[i] = make_float2(__builtin_amdgcn_cosf(fr), __builtin_amdgcn_sinf(fr));
}

template <class P> __global__ void __launch_bounds__(256) k_ngemm(P p) {
    __shared__ float As[16][65], Bs[16][65];
    const int mt = blockIdx.y; if (!p.valid(mt)) return;
    const int m0 = mt * 64, n0 = blockIdx.x * 64, tx = threadIdx.x & 15, ty = threadIdx.x >> 4;
    float a1[4][4] = {}, a2[4][4] = {};
    const int lr = threadIdx.x >> 2, lk = (threadIdx.x & 3) * 4;
    for (int seg = 0; seg < 2; ++seg) {
        const int Ks = seg ? p.K2 : p.K1; if (!Ks) continue;
        const bf16* ap = p.a_ptr(seg, m0 + lr); const bf16* bp = p.b_ptr(seg, mt, n0 + lr);
        for (int k0 = 0; k0 < Ks; k0 += 16) {
            const ushort4 av = *(const ushort4*)(ap + k0 + lk), bv = *(const ushort4*)(bp + k0 + lk);
            As[lk + 0][lr] = bf2f(av.x); As[lk + 1][lr] = bf2f(av.y); As[lk + 2][lr] = bf2f(av.z); As[lk + 3][lr] = bf2f(av.w);
            Bs[lk + 0][lr] = bf2f(bv.x); Bs[lk + 1][lr] = bf2f(bv.y); Bs[lk + 2][lr] = bf2f(bv.z); Bs[lk + 3][lr] = bf2f(bv.w);
            __syncthreads();
#pragma unroll
            for (int k = 0; k < 16; ++k) {
                float a[4], b[4];
#pragma unroll
                for (int i = 0; i < 4; ++i) { a[i] = As[k][ty * 4 + i]; b[i] = Bs[k][tx * 4 + i]; }
#pragma unroll
                for (int i = 0; i < 4; ++i)
#pragma unroll
                    for (int j = 0; j < 4; ++j) { if (seg) a2[i][j] += a[i] * b[j]; else a1[i][j] += a[i] * b[j]; }
            }
            __syncthreads();
        }
    }
#pragma unroll
    for (int i = 0; i < 4; ++i) p.epi(m0 + ty * 4 + i, n0 + tx * 4, a1[i], a2[i]);
}

struct P_inproj {
    int K1, K2; const bf16* xn; const bf16* win; bf16* proj; const float2* rope;
    DEVI const bf16* a_ptr(int, int m) const { return xn + (size_t)m * DM; }
    DEVI const bf16* b_ptr(int, int, int n) const { return win + (size_t)n * DM; }
    DEVI bool valid(int) const { return true; }
    DEVI void epi(int m, int n0, const float* a, const float*) const {
        float v[4] = {a[0], a[1], a[2], a[3]};
        if (n0 >= C_Q && n0 < C_V) {
            const int pos = m & (SEQ - 1), p0 = (n0 & 63) >> 1; const float sc = n0 >= C_K ? 0.125f : 1.f;
#pragma unroll
            for (int j = 0; j < 2; ++j) { const float2 cs = rope[pos * 32 + p0 + j]; const float t1 = v[2 * j], t2 = v[2 * j + 1];
                v[2 * j] = (t1 * cs.x - t2 * cs.y) * sc; v[2 * j + 1] = (t1 * cs.y + t2 * cs.x) * sc; }
        }
        bf16* o = proj + (size_t)m * PROJ_LD + n0;
#pragma unroll
        for (int j = 0; j < 4; ++j) o[j] = f2bf(v[j]);
    }
};
struct P_plain {
    int K1, K2; const bf16* A; const bf16* Bt; bf16* C; int lda, ldb, ldc, pad;
    DEVI const bf16* a_ptr(int, int m) const { return A + (size_t)m * lda; }
    DEVI const bf16* b_ptr(int, int, int n) const { return Bt + (size_t)n * ldb; }
    DEVI bool valid(int) const { return true; }
    DEVI void epi(int m, int n0, const float* a, const float*) const { bf16* o = C + (size_t)m * ldc + n0;
#pragma unroll
        for (int j = 0; j < 4; ++j) o[j] = f2bf(a[j]); }
};
__global__ void k_conv(bf16* proj, const float* __restrict__ cw) {
    const int c = threadIdx.x + (blockIdx.x & 1) * 256, t0 = (blockIdx.x >> 1) * 16, tb = t0 & ~(SEQ - 1);
    const float w0 = cw[c], w1 = cw[512 + c], w2 = cw[1024 + c];
    float u1 = 0.f, u2 = 0.f;
    for (int t = t0 - 2; t < t0 + 16; ++t) {
        float u = 0.f;
        if (t >= tb) { const bf16* r = proj + (size_t)t * PROJ_LD; u = bf2f(r[C_CG + c]) * bf2f(r[C_XIN + c]); }
        if (t >= t0) { bf16* r = proj + (size_t)t * PROJ_LD; r[C_BG + c] = f2bf(bf2f(r[C_BG + c]) * (w0 * u2 + w1 * u1 + w2 * u)); }
        u2 = u1; u1 = u;
    }
}
__global__ void __launch_bounds__(256) k_ret_scan(const bf16* __restrict__ proj, float* OT) {
    const int b = blockIdx.x >> 3, h = blockIdx.x & 7, tid = threadIdx.x, dv = tid & 127, dh = tid >> 7;
    const float gamma = 1.f - exp2f(-5.f - (float)h);
    float st[32];
#pragma unroll
    for (int i = 0; i < 32; ++i) st[i] = 0.f;
    __shared__ float qs[64], ks[64], part[128];
    for (int t = 0; t < SEQ; ++t) {
        const bf16* r = proj + (size_t)(b * SEQ + t) * PROJ_LD;
        if (tid < 64) qs[tid] = bf2f(r[C_Q + h * 64 + tid]); else if (tid < 128) ks[tid - 64] = bf2f(r[C_K + h * 64 + tid - 64]);
        const float v = bf2f(r[C_V + h * 128 + dv]);
        __syncthreads();
        float o = 0.f;
#pragma unroll
        for (int i = 0; i < 32; ++i) { st[i] = gamma * st[i] + ks[dh * 32 + i] * v; o += qs[dh * 32 + i] * st[i]; }
        if (dh) part[dv] = o;
        __syncthreads();
        if (!dh) OT[(size_t)(b * SEQ + t) * DM + h * 128 + dv] = o + part[dv];
    }
}
__global__ void k_ret_gn(bf16* proj, const float* __restrict__ OT) {
    const int row = blockIdx.x, tid = threadIdx.x;
    const float4 v = ((const float4*)(OT + (size_t)row * DM))[tid];
    float s = v.x + v.y + v.z + v.w;
    for (int o = 16; o; o >>= 1) s += __shfl_xor(s, o);
    const float mu = s * (1.f / 128.f);
    const float d0 = v.x - mu, d1 = v.y - mu, d2 = v.z - mu, d3 = v.w - mu;
    float q = d0 * d0 + d1 * d1 + d2 * d2 + d3 * d3;
    for (int o = 16; o; o >>= 1) q += __shfl_xor(q, o);
    const float rs = rsqrtf(q * (1.f / 128.f) + EPS);
    bf16* g = proj + (size_t)row * PROJ_LD + C_G + 4 * tid;
    const float dd[4] = {d0, d1, d2, d3};
#pragma unroll
    for (int j = 0; j < 4; ++j) { const float gv = bf2f(g[j]); g[j] = f2bf(gv * sigmoidf_(gv) * dd[j] * rs); }
}
struct P_merge {
    int K1, K2; const bf16* proj; const bf16* wcat; bf16* mrg;
    DEVI const bf16* a_ptr(int seg, int m) const { return proj + (size_t)m * PROJ_LD + (seg ? C_G : C_BG); }
    DEVI const bf16* b_ptr(int seg, int, int n) const { return wcat + (size_t)n * 1536 + (seg ? 512 : 0); }
    DEVI bool valid(int) const { return true; }
    DEVI void epi(int m, int n0, const float* a1, const float* a2) const {
        const bf16* r = proj + (size_t)m * PROJ_LD; bf16* o = mrg + (size_t)m * DM + n0;
#pragma unroll
        for (int j = 0; j < 4; ++j) o[j] = f2bf(sigmoidf_(bf2f(r[C_GC + n0 + j])) * a1[j] + sigmoidf_(bf2f(r[C_GR + n0 + j])) * a2[j]);
    }
};
struct P_resid {
    int K1, K2; const bf16* A; const bf16* Bt; const float* base; float* H; bf16* HB;
    DEVI const bf16* a_ptr(int, int m) const { return A + (size_t)m * DM; }
    DEVI const bf16* b_ptr(int, int, int n) const { return Bt + (size_t)n * DM; }
    DEVI bool valid(int) const { return true; }
    DEVI void epi(int m, int n0, const float* a, const float*) const {
        const size_t off = (size_t)m * DM + n0;
#pragma unroll
        for (int j = 0; j < 4; ++j) { const float v = base[off + j] + a[j]; H[off + j] = v; HB[off + j] = f2bf(v); }
    }
};
__global__ void k_rowssq(const float* __restrict__ H, float* ssq) {
    const int row = blockIdx.x, t = threadIdx.x;
    const float4 v = ((const float4*)(H + (size_t)row * DM))[t];
    float s = v.x * v.x + v.y * v.y + v.z * v.z + v.w * v.w;
    __shared__ float red[4];
    for (int o = 32; o; o >>= 1) s += __shfl_xor(s, o);
    if ((t & 63) == 0) red[t >> 6] = s;
    __syncthreads();
    if (t < 16) ssq[(size_t)row * 16 + t] = t ? 0.f : red[0] + red[1] + red[2] + red[3];
}
DEVI float rstd_from_ssq(const float* ssq, int row) {
    const float4* p = (const float4*)(ssq + (size_t)row * 16); float s = 0.f;
#pragma unroll
    for (int i = 0; i < 4; ++i) { const float4 v = p[i]; s += (v.x + v.y) + (v.z + v.w); }
    return rsqrtf(s * (1.f / DM) + EPS);
}
struct P_q {
    int K1, K2; const bf16* A; const bf16* Bt; const float* ssq; bf16* Q;
    DEVI const bf16* a_ptr(int, int m) const { return A + (size_t)m * DM; }
    DEVI const bf16* b_ptr(int, int, int n) const { return Bt + (size_t)n * DM; }
    DEVI bool valid(int) const { return true; }
    DEVI void epi(int m, int n0, const float* a, const float*) const { const float s = rstd_from_ssq(ssq, m) * QSCALE; bf16* o = Q + (size_t)m * DM + n0;
#pragma unroll
        for (int j = 0; j < 4; ++j) o[j] = f2bf(a[j] * s); }
};
__global__ void __launch_bounds__(256) k_xattn(bf16* Q, const bf16* __restrict__ kvm) {
    const int tok = blockIdx.x >> 2, h = blockIdx.x & 3, b = tok >> 12, j = threadIdx.x;
    __shared__ float qs[256], ps[256], red[8];
    bf16* qrow = Q + (size_t)tok * DM + h * XHD;
    qs[j] = bf2f(qrow[j]);
    __syncthreads();
    const bf16* kr = kvm + (size_t)(b * MEML + j) * 2048 + h * XHD;
    float s = 0.f;
    for (int d = 0; d < XHD; d += 4) { const ushort4 kv = *(const ushort4*)(kr + d); s += qs[d] * bf2f(kv.x) + qs[d + 1] * bf2f(kv.y) + qs[d + 2] * bf2f(kv.z) + qs[d + 3] * bf2f(kv.w); }
    float mx = s;
    for (int o = 32; o; o >>= 1) mx = fmaxf(mx, __shfl_xor(mx, o));
    if ((j & 63) == 0) red[j >> 6] = mx;
    __syncthreads();
    mx = fmaxf(fmaxf(red[0], red[1]), fmaxf(red[2], red[3]));
    const float p = exp2f(s - mx);
    ps[j] = p;
    float sm = p;
    for (int o = 32; o; o >>= 1) sm += __shfl_xor(sm, o);
    if ((j & 63) == 0) red[4 + (j >> 6)] = sm;
    __syncthreads();
    sm = red[4] + red[5] + red[6] + red[7];
    float o = 0.f;
    const bf16* vb = kvm + (size_t)(b * MEML) * 2048 + 1024 + h * XHD + j;
    for (int m = 0; m < MEML; ++m) o += ps[m] * bf2f(vb[(size_t)m * 2048]);
    qrow[j] = f2bf(o / sm);
}
DEVI float dot1024(const bf16* a, const bf16* w) {
    float s = 0.f;
    for (int k = 0; k < DM; k += 4) { const ushort4 av = *(const ushort4*)(a + k), wv = *(const ushort4*)(w + k); s += bf2f(av.x) * bf2f(wv.x) + bf2f(av.y) * bf2f(wv.y) + bf2f(av.z) * bf2f(wv.z) + bf2f(av.w) * bf2f(wv.w); }
    return s;
}
__global__ void k_route(const bf16* __restrict__ HB, const bf16* __restrict__ wrt, const float* __restrict__ ssq, const float* __restrict__ bg, const float* __restrict__ br,
                        float* rs2, unsigned* cnt, int* lid, float* lw) {
    const int tok = blockIdx.x * 64 + threadIdx.x;
    const float rs = rstd_from_ssq(ssq, tok); rs2[tok] = rs;
    const bf16* a = HB + (size_t)tok * DM;
    int gi = 0; float gm = -3.0e38f, gs = 0.f;
    {   float l4[4];
#pragma unroll
        for (int n = 0; n < 4; ++n) l4[n] = dot1024(a, wrt + (size_t)n * DM) * rs + bg[n];
#pragma unroll
        for (int n = 0; n < 4; ++n) if (l4[n] > gm) { gm = l4[n]; gi = n; }
#pragma unroll
        for (int n = 0; n < 4; ++n) gs += __expf(l4[n] - gm);
    }
    const float pg = 1.f / gs;
    float le[8];
#pragma unroll
    for (int n = 0; n < 8; ++n) le[n] = dot1024(a, wrt + (size_t)(4 + gi * 8 + n) * DM) * rs + br[gi * 8 + n];
    int e1 = 0; float m1 = -3.0e38f;
#pragma unroll
    for (int n = 0; n < 8; ++n) if (le[n] > m1) { m1 = le[n]; e1 = n; }
    int e2 = 0; float m2 = -3.0e38f;
#pragma unroll
    for (int n = 0; n < 8; ++n) if (n != e1 && le[n] > m2) { m2 = le[n]; e2 = n; }
    const float x2 = __expf(m2 - m1), w1 = pg / (1.f + x2), w2 = pg * x2 / (1.f + x2);
    const int E1 = gi * 8 + e1, E2 = gi * 8 + e2;
    const unsigned p1 = atomicAdd(&cnt[E1 * CNT_STRIDE], 1u), p2 = atomicAdd(&cnt[E2 * CNT_STRIDE], 1u);
    lid[E1 * 16384 + p1] = tok * 2; lw[E1 * 16384 + p1] = w1;
    lid[E2 * 16384 + p2] = tok * 2 + 1; lw[E2 * 16384 + p2] = w2;
}
DEVI int tile_expert(const unsigned* cnt, int tile, int& first_tile) {
    int ts = 0;
    for (int e = 0; e < NE; ++e) { const int nt = ((int)cnt[e * CNT_STRIDE] + 255) >> 8; if (tile < ts + nt) { first_tile = ts; return e; } ts += nt; }
    first_tile = ts; return -1;
}
__global__ void k_gather(const bf16* __restrict__ HB, const unsigned* __restrict__ cnt, const int* __restrict__ lid, const float* __restrict__ lw, const float* __restrict__ rs2,
                         bf16* XS, int* rid, float* rw, float* rrs) {
    const int row = blockIdx.x; int ft; const int e = tile_expert(cnt, row >> 8, ft);
    if (e < 0) return;
    const int pos = row - ft * 256; const bool real = pos < (int)cnt[e * CNT_STRIDE];
    const int id = real ? lid[e * 16384 + pos] : -1; const int tok = real ? (id >> 1) : 0;
    if (threadIdx.x == 0) { rid[row] = id; rw[row] = real ? lw[e * 16384 + pos] : 0.f; rrs[row] = rs2[tok]; }
    ((uint2*)(XS + (size_t)row * DM))[threadIdx.x] = ((const uint2*)(HB + (size_t)tok * DM))[threadIdx.x];
}
struct P_gu {
    int K1, K2; const bf16* XS; const bf16* egu; const unsigned* cnt; const float* rrs; bf16* HID;
    DEVI const bf16* a_ptr(int, int m) const { return XS + (size_t)m * DM; }
    DEVI const bf16* b_ptr(int seg, int mt, int n) const { int ft; const int e = tile_expert(cnt, mt >> 2, ft); return egu + ((size_t)e * 1024 + (n >> 7) * 256 + seg * 128 + (n & 127)) * DM; }
    DEVI bool valid(int mt) const { int ft; return tile_expert(cnt, mt >> 2, ft) >= 0; }
    DEVI void epi(int m, int n0, const float* a1, const float* a2) const { const float rs = rrs[m]; bf16* o = HID + (size_t)m * EH + n0;
#pragma unroll
        for (int j = 0; j < 4; ++j) { const float g = a1[j] * rs, u = a2[j] * rs; o[j] = f2bf(g * sigmoidf_(g) * u); } }
};
struct P_down {
    int K1, K2; const bf16* HID; const bf16* ed; const unsigned* cnt; const int* rid; const float* rw; bf16* YB;
    DEVI const bf16* a_ptr(int, int m) const { return HID + (size_t)m * EH; }
    DEVI const bf16* b_ptr(int, int mt, int n) const { int ft; const int e = tile_expert(cnt, mt >> 2, ft); return ed + ((size_t)e * 1024 + n) * EH; }
    DEVI bool valid(int mt) const { int ft; return tile_expert(cnt, mt >> 2, ft) >= 0; }
    DEVI void epi(int m, int n0, const float* a, const float*) const { const int id = rid[m]; if (id < 0) return; const float w = rw[m]; bf16* o = YB + (size_t)id * DM + n0;
#pragma unroll
        for (int j = 0; j < 4; ++j) o[j] = f2bf(a[j] * w); }
};
__global__ void k_final(float* H, const bf16* __restrict__ YB, const float* __restrict__ g) {
    const int row = blockIdx.x, t = threadIdx.x;
    float4 v = ((const float4*)(H + (size_t)row * DM))[t];
    const ushort4 y0 = ((const ushort4*)(YB + (size_t)(2 * row) * DM))[t], y1 = ((const ushort4*)(YB + (size_t)(2 * row + 1) * DM))[t];
    v.x += bf2f(y0.x) + bf2f(y1.x); v.y += bf2f(y0.y) + bf2f(y1.y); v.z += bf2f(y0.z) + bf2f(y1.z); v.w += bf2f(y0.w) + bf2f(y1.w);
    float s = v.x * v.x + v.y * v.y + v.z * v.z + v.w * v.w;
    __shared__ float red[4];
    for (int o = 32; o; o >>= 1) s += __shfl_xor(s, o);
    if ((t & 63) == 0) red[t >> 6] = s;
    __syncthreads();
    const float rstd = rsqrtf((red[0] + red[1] + red[2] + red[3]) * (1.f / DM) + EPS);
    const float4 gg = ((const float4*)g)[t];
    ((float4*)(H + (size_t)row * DM))[t] = make_float4(v.x * rstd * gg.x, v.y * rstd * gg.y, v.z * rstd * gg.z, v.w * rstd * gg.w);
}


#define LAS __attribute__((address_space(3)))
#define GAS __attribute__((address_space(1)))
typedef short bf16x8 __attribute__((ext_vector_type(8)));
typedef float f32x4 __attribute__((ext_vector_type(4)));
typedef float f32x2 __attribute__((ext_vector_type(2)));
typedef unsigned u32x4 __attribute__((ext_vector_type(4)));
typedef unsigned u32x2 __attribute__((ext_vector_type(2)));
typedef GAS unsigned gu32;
#define RLX_AGENT __ATOMIC_RELAXED, __HIP_MEMORY_SCOPE_AGENT
#define LDS_WAIT() asm volatile("s_waitcnt lgkmcnt(0)" ::: "memory")
#define VM_WAIT() asm volatile("s_waitcnt vmcnt(0)" ::: "memory")
constexpr int NWAVES = 8, NTHR = 512;
constexpr int RING_BYTES = 131072, LDSCTL_OFF = RING_BYTES, MISC_OFF = LDSCTL_OFF + 320, LDS_BYTES = 147456;
constexpr int CW_BAR = 4096;

#define XB_TMO      128
#define XB_XCNT(j)  (256  + 64 * (j))
#define XB_XSUB(j)  (1280 + 64 * (j))
#define XB_XGEN(j)  (2304 + 64 * (j))
#define XB_TOP      3328
#define XB_TOPGEN   3392
#define XCD_BAR_WORDS 3456
#define XB_SPIN_CAP (1u << 18)

__device__ __forceinline__ unsigned xb_ld(unsigned* p)              { return __hip_atomic_load(p, __ATOMIC_RELAXED, __HIP_MEMORY_SCOPE_AGENT); }
__device__ __forceinline__ unsigned xb_add(unsigned* p, unsigned v) { return __hip_atomic_fetch_add(p, v, __ATOMIC_RELAXED, __HIP_MEMORY_SCOPE_AGENT); }
__device__ __forceinline__ unsigned xb_xcc_id() { return (unsigned)__builtin_amdgcn_s_getreg((3 << 11) | 20) & 0xFu; }
#define XB_SPIN(cond, bar) do { unsigned _sp = 0; while (cond) { __builtin_amdgcn_s_sleep(1); \
    if ((++_sp & 255u) == 0u) { if (xb_ld(&(bar)[XB_TMO])) break; if (_sp > XB_SPIN_CAP) { atomicAdd(&(bar)[XB_TMO], 1u); break; } } } } while (0)

struct XcdBarrier {
    unsigned* bar; unsigned x;
    volatile LAS unsigned* st;
};

__device__ __forceinline__ XcdBarrier xcd_barrier_post(unsigned* bar, volatile LAS unsigned* st) {
    XcdBarrier b; b.bar = bar; b.x = xb_xcc_id(); b.st = st;
    if (threadIdx.x == 0) (void)xb_add(&bar[XB_XCNT(b.x)], 1u);
    return b;
}
__device__ __forceinline__ void xcd_barrier_complete(unsigned* bar, unsigned x, unsigned& nloc, unsigned& nx) {
    const unsigned G = gridDim.x * gridDim.y * gridDim.z;
    unsigned sum, cnt, mine, sp = 0u;
    for (;;) {
        sum = 0u; cnt = 0u; mine = 0u;
#pragma unroll
        for (unsigned j = 0; j < 16; ++j) { const unsigned c = xb_ld(&bar[XB_XCNT(j)]); sum += c; cnt += (c > 0u) ? 1u : 0u; mine = (j == x) ? c : mine; }
        if (sum == G) break;
        __builtin_amdgcn_s_sleep(1);
        if ((++sp & 255u) == 0u) { if (xb_ld(&bar[XB_TMO])) break; if (sp > XB_SPIN_CAP) { atomicAdd(&bar[XB_TMO], 1u); break; } }
    }
    nloc = mine > 0u ? mine : 1u; nx = cnt > 0u ? cnt : 1u;
}

__device__ __forceinline__ void xcd_barrier(const XcdBarrier& b) {
    asm volatile("s_waitcnt vmcnt(0)" ::: "memory");
    __syncthreads();
    if (threadIdx.x == 0) {
        unsigned* bar = b.bar;
        __builtin_amdgcn_s_waitcnt(0);
        unsigned nloc = b.st[0], nx = b.st[1];
        if (nloc == 0u) { xcd_barrier_complete(bar, b.x, nloc, nx); b.st[0] = nloc; b.st[1] = nx; }
        const unsigned old = xb_add(&bar[XB_XSUB(b.x)], 1u);
        const unsigned gen = old / nloc;
        if (old + 1u == (gen + 1u) * nloc) {
            __builtin_amdgcn_fence(__ATOMIC_RELEASE, "agent");
            asm volatile("s_waitcnt vmcnt(0)" ::: "memory");
            const unsigned og = xb_add(&bar[XB_TOP], 1u);
            const unsigned tg = og / nx;
            if (og + 1u == (tg + 1u) * nx) xb_add(&bar[XB_TOPGEN], 1u);
            else XB_SPIN(xb_ld(&bar[XB_TOPGEN]) == tg, bar);
            __builtin_amdgcn_fence(__ATOMIC_ACQUIRE, "agent");
            xb_add(&bar[XB_XGEN(b.x)], 1u);
            asm volatile("s_waitcnt vmcnt(0)" ::: "memory");
        } else {
            XB_SPIN(xb_ld(&bar[XB_XGEN(b.x)]) == gen, bar);
            __builtin_amdgcn_fence(__ATOMIC_ACQUIRE, "agent");
            asm volatile("s_waitcnt vmcnt(0)" ::: "memory");
        }
    }
    __syncthreads();
}


constexpr int BM = 256, BK = 64, HALF = 128, HTB = HALF * BK * 2, NXCD = 8, WGM = 8;
DEVI int lds_byte(int r, int c) { const int st = (r >> 4) * 2 + (c >> 5), rr = r & 15, cc = c & 31, ob = rr * 64 + cc * 2; return st * 1024 + (ob ^ (((ob >> 9) & 1) << 5)); }
DEVI void stage_rc(int b, int& R, int& C) { const int st = b / 1024, sb = b % 1024, swz = sb ^ (((sb >> 9) & 1) << 5); R = (st >> 1) * 16 + swz / 64; C = (st & 1) * 32 + (swz % 64) / 2; }
DEVI int perm32(int rho) { const int n = rho >> 4, i = rho & 15; return 8 * (i >> 2) + 4 * n + (i & 3); }
DEVI unsigned cvt_pk_bf16(float lo, float hi) { unsigned r; asm volatile("v_cvt_pk_bf16_f32 %0, %1, %2" : "=v"(r) : "v"(lo), "v"(hi)); return r; }
DEVI u32x4 pack8(const f32x4 a, const f32x4 b) { u32x4 w; w.x = cvt_pk_bf16(a[0], a[1]); w.y = cvt_pk_bf16(a[2], a[3]); w.z = cvt_pk_bf16(b[0], b[1]); w.w = cvt_pk_bf16(b[2], b[3]); return w; }
DEVI float bflo(unsigned w) { return __uint_as_float(w << 16); }
DEVI float bfhi(unsigned w) { return __uint_as_float(w & 0xffff0000u); }

DEVI unsigned launder(unsigned x) { asm volatile("" : "+v"(x)); return x; }
struct Unit { int pm, pn, e, lb, rem; };
DEVI bool tile_order(int L, int nM, int nN, int& pm, int& pn) {
    const int nwg = nM * nN; if (L >= nwg) return false;
    int wgid = L; { const int q = nwg / NXCD, r = nwg % NXCD, xcd = wgid % NXCD, off = wgid / NXCD; wgid = (xcd < r ? xcd * (q + 1) : r * (q + 1) + (xcd - r) * q) + off; }
    const int nig = WGM * nN, gid = wgid / nig, fm = gid * WGM, gsz = (nM - fm) < WGM ? (nM - fm) : WGM;
    pm = fm + ((wgid % nig) % gsz); pn = (wgid % nig) / gsz; return true;
}

template <class Epi, class Sched, int JT>
DEVI void gemm_phase(LAS unsigned char* lds, const Sched& S, const Epi& E, const int lda, const int ldb, const int nt, const int jumpA) {
    const int tid = threadIdx.x, wid = __builtin_amdgcn_readfirstlane(tid >> 6), lane = tid & 63, wr = wid >> 2, wc = wid & 3, fr = lane & 15, fq = lane >> 4;
    unsigned voffA[2], voffB[2];
#pragma unroll
    for (int i = 0; i < 2; ++i) { int R, C; stage_rc(tid * 16 + i * 8192, R, C); const int Rb = (R & ~31) + perm32(R & 31);
        voffA[i] = (unsigned)(R * lda + C) * 2u; voffB[i] = (unsigned)(Rb * ldb + C) * 2u; }
    const size_t kstep = (size_t)(BK * 2);
    const size_t hstepA = (size_t)HALF * lda * 2, hstepB = (size_t)HALF * ldb * 2;
    const unsigned ldsw = (unsigned)wid * 1024u;
    const int aoff = lds_byte(wr * 64 + fr, fq * 8), boff = lds_byte(wc * 32 + fr, fq * 8);
#define PG8_SA(b, h) (((b) * 2 + (h)) * HTB)
#define PG8_SB(b, h) ((4 + (b) * 2 + (h)) * HTB)
#define PG8_STAGE(bufoff, gbase, voff) do { _Pragma("unroll") for (int _i = 0; _i < 2; ++_i) \
        __builtin_amdgcn_global_load_lds((const unsigned*)((const char*)(gbase) + (voff)[_i]), (LAS unsigned*)(lds + (bufoff) + ldsw + _i * 8192), 16, 0, 0); } while (0)
#define PG8_LDA(dst, b, h) do { _Pragma("unroll") for (int m = 0; m < 4; ++m) _Pragma("unroll") for (int k = 0; k < 2; ++k) dst[m][k] = *(const LAS bf16x8*)(lds + PG8_SA(b, h) + aoff + m * 2048 + k * 1024); } while (0)
#define PG8_LDB(dst, b, h) do { _Pragma("unroll") for (int n = 0; n < 2; ++n) _Pragma("unroll") for (int k = 0; k < 2; ++k) dst[n][k] = *(const LAS bf16x8*)(lds + PG8_SB(b, h) + boff + n * 2048 + k * 1024); } while (0)
#define PG8_MMA(ai, bj, At, Bt) do { __builtin_amdgcn_s_setprio(1); _Pragma("unroll") for (int m = 0; m < 4; ++m) _Pragma("unroll") for (int n = 0; n < 2; ++n) _Pragma("unroll") for (int k = 0; k < 2; ++k) \
        acc[ai][bj][m][n] = __builtin_amdgcn_mfma_f32_16x16x32_bf16(Bt[n][k], At[m][k], acc[ai][bj][m][n], 0, 0, 0); __builtin_amdgcn_s_setprio(0); } while (0)
#define PG8_WAIT_V(n) asm volatile("s_waitcnt vmcnt(" #n ")" ::: "memory")
#define PG8_WAIT_L(n) asm volatile("s_waitcnt lgkmcnt(" #n ")" ::: "memory")
#define PG8_BAR __builtin_amdgcn_s_barrier()
#define PG8_SCHED __builtin_amdgcn_sched_barrier(0)
#define PG8_AK(t) ((size_t)(t) * kstep + ((JT > 0 && (t) >= JT) ? (size_t)jumpA : (size_t)0))
#define PG8_KBODY(t) do { \
            const bool last = (t == nt - 2); const bool ln_ = last && has_next; \
            const char* a1 = cA + PG8_AK(t + 1); \
            const char* a2 = last ? nA : cA + PG8_AK(t + 2); const char* b2 = last ? nB : cB + (size_t)(t + 2) * kstep; \
            const char* a3 = last ? nA + kstep : cA + PG8_AK(t + 3); const char* b3 = b2 + kstep; \
            PG8_LDB(B0, 0, 0); PG8_LDB(B1, 0, 1); PG8_SCHED; PG8_LDA(At, 0, 0); PG8_STAGE_A(PG8_SA(1, 1), a1, 1, false); \
            PG8_WAIT_V(8); PG8_WAIT_L(0); PG8_BAR; PG8_MMA(0, 0, At, B0); PG8_MMA(0, 1, At, B1); PG8_BAR; PG8_SCHED; \
            PG8_LDA(At, 0, 1); PG8_STAGE(PG8_SB(0, 0), b2, voffB); PG8_STAGE(PG8_SB(0, 1), b2 + hstepB, voffB); PG8_STAGE_A(PG8_SA(0, 0), a2, 0, ln_); \
            PG8_WAIT_V(8); PG8_WAIT_L(0); PG8_BAR; PG8_MMA(1, 0, At, B0); PG8_MMA(1, 1, At, B1); PG8_BAR; PG8_SCHED; \
            PG8_LDB(B0, 1, 0); PG8_LDB(B1, 1, 1); PG8_SCHED; PG8_LDA(At, 1, 0); PG8_STAGE_A(PG8_SA(0, 1), a2, 1, ln_); \
            PG8_WAIT_V(8); PG8_WAIT_L(0); PG8_BAR; PG8_MMA(0, 0, At, B0); PG8_MMA(0, 1, At, B1); PG8_BAR; PG8_SCHED; \
            PG8_LDA(At, 1, 1); PG8_STAGE(PG8_SB(1, 0), b3, voffB); PG8_STAGE(PG8_SB(1, 1), b3 + hstepB, voffB); PG8_STAGE_A(PG8_SA(1, 0), a3, 0, ln_); \
            PG8_WAIT_V(8); PG8_WAIT_L(0); PG8_BAR; PG8_MMA(1, 0, At, B0); PG8_MMA(1, 1, At, B1); PG8_BAR; PG8_SCHED; \
        } while (0)
    Unit cur, nxt; int ui = 0;
    if (!S.next(0, cur)) return;
    constexpr bool GATHER = Sched::GATHER;
    unsigned gvo[2][2], gnx[2][2];
#define PG8_GOFF(dst, u) do { _Pragma("unroll") for (int h_ = 0; h_ < 2; ++h_) _Pragma("unroll") for (int i_ = 0; i_ < 2; ++i_) { int R_, C_; stage_rc((int)launder((unsigned)tid) * 16 + i_ * 8192, R_, C_); dst[h_][i_] = S.gather_row(u, h_ * HALF + R_) * (unsigned)(lda * 2) + (unsigned)(C_ * 2); } } while (0)
#define PG8_STAGE2(bufoff, gbase, o0, o1) do { __builtin_amdgcn_global_load_lds((const unsigned*)((const char*)(gbase) + (o0)), (LAS unsigned*)(lds + (bufoff) + ldsw), 16, 0, 0); \
        __builtin_amdgcn_global_load_lds((const unsigned*)((const char*)(gbase) + (o1)), (LAS unsigned*)(lds + (bufoff) + ldsw + 8192), 16, 0, 0); } while (0)
#define PG8_STAGE_X(bufoff, gbase, voff) do { _Pragma("unroll") for (int _i = 0; _i < 2; ++_i) \
        __builtin_amdgcn_global_load_lds((const unsigned*)((const char*)(gbase) + (voff)[_i]), (LAS unsigned*)(lds + (bufoff) + ldsw + _i * 8192), 16, 0, Sched::A_AUX); } while (0)
#define PG8_STAGE_A(bufoff, gptr, half, usenext) do { if constexpr (GATHER) { const unsigned o0_ = (usenext) ? gnx[half][0] : gvo[half][0], o1_ = (usenext) ? gnx[half][1] : gvo[half][1]; PG8_STAGE2(bufoff, gptr, o0_, o1_); } \
        else { PG8_STAGE_X(bufoff, (gptr) + (half) * hstepA, voffA); } } while (0)
    if constexpr (GATHER) { PG8_GOFF(gvo, cur); }
    f32x4 acc[2][2][4][2];
#pragma unroll
    for (int a = 0; a < 2; ++a)
#pragma unroll
        for (int b = 0; b < 2; ++b)
#pragma unroll
            for (int m = 0; m < 4; ++m)
#pragma unroll
                for (int n = 0; n < 2; ++n) acc[a][b][m][n] = (f32x4){0.f, 0.f, 0.f, 0.f};
    bf16x8 At[4][2], B0[2][2], B1[2][2];
    const char* cA = S.abase(cur); const char* cB = S.bbase(cur);
    PG8_STAGE(PG8_SB(0, 0), cB, voffB); PG8_STAGE(PG8_SB(0, 1), cB + hstepB, voffB); PG8_STAGE_A(PG8_SA(0, 0), cA, 0, false); PG8_STAGE_A(PG8_SA(0, 1), cA, 1, false);
    if (wr == 1) PG8_BAR;
    PG8_WAIT_V(2); PG8_BAR;
    PG8_STAGE(PG8_SB(1, 0), cB + kstep, voffB); PG8_STAGE_A(PG8_SA(1, 0), cA + kstep, 0, false); PG8_STAGE(PG8_SB(1, 1), cB + hstepB + kstep, voffB);
    PG8_WAIT_V(6); PG8_BAR;
    for (;;) {
        const bool has_next = S.next(ui + 1, nxt);
        const char* nA = has_next ? S.abase(nxt) : cA; const char* nB = has_next ? S.bbase(nxt) : cB;
        if constexpr (GATHER) { if (has_next) PG8_GOFF(gnx, nxt); }
        if constexpr (JT > 0) {
            for (int t = 0; t < JT; t += 2) PG8_KBODY(t);
            E.mid(acc, cur, wr, wc, fr, fq);
            for (int t = JT; t < nt; t += 2) PG8_KBODY(t);
        } else {
            for (int t = 0; t < nt; t += 2) PG8_KBODY(t);
        }
        if (wr == 0) PG8_BAR;
        E(acc, cur, wr, wc, fr, fq);
        if (!has_next) break;
#pragma unroll
        for (int a = 0; a < 2; ++a)
#pragma unroll
            for (int b = 0; b < 2; ++b)
#pragma unroll
                for (int m = 0; m < 4; ++m)
#pragma unroll
                    for (int n = 0; n < 2; ++n) acc[a][b][m][n] = (f32x4){0.f, 0.f, 0.f, 0.f};
        cur = nxt; cA = nA; cB = nB; ++ui;
        if constexpr (GATHER) { gvo[0][0] = gnx[0][0]; gvo[0][1] = gnx[0][1]; gvo[1][0] = gnx[1][0]; gvo[1][1] = gnx[1][1]; }
        if (wr == 1) PG8_BAR;
    }
    PG8_WAIT_V(0);
    PG8_BAR;
#undef PG8_SA
#undef PG8_SB
#undef PG8_STAGE
#undef PG8_LDA
#undef PG8_LDB
#undef PG8_MMA
#undef PG8_WAIT_V
#undef PG8_WAIT_L
#undef PG8_BAR
#undef PG8_SCHED
#undef PG8_AK
#undef PG8_KBODY
#undef PG8_GOFF
#undef PG8_STAGE2
#undef PG8_STAGE_A
#undef PG8_STAGE_X
}

struct SchedInproj {
    static constexpr bool GATHER = false; static constexpr int A_AUX = 0; DEVI unsigned gather_row(const Unit&, int) const { return 0u; }
    int G, c; const char *xn, *mn, *win, *wkv;
    DEVI bool next(int i, Unit& u) const {
        const int L = i * G + c;
        if (L < 64 * 26) { u.e = 0; return tile_order(L, 64, 26, u.pm, u.pn); }
        const int r = L - 64 * 26; if (r >= 32) return false;
        u.e = 1; u.pm = r & 3; u.pn = r >> 2; return true;
    }
    DEVI const char* abase(const Unit& u) const { return (u.e ? mn : xn) + (size_t)u.pm * (256 * DM * 2); }
    DEVI const char* bbase(const Unit& u) const { return (u.e ? wkv : win) + (size_t)u.pn * (256 * DM * 2); }
};
struct SchedSimple {
    static constexpr bool GATHER = false; static constexpr int A_AUX = 0; DEVI unsigned gather_row(const Unit&, int) const { return 0u; }
    int G, c; const char *A, *B; int lda, ldb;
    DEVI bool next(int i, Unit& u) const { u.e = 0; return tile_order(i * G + c, 64, 4, u.pm, u.pn); }
    DEVI const char* abase(const Unit& u) const { return A + (size_t)u.pm * 256 * lda * 2; }
    DEVI const char* bbase(const Unit& u) const { return B + (size_t)u.pn * 256 * ldb * 2; }
};
constexpr int TAB_OFF = LDSCTL_OFF + 1024;
template <bool GATHER_> struct SchedMoe {
    static constexpr bool GATHER = GATHER_;
    static constexpr int A_AUX = GATHER_ ? 0 : 16;
    int G, c, ntile; const LAS int* tab; const unsigned long long* lrec; const char *A, *B; int lda, ldb;
    DEVI bool next(int i, Unit& u) const { if (!tile_order(i * G + c, ntile, 4, u.pm, u.pn)) return false;
        const LAS int* t = tab + 4 * u.pm; u.e = __builtin_amdgcn_readfirstlane(t[0]); u.lb = __builtin_amdgcn_readfirstlane(t[1]); u.rem = __builtin_amdgcn_readfirstlane(t[2]); return true; }
    DEVI const char* abase(const Unit& u) const { return GATHER_ ? A : A + (size_t)u.pm * 256 * lda * 2; }
    DEVI const char* bbase(const Unit& u) const { return B + ((size_t)u.e * 1024 + u.pn * 256) * ldb * 2; }
    DEVI unsigned gather_row(const Unit& u, int r) const { return r < u.rem ? ((unsigned)__hip_atomic_load(lrec + u.lb + r, __ATOMIC_RELAXED, __HIP_MEMORY_SCOPE_AGENT) >> 1) : 0u; }
};
DEVI int moe_table(LAS unsigned char* lds, int tid_, const unsigned* cnt) {
    LAS int* tab = (LAS int*)(lds + TAB_OFF); int ts = 0, me = -1, mlb = 0, mrem = 0;
    for (int e = 0; e < NE; ++e) { const int c = (int)__hip_atomic_load(cnt + e * CNT_STRIDE, __ATOMIC_RELAXED, __HIP_MEMORY_SCOPE_AGENT), nt = (c + 255) >> 8;
        if (tid_ >= ts && tid_ < ts + nt) { me = e; mlb = e * 16384 + (tid_ - ts) * 256; mrem = c - (tid_ - ts) * 256; } ts += nt; }
    if (me >= 0) { tab[4 * tid_ + 0] = me; tab[4 * tid_ + 1] = mlb; tab[4 * tid_ + 2] = mrem; tab[4 * tid_ + 3] = 0; }
    __syncthreads();
    return __builtin_amdgcn_readfirstlane(ts);
}
DEVI int moe_ntiles(const unsigned* cnt) { int ts = 0; for (int e = 0; e < NE; ++e) ts += ((int)cnt[e * CNT_STRIDE] + 255) >> 8; return ts; }

typedef f32x4 Acc[2][2][4][2];
#define EPI_FENCE() asm volatile("" ::: "memory")
#define ROT2(V, I, C, J) do { const float t1_ = V[I], t2_ = V[I + 1]; V[I] = (t1_ * C[J] - t2_ * C[J + 1]) * sc; V[I + 1] = (t1_ * C[J + 1] + t2_ * C[J]) * sc; } while (0)
#define ROWOFF(ai, m, ld, esz) ((unsigned)(((ai) * 128 + (m) * 16) * (ld) * (esz)))
struct EpiProj {
    bf16* proj; bf16* kvm; const float2* rope;
    DEVI void mid(Acc&, const Unit&, int, int, int, int) const {}
    DEVI void operator()(const Acc& acc, const Unit& u, int wr, int wc, int fr, int fq) const {
        const int row0 = u.pm * 256 + wr * 64 + fr, cl = wc * 32 + 8 * fq;
        if (u.e) {
            const unsigned lo = launder((unsigned)(row0 * 2048 + u.pn * 256 + cl) * 2u); char* base = (char*)kvm;
#pragma unroll
            for (int ai = 0; ai < 2; ++ai)
#pragma unroll
                for (int m = 0; m < 4; ++m) {
#pragma unroll
                    for (int bj = 0; bj < 2; ++bj) *(u32x4*)(base + lo + ROWOFF(ai, m, 2048, 2) + bj * 256) = pack8(acc[ai][bj][m][0], acc[ai][bj][m][1]); }
        } else {
            const bool rot = (u.pn >= 6) && (u.pn < 10), kq = (u.pn >= 8);
            float lgk[2];
#pragma unroll
            for (int bj = 0; bj < 2; ++bj) { const int hh = ((u.pn & 1) * 256 + bj * 128 + cl) >> 6; lgk[bj] = __log2f(1.f - exp2f(-5.f - (float)hh)); }
            const unsigned lo = launder((unsigned)(row0 * PROJ_LD + u.pn * 256 + cl) * 2u); char* base = (char*)proj;
            const unsigned ro = launder((unsigned)((row0 & (SEQ - 1)) * 32 + ((cl & 63) >> 1)) * 8u); const char* rbase = (const char*)rope;
#pragma unroll
            for (int ai = 0; ai < 2; ++ai)
#pragma unroll
                for (int m = 0; m < 4; ++m) {
                    f32x4 c01 = (f32x4){1.f, 0.f, 1.f, 0.f}, c23 = c01;
                    if (rot) { const f32x4* tp = (const f32x4*)(rbase + ro + ROWOFF(ai, m, 32, 8)); c01 = tp[0]; c23 = tp[1]; }
                    const float pe = (float)(127 - ((fr + m * 16) & 127));
#pragma unroll
                    for (int bj = 0; bj < 2; ++bj) { f32x4 v0 = acc[ai][bj][m][0], v1 = acc[ai][bj][m][1];
                        if (rot) { const float e_ = exp2f((pe - (float)(wr * 64)) * (kq ? lgk[bj] : -lgk[bj])); const float sc = kq ? 0.125f * e_ : e_;
                            ROT2(v0, 0, c01, 0); ROT2(v0, 2, c01, 2); ROT2(v1, 0, c23, 0); ROT2(v1, 2, c23, 2); }
                        *(u32x4*)(base + lo + ROWOFF(ai, m, PROJ_LD, 2) + bj * 256) = pack8(v0, v1); }
                    if (m & 1) EPI_FENCE(); }
        }
    }
};
DEVI float gate_ratio(float gr, float gc) { return (1.f + __expf(-gr)) * __builtin_amdgcn_rcpf(1.f + __expf(-gc)); }
struct EpiMerge {
    const bf16* proj; bf16* mrg;
    DEVI void mid(Acc& acc, const Unit& u, int wr, int wc, int fr, int fq) const {
        const int row0 = u.pm * 256 + wr * 64 + fr, cl = wc * 32 + 8 * fq;
        const unsigned lo = launder((unsigned)(row0 * PROJ_LD + u.pn * 256 + cl) * 2u); const char* base = (const char*)proj;
#pragma unroll
        for (int ai = 0; ai < 2; ++ai)
#pragma unroll
            for (int m = 0; m < 4; ++m) { const char* rp = base + lo + ROWOFF(ai, m, PROJ_LD, 2);
#pragma unroll
                for (int bj = 0; bj < 2; ++bj) { const u32x4 gc = *(const u32x4*)(rp + C_GC * 2 + bj * 256), gr = *(const u32x4*)(rp + C_GR * 2 + bj * 256);
#pragma unroll
                    for (int q = 0; q < 2; ++q) { acc[ai][bj][m][0][2 * q] *= gate_ratio(bflo(gr[q]), bflo(gc[q])); acc[ai][bj][m][0][2 * q + 1] *= gate_ratio(bfhi(gr[q]), bfhi(gc[q]));
                        acc[ai][bj][m][1][2 * q] *= gate_ratio(bflo(gr[2 + q]), bflo(gc[2 + q])); acc[ai][bj][m][1][2 * q + 1] *= gate_ratio(bfhi(gr[2 + q]), bfhi(gc[2 + q])); } }
                EPI_FENCE(); }
    }
    DEVI void operator()(const Acc& acc, const Unit& u, int wr, int wc, int fr, int fq) const {
        const int row0 = u.pm * 256 + wr * 64 + fr, cl = wc * 32 + 8 * fq;
        const unsigned lo = launder((unsigned)(row0 * PROJ_LD + u.pn * 256 + cl) * 2u); const char* base = (const char*)proj;
        const unsigned oo = launder((unsigned)(row0 * DM + u.pn * 256 + cl) * 2u); char* ob = (char*)mrg;
#pragma unroll
        for (int ai = 0; ai < 2; ++ai)
#pragma unroll
            for (int m = 0; m < 4; ++m) { const char* rp = base + lo + ROWOFF(ai, m, PROJ_LD, 2); char* op = ob + oo + ROWOFF(ai, m, DM, 2);
#pragma unroll
                for (int bj = 0; bj < 2; ++bj) { const u32x4 gr = *(const u32x4*)(rp + C_GR * 2 + bj * 256); f32x4 v0 = acc[ai][bj][m][0], v1 = acc[ai][bj][m][1];
#pragma unroll
                    for (int q = 0; q < 2; ++q) { v0[2 * q] *= sigmoidf_(bflo(gr[q])); v0[2 * q + 1] *= sigmoidf_(bfhi(gr[q])); v1[2 * q] *= sigmoidf_(bflo(gr[2 + q])); v1[2 * q + 1] *= sigmoidf_(bfhi(gr[2 + q])); }
                    *(u32x4*)(op + bj * 256) = pack8(v0, v1); }
                EPI_FENCE(); }
    }
};
template <bool BASE_BF16> struct EpiResid {
    const void* base; bf16* HB; float* ssq;
    DEVI void mid(Acc&, const Unit&, int, int, int, int) const {}
    DEVI void operator()(const Acc& acc, const Unit& u, int wr, int wc, int fr, int fq) const {
        const int row0 = u.pm * 256 + wr * 64 + fr, cl = wc * 32 + 8 * fq;
        const unsigned eo = launder((unsigned)(row0 * DM + u.pn * 256 + cl)); const unsigned so = launder((unsigned)(row0 * 16 + u.pn * 4 + wc) * 4u);
        const char* bb = (const char*)base; char* hbb = (char*)HB; char* sb = (char*)ssq;
#pragma unroll
        for (int ai = 0; ai < 2; ++ai)
#pragma unroll
            for (int m = 0; m < 4; ++m) { const unsigned o4 = eo * 4u + ROWOFF(ai, m, DM, 4), o2 = eo * 2u + ROWOFF(ai, m, DM, 2); float ss = 0.f;
#pragma unroll
                for (int bj = 0; bj < 2; ++bj) { f32x4 b0, b1;
                    if (BASE_BF16) { const u32x4 bw = *(const u32x4*)(bb + o2 + bj * 256); b0 = (f32x4){bflo(bw.x), bfhi(bw.x), bflo(bw.y), bfhi(bw.y)}; b1 = (f32x4){bflo(bw.z), bfhi(bw.z), bflo(bw.w), bfhi(bw.w)}; }
                    else { b0 = *(const f32x4*)(bb + o4 + bj * 512); b1 = *(const f32x4*)(bb + o4 + bj * 512 + 16); }
                    const f32x4 v0 = b0 + acc[ai][bj][m][0], v1 = b1 + acc[ai][bj][m][1];
                    *(u32x4*)(hbb + o2 + bj * 256) = pack8(v0, v1);
                    ss += (v0[0] * v0[0] + v0[1] * v0[1]) + (v0[2] * v0[2] + v0[3] * v0[3]) + (v1[0] * v1[0] + v1[1] * v1[1]) + (v1[2] * v1[2] + v1[3] * v1[3]); }
                ss += __shfl_xor(ss, 16); ss += __shfl_xor(ss, 32);
                if (fq == 0) *(float*)(sb + so + ROWOFF(ai, m, 16, 4)) = ss;
                EPI_FENCE(); }
    }
};
struct EpiQ {
    const float* ssq; bf16* Q;
    DEVI void mid(Acc&, const Unit&, int, int, int, int) const {}
    DEVI void operator()(const Acc& acc, const Unit& u, int wr, int wc, int fr, int fq) const {
        const int row0 = u.pm * 256 + wr * 64 + fr, cl = wc * 32 + 8 * fq;
        const unsigned oo = launder((unsigned)(row0 * DM + u.pn * 256 + cl) * 2u); const unsigned so = launder((unsigned)(row0 * 16) * 4u); char* ob = (char*)Q; const char* sb = (const char*)ssq;
#pragma unroll
        for (int ai = 0; ai < 2; ++ai)
#pragma unroll
            for (int m = 0; m < 4; ++m) { const f32x4* p = (const f32x4*)(sb + so + ROWOFF(ai, m, 16, 4)); float t = 0.f;
#pragma unroll
                for (int i = 0; i < 4; ++i) { const f32x4 v = p[i]; t += (v[0] + v[1]) + (v[2] + v[3]); }
                const float s = rsqrtf(t * (1.f / DM) + EPS) * QSCALE; char* op = ob + oo + ROWOFF(ai, m, DM, 2);
#pragma unroll
                for (int bj = 0; bj < 2; ++bj) *(u32x4*)(op + bj * 256) = pack8(acc[ai][bj][m][0] * s, acc[ai][bj][m][1] * s);
                if (m & 1) EPI_FENCE(); }
    }
};
struct EpiGU {
    const unsigned long long* lrec; const float* rs2; bf16* HID;
    DEVI void mid(Acc&, const Unit&, int, int, int, int) const {}
    DEVI void operator()(const Acc& acc, const Unit& u, int wr, int wc, int fr, int fq) const {
        const int rt = wr * 64 + fr, row0 = u.pm * 256 + rt, cl = wc * 32 + 8 * fq;
        const unsigned oo = launder((unsigned)(row0 * EH + u.pn * 128 + cl) * 2u); const unsigned so = launder((unsigned)(u.lb + rt) * 8u); char* ob = (char*)HID; const char* sb = (const char*)lrec;
#pragma unroll
        for (int ai = 0; ai < 2; ++ai)
#pragma unroll
            for (int m = 0; m < 4; ++m) { const bool real = rt + ai * 128 + m * 16 < u.rem; float rs = 0.f;
                if (real) { const unsigned id = (unsigned)__hip_atomic_load((const unsigned long long*)(sb + so + ROWOFF(ai, m, 1, 8)), __ATOMIC_RELAXED, __HIP_MEMORY_SCOPE_AGENT); rs = rs2[id >> 1]; }
                f32x4 h[2];
#pragma unroll
                for (int n = 0; n < 2; ++n)
#pragma unroll
                    for (int q = 0; q < 4; ++q) { const float g = acc[ai][0][m][n][q] * rs, up = acc[ai][1][m][n][q] * rs; h[n][q] = g * sigmoidf_(g) * up; }
                *(u32x4*)(ob + oo + ROWOFF(ai, m, EH, 2)) = pack8(h[0], h[1]);
                if (m & 1) EPI_FENCE(); }
    }
};
struct EpiDown {
    const unsigned long long* lrec; bf16* YB;
    DEVI void mid(Acc&, const Unit&, int, int, int, int) const {}
    DEVI void operator()(const Acc& acc, const Unit& u, int wr, int wc, int fr, int fq) const {
        const int rt = wr * 64 + fr, cl = wc * 32 + 8 * fq;
        const unsigned so = launder((unsigned)(u.lb + rt) * 8u); const unsigned co = launder((unsigned)(u.pn * 256 + cl) * 2u); const char* sb = (const char*)lrec; char* ob = (char*)YB;
#pragma unroll
        for (int ai = 0; ai < 2; ++ai)
#pragma unroll
            for (int m = 0; m < 4; ++m) { const bool real = rt + ai * 128 + m * 16 < u.rem;
                if (real) { const unsigned long long rec = __hip_atomic_load((const unsigned long long*)(sb + so + ROWOFF(ai, m, 1, 8)), __ATOMIC_RELAXED, __HIP_MEMORY_SCOPE_AGENT);
                    const unsigned id = (unsigned)rec; const float w = __uint_as_float((unsigned)(rec >> 32)); char* op = ob + (size_t)id * (DM * 2) + co;
#pragma unroll
                    for (int bj = 0; bj < 2; ++bj) *(u32x4*)(op + bj * 256) = pack8(acc[ai][bj][m][0] * w, acc[ai][bj][m][1] * w); }
                if (m & 1) EPI_FENCE(); }
    }
};

struct Args { const float* in[22]; float* out; unsigned char* ws; int ph_lo, ph_hi; };
struct Frame {
    LAS unsigned char* lds; int tid, lane, wave, vcu, G;
    DEVI int gw() const { return vcu * NWAVES + wave; }
    DEVI int ngw() const { return G * NWAVES; }
};
DEVI float wave_sum(float v) {
#pragma unroll
    for (int o = 1; o < 64; o <<= 1) v += __shfl_xor(v, o);
    return v;
}
DEVI unsigned pk2(float lo, float hi) { return (unsigned)f2bf(lo) | ((unsigned)f2bf(hi) << 16); }
DEVI int wt_rowmap(int n, int mode) {
    if (mode == 1) { if (n >= C_Q && n < C_V) { const int o = n & 63; return (n & ~63) + 2 * (o & 31) + (o >> 5); } return n; }
    if (mode == 2) return (n >> 7) * 256 + (n & 127);
    if (mode == 3) return (n >> 7) * 256 + 128 + (n & 127);
    return n;
}
DEVI void transpose_item(const float* W, int K, int N, bf16* WT, int ldwt, int koff, const float* kscale, int mode, LAS float* scr, int item, int lane) {
    const int nblk = N / 32, kb = item / nblk, nb = item % nblk, k0 = 64 * kb, n0 = 32 * nb;
#pragma unroll 8
    for (int i = 0; i < 32; ++i) { const int kk = 2 * i + (lane >> 5); float v = W[(size_t)(k0 + kk) * N + n0 + (lane & 31)]; if (kscale) v *= kscale[k0 + kk]; scr[kk * 33 + (lane & 31)] = v; }
    LDS_WAIT(); asm volatile("" ::: "memory");
    const int c = lane & 7;
#pragma unroll
    for (int j = 0; j < 4; ++j) { const int n = (lane >> 3) + 8 * j; const LAS float* s = scr + (8 * c) * 33 + n;
        u32x4 o; o.x = pk2(s[0 * 33], s[1 * 33]); o.y = pk2(s[2 * 33], s[3 * 33]); o.z = pk2(s[4 * 33], s[5 * 33]); o.w = pk2(s[6 * 33], s[7 * 33]);
        *(u32x4*)(WT + (size_t)wt_rowmap(n0 + n, mode) * ldwt + koff + k0 + 8 * c) = o; }
    LDS_WAIT(); asm volatile("" ::: "memory");
}
DEVI void rms_row_to_bf16(const float* xrow, const float* g, bf16* orow, int lane) {
    const f32x4* xr = (const f32x4*)xrow + lane; const f32x4* gr = (const f32x4*)g + lane;
    f32x4 v[4]; float s = 0.f;
#pragma unroll
    for (int j = 0; j < 4; ++j) { v[j] = xr[64 * j]; s += (v[j].x * v[j].x + v[j].y * v[j].y) + (v[j].z * v[j].z + v[j].w * v[j].w); }
    const float rstd = rsqrtf(wave_sum(s) * (1.f / DM) + EPS);
    unsigned long long* o8 = (unsigned long long*)orow + lane;
#pragma unroll
    for (int j = 0; j < 4; ++j) { const f32x4 gg = gr[64 * j]; o8[64 * j] = (unsigned long long)pk2(v[j].x * rstd * gg.x, v[j].y * rstd * gg.y) | ((unsigned long long)pk2(v[j].z * rstd * gg.z, v[j].w * rstd * gg.w) << 32); }
}

#define MFMA16(a, b, c) __builtin_amdgcn_mfma_f32_16x16x32_bf16((a), (b), (c), 0, 0, 0)
typedef short v4i16_t __attribute__((ext_vector_type(4)));
DEVI bf16x8 tr_frag(const LAS unsigned char* p0, const LAS unsigned char* p1) {
    const v4i16_t a = __builtin_amdgcn_ds_read_tr16_b64_v4i16((LAS v4i16_t*)p0), b = __builtin_amdgcn_ds_read_tr16_b64_v4i16((LAS v4i16_t*)p1);
    return (bf16x8){a[0], a[1], a[2], a[3], b[0], b[1], b[2], b[3]};
}
constexpr int TI_P = 144, TI_BYTES = 64 * TI_P;
DEVI void transpose_item64(const float* W, int K, int N, bf16* WT, int ldwt, int koff, const float* kscale, int mode, LAS unsigned char* scr, int item, int lane) {
    const int nblk = N >> 6, kb = item / nblk, nb = item - kb * nblk, k0 = 64 * kb, n0 = 64 * nb;
    const int kr = lane >> 4, nc = 4 * (lane & 15);
    const float* src = W + (size_t)(k0 + kr) * N + n0 + nc;
#pragma unroll 8
    for (int i = 0; i < 16; ++i) { f32x4 v = *(const f32x4*)(src + (size_t)(4 * i) * N); if (kscale) v = v * kscale[k0 + 4 * i + kr];
        u32x2 w; w.x = cvt_pk_bf16(v[0], v[1]); w.y = cvt_pk_bf16(v[2], v[3]); *(LAS u32x2*)(scr + (4 * i + kr) * TI_P + nc * 2) = w; }
    LDS_WAIT(); asm volatile("" ::: "memory");
    const int g = lane >> 4, q4 = (lane & 15) >> 2, p4 = lane & 3, ii = lane & 15;
    const LAS unsigned char* rb = scr + (8 * g + q4) * TI_P + 8 * p4;
#pragma unroll
    for (int c = 0; c < 4; ++c) { bf16* drow = WT + (size_t)wt_rowmap(n0 + 16 * c + ii, mode) * ldwt + koff + k0 + 8 * g;
#pragma unroll
        for (int kh = 0; kh < 2; ++kh) { const bf16x8 v = tr_frag(rb + 32 * kh * TI_P + 32 * c, rb + (32 * kh + 4) * TI_P + 32 * c); *(bf16x8*)(drow + 32 * kh) = v; } }
    LDS_WAIT(); asm volatile("" ::: "memory");
}

DEVI void p0_prologue(Frame& F, const Args& a, unsigned char* ws) {
    LAS unsigned char* scr = F.lds + F.wave * TI_BYTES;
    const int gw = F.gw(), NGW = F.ngw();
    const float* w_in = a.in[3]; const float* w_conv_out = a.in[5]; const float* w_ret_out = a.in[6]; const float* w_mix_out = a.in[7];
    const float* xa_g = a.in[8]; const float* w_xa_q = a.in[10]; const float* w_xa_kv = a.in[11]; const float* w_xa_o = a.in[12]; const float* moe_g = a.in[13];
    bf16 *win = (bf16*)(ws + WS_WIN), *wcat = (bf16*)(ws + WS_WCAT), *wmix = (bf16*)(ws + WS_WMIX), *wq = (bf16*)(ws + WS_WQ), *wkv = (bf16*)(ws + WS_WKV), *wo = (bf16*)(ws + WS_WO), *wrt = (bf16*)(ws + WS_WRT);
    constexpr int I_IN = 16 * 104, I_C = 8 * 16, I_S = 16 * 16, I_KV = 16 * 32;
    constexpr int NITEMS = I_IN + I_C + 4 * I_S + I_KV;
    for (int it = gw; it < NITEMS; it += NGW) {
        int r = it;
        if (r < I_IN) { transpose_item64(w_in, DM, PROJ_LD, win, DM, 0, nullptr, 1, scr, r, F.lane); continue; } r -= I_IN;
        if (r < I_C) { transpose_item64(w_conv_out, 512, DM, wcat, 1536, 0, nullptr, 0, scr, r, F.lane); continue; } r -= I_C;
        if (r < I_S) { transpose_item64(w_ret_out, DM, DM, wcat, 1536, 512, nullptr, 0, scr, r, F.lane); continue; } r -= I_S;
        if (r < I_S) { transpose_item64(w_mix_out, DM, DM, wmix, DM, 0, nullptr, 0, scr, r, F.lane); continue; } r -= I_S;
        if (r < I_S) { transpose_item64(w_xa_q, DM, DM, wq, DM, 0, xa_g, 0, scr, r, F.lane); continue; } r -= I_S;
        if (r < I_S) { transpose_item64(w_xa_o, DM, DM, wo, DM, 0, nullptr, 0, scr, r, F.lane); continue; } r -= I_S;
        transpose_item64(w_xa_kv, DM, 2048, wkv, DM, 0, nullptr, 0, scr, r, F.lane);
    }
    const int gt = F.vcu * NTHR + F.tid, NGT = F.G * NTHR;
    {   const float* w_group = a.in[14]; const float* w_router = a.in[16];
        for (int i = gt; i < 48 * DM; i += NGT) { const int n = i >> 10, k = i & 1023; float v = 0.f;
            if (n < 4) v = w_group[k * 4 + n] * moe_g[k]; else if (n < 36) v = w_router[k * 32 + (n - 4)] * moe_g[k];
            wrt[i] = f2bf(v); } }
    {   float2* rope = (float2*)(ws + WS_ROPE);
        for (int i = gt; i < SEQ * 32; i += NGT) { const int pos = i >> 5, p = i & 31;
            const float ang = (float)pos * (float)c_invfreq[p]; const double rev = (double)ang * 0.15915494309189535; const float fr = (float)(rev - floor(rev));
            rope[i] = make_float2(__builtin_amdgcn_cosf(fr), __builtin_amdgcn_sinf(fr)); } }
    const float* x = a.in[0]; const float* mem = a.in[1]; bf16* xn = (bf16*)(ws + WS_XN); bf16* mn = (bf16*)(ws + WS_MN);
    for (int m = gw; m < T; m += NGW) rms_row_to_bf16(x + (size_t)m * DM, a.in[2], xn + (size_t)m * DM, F.lane);
    for (int m = gw; m < NB * MEML; m += NGW) rms_row_to_bf16(mem + (size_t)m * DM, a.in[9], mn + (size_t)m * DM, F.lane);
}
DEVI void p9_route(Frame& F, const Args& a, unsigned char* ws, int cntoff = 0) {
    const bf16* HB = (const bf16*)(ws + WS_HB); const bf16* wrt = (const bf16*)(ws + WS_WRT); const float* ssq = (const float*)(ws + WS_SSQ2);
    const float* bg = a.in[15]; const float* br = a.in[17]; float* rs2 = (float*)(ws + WS_RS2); unsigned* cnt = (unsigned*)(ws + WS_CTL) + CW_CNT + cntoff; unsigned long long* lrec = (unsigned long long*)(ws + WS_LID);
    const int lane = F.lane, fr = lane & 15, fq = lane >> 4, w = F.wave, tid = F.tid;
    LAS float* lg = (LAS float*)F.lds;
    LAS unsigned* hist = (LAS unsigned*)(F.lds + 2 * 64 * 49 * 4); LAS unsigned* base = hist + 32;
    for (int tb = F.vcu; tb < T / 64; tb += F.G) {
        if (tid < 32) hist[tid] = 0u;
        {   const int tg = w & 3, kh = w >> 2, tok0 = tb * 64 + tg * 16;
            f32x4 acc[3]; acc[0] = acc[1] = acc[2] = (f32x4){0.f, 0.f, 0.f, 0.f};
            const bf16* ap = HB + (size_t)(tok0 + fr) * DM + 512 * kh + 8 * fq; const bf16* bp = wrt + (size_t)fr * DM + 512 * kh + 8 * fq;
#pragma unroll 8
            for (int ks = 0; ks < 16; ++ks) { const bf16x8 av = *(const bf16x8*)(ap + 32 * ks);
#pragma unroll
                for (int nb = 0; nb < 3; ++nb) { const bf16x8 bv = *(const bf16x8*)(bp + (size_t)nb * 16 * DM + 32 * ks); acc[nb] = MFMA16(av, bv, acc[nb]); } }
            LAS float* l = lg + (kh * 64 + tg * 16) * 49;
#pragma unroll
            for (int nb = 0; nb < 3; ++nb)
#pragma unroll
                for (int r = 0; r < 4; ++r) l[(4 * fq + r) * 49 + 16 * nb + fr] = acc[nb][r];
        }
        __syncthreads();
        int E1 = 0, E2 = 0; unsigned r1 = 0, r2 = 0; float w1 = 0.f, w2 = 0.f, rsv = 0.f;
        if (tid < 64) {
            const int tok = tb * 64 + tid; const float rs = rstd_from_ssq(ssq, tok); rsv = rs; const LAS float* l0 = lg + tid * 49; const LAS float* l1 = l0 + 64 * 49;
            int gi = 0; float gm = -3.0e38f, gs = 0.f; float l4[4];
#pragma unroll
            for (int n = 0; n < 4; ++n) l4[n] = (l0[n] + l1[n]) * rs + bg[n];
#pragma unroll
            for (int n = 0; n < 4; ++n) if (l4[n] > gm) { gm = l4[n]; gi = n; }
#pragma unroll
            for (int n = 0; n < 4; ++n) gs += __expf(l4[n] - gm);
            const float pg = 1.f / gs; float le[8];
#pragma unroll
            for (int n = 0; n < 8; ++n) le[n] = (l0[4 + gi * 8 + n] + l1[4 + gi * 8 + n]) * rs + br[gi * 8 + n];
            int e1 = 0; float m1 = -3.0e38f;
#pragma unroll
            for (int n = 0; n < 8; ++n) if (le[n] > m1) { m1 = le[n]; e1 = n; }
            int e2 = 0; float m2 = -3.0e38f;
#pragma unroll
            for (int n = 0; n < 8; ++n) if (n != e1 && le[n] > m2) { m2 = le[n]; e2 = n; }
            const float x2 = __expf(m2 - m1); w1 = pg / (1.f + x2); w2 = pg * x2 / (1.f + x2);
            E1 = gi * 8 + e1; E2 = gi * 8 + e2;
            r1 = __hip_atomic_fetch_add(hist + E1, 1u, __ATOMIC_RELAXED, __HIP_MEMORY_SCOPE_WORKGROUP); r2 = __hip_atomic_fetch_add(hist + E2, 1u, __ATOMIC_RELAXED, __HIP_MEMORY_SCOPE_WORKGROUP);
        }
        __syncthreads();
        if (tid < 32) { const unsigned hc = hist[tid]; base[tid] = hc ? atomicAdd(&cnt[tid * CNT_STRIDE], hc) : 0u; }
        __syncthreads();
        if (tid < 64) { const int tok = tb * 64 + tid; const unsigned p1 = base[E1] + r1, p2 = base[E2] + r2;
            __hip_atomic_store(lrec + E1 * 16384 + p1, (unsigned long long)(unsigned)(tok * 2) | ((unsigned long long)__float_as_uint(w1) << 32), __ATOMIC_RELAXED, __HIP_MEMORY_SCOPE_AGENT);
            __hip_atomic_store(lrec + E2 * 16384 + p2, (unsigned long long)(unsigned)(tok * 2 + 1) | ((unsigned long long)__float_as_uint(w2) << 32), __ATOMIC_RELAXED, __HIP_MEMORY_SCOPE_AGENT); rs2[tok] = rsv; }
        __syncthreads();
    }
    {
        LAS unsigned char* scr = F.lds + F.wave * TI_BYTES;
        const float* w_gate = a.in[18]; const float* w_up = a.in[19]; const float* w_down = a.in[20]; const float* moe_g = a.in[13];
        bf16* egu = (bf16*)(ws + WS_EGU); bf16* ed = (bf16*)(ws + WS_ED);
        for (int it = F.gw(); it < 3 * NE * 128; it += F.ngw()) { const int ty = it / (NE * 128), r = it % (NE * 128), e = r >> 7, li = r & 127;
            if (ty == 0) transpose_item64(w_gate + (size_t)e * DM * EH, DM, EH, egu + (size_t)e * 1024 * DM, DM, 0, moe_g, 2, scr, li, lane);
            else if (ty == 1) transpose_item64(w_up + (size_t)e * DM * EH, DM, EH, egu + (size_t)e * 1024 * DM, DM, 0, moe_g, 3, scr, li, lane);
            else transpose_item64(w_down + (size_t)e * EH * DM, EH, DM, ed + (size_t)e * 1024 * EH, EH, 0, nullptr, 0, scr, li, lane); }
    }
}
DEVI void p10_gather(Frame& F, unsigned char* ws) {
    const bf16* HB = (const bf16*)(ws + WS_HB); const unsigned* cnt = (const unsigned*)(ws + WS_CTL) + CW_CNT; const int* lid = (const int*)(ws + WS_LID); const float* lw = (const float*)(ws + WS_LW);
    const float* rs2 = (const float*)(ws + WS_RS2); bf16* XS = (bf16*)(ws + WS_XS); int* rid = (int*)(ws + WS_RID); float* rw = (float*)(ws + WS_RW); float* rrs = (float*)(ws + WS_RRS);
    const int rows = moe_ntiles(cnt) * 256;
    for (int row = F.gw(); row < rows; row += F.ngw()) {
        int ft; const int e = tile_expert(cnt, row >> 8, ft); const int pos = row - ft * 256; const bool real = pos < (int)cnt[e * CNT_STRIDE];
        const int id = real ? lid[e * 16384 + pos] : -1; const int tok = real ? (id >> 1) : 0;
        if (F.lane == 0) { rid[row] = id; rw[row] = real ? lw[e * 16384 + pos] : 0.f; rrs[row] = rs2[tok]; }
        const u32x4* s = (const u32x4*)(HB + (size_t)tok * DM); u32x4* d = (u32x4*)(XS + (size_t)row * DM);
        const u32x4 v0 = s[F.lane], v1 = s[F.lane + 64]; d[F.lane] = v0; d[F.lane + 64] = v1;
    }
}
DEVI void p13_final(Frame& F, const Args& a, unsigned char* ws) {
    float* O = a.out; const bf16* HB = (const bf16*)(ws + WS_HB); const bf16* YB = (const bf16*)(ws + WS_XS); const f32x4* g4 = (const f32x4*)a.in[21];
    for (int row = F.gw(); row < T; row += F.ngw()) {
        f32x4* orow = (f32x4*)(O + (size_t)row * DM); const u32x2* hr = (const u32x2*)(HB + (size_t)row * DM); const u32x2* y0 = (const u32x2*)(YB + (size_t)(2 * row) * DM); const u32x2* y1 = (const u32x2*)(YB + (size_t)(2 * row + 1) * DM);
        f32x4 v[4]; float s = 0.f;
#pragma unroll
        for (int j = 0; j < 4; ++j) { const int i = F.lane + 64 * j; const u32x2 hh = hr[i], a0 = y0[i], a1 = y1[i];
            v[j].x = bflo(hh.x) + bflo(a0.x) + bflo(a1.x); v[j].y = bfhi(hh.x) + bfhi(a0.x) + bfhi(a1.x); v[j].z = bflo(hh.y) + bflo(a0.y) + bflo(a1.y); v[j].w = bfhi(hh.y) + bfhi(a0.y) + bfhi(a1.y);
            s += (v[j].x * v[j].x + v[j].y * v[j].y) + (v[j].z * v[j].z + v[j].w * v[j].w); }
        const float rstd = rsqrtf(wave_sum(s) * (1.f / DM) + EPS);
#pragma unroll
        for (int j = 0; j < 4; ++j) { const int i = F.lane + 64 * j; orow[i] = v[j] * rstd * g4[i]; }
    }
}

DEVI bf16x8 pack_frag(const f32x4 a, const f32x4 b) { const u32x4 w = pack8(a, b); return __builtin_bit_cast(bf16x8, w); }
constexpr int RT_QP = 160, RT_VP = 288, RT_SP = 144;
constexpr int RT_Q = 0, RT_K = 128 * RT_QP, RT_V = 2 * 128 * RT_QP, RT_S = RT_V + 128 * RT_VP, RT_O = RT_S + 128 * RT_SP, RT_OP = 272, RT_END = RT_O + 8 * 16 * RT_OP;
static_assert(RT_END <= RING_BYTES, "retention LDS");
template <bool OUT> DEVI void ret_unit(Frame& F, int un, bf16* proj, float* Eg) {
    const int b = un >> 6, h = (un >> 3) & 7, grp = un & 7, lane = F.lane, w = F.wave, fr = lane & 15, fq = lane >> 4, tid = F.tid;
    const float lg2 = __log2f(1.f - exp2f(-5.f - (float)h)), cd = exp2f(128.f * lg2);
    LAS unsigned char* L = F.lds;
    f32x4 sb[4];
#pragma unroll
    for (int db = 0; db < 4; ++db) sb[db] = (f32x4){0.f, 0.f, 0.f, 0.f};
    if (OUT) {
        const float cd4 = cd * cd * cd * cd;
        for (int gp = 0; gp < grp; ++gp) { const float* e = Eg + (size_t)(un - grp + gp) * 8192 + 16 * w + fr;
#pragma unroll
            for (int db = 0; db < 4; ++db)
#pragma unroll
                for (int r = 0; r < 4; ++r) sb[db][r] = sb[db][r] * cd4 + e[(16 * db + 4 * fq + r) * 128]; }
    }
    const int q4 = (lane & 15) >> 2, p4 = lane & 3;
    for (int n = 0; n < 4; ++n) {
        const size_t t0 = (size_t)b * SEQ + (size_t)(grp * 4 + n) * 128;
#pragma unroll
        for (int i = 0; i < 2; ++i) { const int idx = tid + 512 * i, row = idx >> 3, c = idx & 7; const bf16* g = proj + (t0 + row) * PROJ_LD + h * 64 + c * 8;
            *(LAS u32x4*)(L + RT_K + row * RT_QP + c * 16) = *(const u32x4*)(g + C_K);
            if (OUT) *(LAS u32x4*)(L + RT_Q + row * RT_QP + c * 16) = *(const u32x4*)(g + C_Q); }
#pragma unroll
        for (int i = 0; i < 4; ++i) { const int idx = tid + 512 * i, row = idx >> 4, c = idx & 15;
            *(LAS u32x4*)(L + RT_V + row * RT_VP + c * 16) = *(const u32x4*)(proj + (t0 + row) * PROJ_LD + C_V + h * 128 + c * 8); }
        u32x4 gv[4];
        bf16* grow = proj + (t0 + 16 * w + (lane >> 2)) * PROJ_LD + C_G + h * 128 + 32 * (lane & 3);
        if (OUT) {
#pragma unroll
            for (int i = 0; i < 4; ++i) gv[i] = *(const u32x4*)(grow + 8 * i); }
#pragma unroll
        for (int db = 0; db < 4; ++db) { sb[db] = sb[db] * cd;
            if (OUT) { u32x2 wv; wv.x = cvt_pk_bf16(sb[db][0], sb[db][1]); wv.y = cvt_pk_bf16(sb[db][2], sb[db][3]); *(LAS u32x2*)(L + RT_S + (16 * w + fr) * RT_SP + (16 * db + 4 * fq) * 2) = wv; } }
        __syncthreads();
        if (OUT) {
            bf16x8 qf[2];
#pragma unroll
            for (int ks = 0; ks < 2; ++ks) qf[ks] = *(const LAS bf16x8*)(L + RT_Q + (16 * w + fr) * RT_QP + 64 * ks + 16 * fq);
            f32x4 o[8];
#pragma unroll
            for (int d = 0; d < 8; ++d) o[d] = (f32x4){0.f, 0.f, 0.f, 0.f};
#pragma unroll
            for (int ks = 0; ks < 2; ++ks)
#pragma unroll
                for (int d = 0; d < 8; ++d) { const bf16x8 sf = *(const LAS bf16x8*)(L + RT_S + (16 * d + fr) * RT_SP + 64 * ks + 16 * fq); o[d] = MFMA16(qf[ks], sf, o[d]); }
            for (int s = 0; 2 * s <= w; ++s) {
                f32x4 st[2];
#pragma unroll
                for (int hh = 0; hh < 2; ++hh) { const int kb = 2 * s + hh; st[hh] = (f32x4){0.f, 0.f, 0.f, 0.f};
                    if (kb <= w) {
#pragma unroll
                        for (int ks = 0; ks < 2; ++ks) { const bf16x8 kf = *(const LAS bf16x8*)(L + RT_K + (16 * kb + fr) * RT_QP + 64 * ks + 16 * fq); st[hh] = MFMA16(kf, qf[ks], st[hh]); }
                        if (kb == w) {
#pragma unroll
                            for (int r = 0; r < 4; ++r) if (4 * fq + r > fr) st[hh][r] = 0.f; }
                    } }
                const bf16x8 pa = pack_frag(st[0], st[1]);
                const LAS unsigned char* vb = L + RT_V + (32 * s + 4 * fq + q4) * RT_VP + 8 * p4;
#pragma unroll
                for (int d = 0; d < 8; ++d) { const bf16x8 vf = tr_frag(vb + 32 * d, vb + 16 * RT_VP + 32 * d); o[d] = MFMA16(pa, vf, o[d]); }
            }
            LAS unsigned char* ot = L + RT_O + w * (16 * RT_OP);
#pragma unroll
            for (int r = 0; r < 4; ++r) { float s1 = 0.f;
#pragma unroll
                for (int d = 0; d < 8; ++d) s1 += o[d][r];
                s1 += __shfl_xor(s1, 1); s1 += __shfl_xor(s1, 2); s1 += __shfl_xor(s1, 4); s1 += __shfl_xor(s1, 8);
                const float mu = s1 * (1.f / 128.f); float s2 = 0.f;
#pragma unroll
                for (int d = 0; d < 8; ++d) { const float dd = o[d][r] - mu; s2 += dd * dd; }
                s2 += __shfl_xor(s2, 1); s2 += __shfl_xor(s2, 2); s2 += __shfl_xor(s2, 4); s2 += __shfl_xor(s2, 8);
                const float rs = rsqrtf(s2 * (1.f / 128.f) + EPS);
#pragma unroll
                for (int d = 0; d < 8; ++d) *(LAS bf16*)(ot + (4 * fq + r) * RT_OP + (16 * d + fr) * 2) = f2bf((o[d][r] - mu) * rs); }
            LDS_WAIT(); asm volatile("" ::: "memory");
#pragma unroll
            for (int i = 0; i < 4; ++i) { const u32x4 ov = *(const LAS u32x4*)(ot + (lane >> 2) * RT_OP + 64 * (lane & 3) + 16 * i); u32x4 res;
#pragma unroll
                for (int q = 0; q < 4; ++q) { const float g0 = bflo(gv[i][q]), g1 = bfhi(gv[i][q]); res[q] = cvt_pk_bf16(g0 * sigmoidf_(g0) * bflo(ov[q]), g1 * sigmoidf_(g1) * bfhi(ov[q])); }
                *(u32x4*)(grow + 8 * i) = res; }
        }
        {   const LAS unsigned char* kb_ = L + RT_K + (4 * fq + q4) * RT_QP + 8 * p4; const LAS unsigned char* vb_ = L + RT_V + (4 * fq + q4) * RT_VP + 32 * w + 8 * p4;
#pragma unroll
            for (int ks = 0; ks < 4; ++ks) { const bf16x8 vf = tr_frag(vb_ + 32 * ks * RT_VP, vb_ + (32 * ks + 16) * RT_VP);
#pragma unroll
                for (int db = 0; db < 4; ++db) { const bf16x8 kf = tr_frag(kb_ + 32 * ks * RT_QP + 32 * db, kb_ + (32 * ks + 16) * RT_QP + 32 * db); sb[db] = MFMA16(kf, vf, sb[db]); } }
        }
        __syncthreads();
    }
    if (!OUT) { float* e = Eg + (size_t)un * 8192 + 16 * w + fr;
#pragma unroll
        for (int db = 0; db < 4; ++db)
#pragma unroll
            for (int r = 0; r < 4; ++r) e[(16 * db + 4 * fq + r) * 128] = sb[db][r]; }
}
DEVI void conv_rows(Frame& F, bf16* proj, const float* cw, bf16* outb, int ldo) {
    const int lane = F.lane; float w0[8], w1[8], w2[8];
#pragma unroll
    for (int j = 0; j < 8; ++j) { w0[j] = cw[8 * lane + j]; w1[j] = cw[512 + 8 * lane + j]; w2[j] = cw[1024 + 8 * lane + j]; }
    for (int blk = F.gw(); blk < T / 4; blk += F.ngw()) {
        const int t0 = blk * 4, tb = t0 & ~(SEQ - 1); u32x4 xv[6], cv[6], bv[4];
#pragma unroll
        for (int i = 0; i < 6; ++i) { const int t = t0 - 2 + i; const bool ok = t >= tb; const bf16* r = proj + (size_t)(ok ? t : t0) * PROJ_LD + 8 * lane;
            xv[i] = *(const u32x4*)(r + C_XIN); cv[i] = *(const u32x4*)(r + C_CG); if (!ok) { xv[i] = (u32x4){0u, 0u, 0u, 0u}; } }
#pragma unroll
        for (int i = 0; i < 4; ++i) bv[i] = *(const u32x4*)(proj + (size_t)(t0 + i) * PROJ_LD + C_BG + 8 * lane);
        float u[6][8];
#pragma unroll
        for (int i = 0; i < 6; ++i)
#pragma unroll
            for (int q = 0; q < 4; ++q) { u[i][2 * q] = bflo(xv[i][q]) * bflo(cv[i][q]); u[i][2 * q + 1] = bfhi(xv[i][q]) * bfhi(cv[i][q]); }
#pragma unroll
        for (int i = 0; i < 4; ++i) { u32x4 ov;
#pragma unroll
            for (int q = 0; q < 4; ++q) { const float a0 = bflo(bv[i][q]) * (w0[2 * q] * u[i][2 * q] + w1[2 * q] * u[i + 1][2 * q] + w2[2 * q] * u[i + 2][2 * q]);
                const float a1 = bfhi(bv[i][q]) * (w0[2 * q + 1] * u[i][2 * q + 1] + w1[2 * q + 1] * u[i + 1][2 * q + 1] + w2[2 * q + 1] * u[i + 2][2 * q + 1]); ov[q] = cvt_pk_bf16(a0, a1); }
            *(u32x4*)(outb + (size_t)(t0 + i) * ldo + 8 * lane) = ov; }
    }
}
constexpr int XA_KP = 528, XA_VP = 544, XA_BUF = 64 * XA_VP;
static_assert(2 * XA_BUF <= RING_BYTES, "xattn LDS");
DEVI void xattn_unit(Frame& F, int un, const bf16* Q, const bf16* kvm, bf16* O) {
    const int bh = un >> 5, rb = un & 31, b = bh >> 2, h = bh & 3, lane = F.lane, w = F.wave, fr = lane & 15, fq = lane >> 4, tid = F.tid, q4 = (lane & 15) >> 2, p4 = lane & 3;
    const size_t q0 = (size_t)b * SEQ + rb * 128 + 16 * w;
    LAS unsigned char* L = F.lds;
    const bf16* kbase = kvm + (size_t)(b * MEML) * 2048 + h * XHD;
    bf16x8 qf[8];
#pragma unroll
    for (int ks = 0; ks < 8; ++ks) qf[ks] = *(const bf16x8*)(Q + (q0 + fr) * DM + h * XHD + 32 * ks + 8 * fq);
    u32x4 sr[4];
#define XA_LOAD(sl) do { const bf16* src_ = kbase + ((sl) >= 4 ? 1024 : 0) + (size_t)(((sl) & 3) * 64) * 2048; \
        _Pragma("unroll") for (int i = 0; i < 4; ++i) { const int idx = tid + 512 * i, row = idx >> 5, c = idx & 31; sr[i] = *(const u32x4*)(src_ + (size_t)row * 2048 + c * 8); } } while (0)
#define XA_WRITE(sl) do { const int pitch_ = (sl) >= 4 ? XA_VP : XA_KP; LAS unsigned char* dst_ = L + ((sl) & 1) * XA_BUF; \
        _Pragma("unroll") for (int i = 0; i < 4; ++i) { const int idx = tid + 512 * i, row = idx >> 5, c = idx & 31; *(LAS u32x4*)(dst_ + row * pitch_ + c * 16) = sr[i]; } } while (0)
    XA_LOAD(0); XA_WRITE(0);
    __syncthreads();
    f32x4 st[16];
#pragma unroll
    for (int j = 0; j < 4; ++j) {
        XA_LOAD(j + 1);
        const LAS unsigned char* kb_ = L + (j & 1) * XA_BUF + fr * XA_KP + 16 * fq;
#pragma unroll
        for (int kk = 0; kk < 4; ++kk) { f32x4 a = (f32x4){0.f, 0.f, 0.f, 0.f};
#pragma unroll
            for (int ks = 0; ks < 8; ++ks) { const bf16x8 kf = *(const LAS bf16x8*)(kb_ + 16 * kk * XA_KP + 64 * ks); a = MFMA16(kf, qf[ks], a); }
            st[4 * j + kk] = a; }
        XA_WRITE(j + 1);
        __syncthreads();
    }
    float mx = -3.0e38f;
#pragma unroll
    for (int kb = 0; kb < 16; ++kb) mx = fmaxf(fmaxf(fmaxf(mx, st[kb][0]), fmaxf(st[kb][1], st[kb][2])), st[kb][3]);
    mx = fmaxf(mx, __shfl_xor(mx, 16)); mx = fmaxf(mx, __shfl_xor(mx, 32));
    float sm = 0.f;
#pragma unroll
    for (int kb = 0; kb < 16; ++kb)
#pragma unroll
        for (int r = 0; r < 4; ++r) { const float p = exp2f(st[kb][r] - mx); st[kb][r] = p; sm += p; }
    sm += __shfl_xor(sm, 16); sm += __shfl_xor(sm, 32);
    bf16x8 pa[8];
#pragma unroll
    for (int s = 0; s < 8; ++s) pa[s] = pack_frag(st[2 * s], st[2 * s + 1]);
    f32x4 o[16];
#pragma unroll
    for (int d = 0; d < 16; ++d) o[d] = (f32x4){0.f, 0.f, 0.f, 0.f};
#pragma unroll
    for (int j = 4; j < 8; ++j) {
        if (j < 7) XA_LOAD(j + 1);
        const LAS unsigned char* vb_ = L + (j & 1) * XA_BUF + (4 * fq + q4) * XA_VP + 8 * p4;
#pragma unroll
        for (int s2 = 0; s2 < 2; ++s2)
#pragma unroll
            for (int d = 0; d < 16; ++d) { const bf16x8 vf = tr_frag(vb_ + 32 * s2 * XA_VP + 32 * d, vb_ + (32 * s2 + 16) * XA_VP + 32 * d); o[d] = MFMA16(pa[2 * (j - 4) + s2], vf, o[d]); }
        if (j < 7) XA_WRITE(j + 1);
        __syncthreads();
    }
#undef XA_LOAD
#undef XA_WRITE
    const float inv = 1.f / sm;
    LAS unsigned char* ot = L + w * (16 * XA_KP);
#pragma unroll
    for (int r = 0; r < 4; ++r) { const float iv = __shfl(inv, 4 * fq + r);
#pragma unroll
        for (int d = 0; d < 16; ++d) *(LAS bf16*)(ot + (4 * fq + r) * XA_KP + (16 * d + fr) * 2) = f2bf(o[d][r] * iv); }
    LDS_WAIT(); asm volatile("" ::: "memory");
    {   bf16* op = O + (q0 + (lane >> 2)) * DM + h * XHD + 64 * (lane & 3); const LAS unsigned char* rp = ot + (lane >> 2) * XA_KP + 128 * (lane & 3);
#pragma unroll
        for (int i = 0; i < 8; ++i) *(u32x4*)(op + 8 * i) = *(const LAS u32x4*)(rp + 16 * i); }
    __syncthreads();
}

constexpr int NPH = 14;
struct ArgsK { Args a; int li, pad; };
__global__ void __launch_bounds__(NTHR, 2) mega(ArgsK ak) {
    extern __shared__ __attribute__((aligned(16))) unsigned char lds_raw[];
    const Args& args = ak.a;
    Frame F; F.lds = (LAS unsigned char*)lds_raw; F.tid = threadIdx.x; F.lane = F.tid & 63; F.wave = __builtin_amdgcn_readfirstlane(F.tid >> 6);
    F.G = gridDim.x; { const int bx = blockIdx.x; F.vcu = (F.G % 8 == 0) ? (bx % 8) * (F.G / 8) + bx / 8 : bx; }
    unsigned char* ws = args.ws; gu32* ctl = (gu32*)(ws + WS_CTL);
    for (int u = F.tid; u < (LDS_BYTES - LDSCTL_OFF) / 4; u += NTHR) ((LAS unsigned*)(F.lds + LDSCTL_OFF))[u] = 0u;
    __syncthreads();
    const int lo = args.ph_lo, hi = args.ph_hi;
    XcdBarrier bar; bar.bar = (unsigned*)(ctl + CW_BAR) + ak.li * XCD_BAR_WORDS; bar.x = 0; bar.st = nullptr;
    if (hi - lo > 1) bar = xcd_barrier_post((unsigned*)(ctl + CW_BAR) + ak.li * XCD_BAR_WORDS, (volatile LAS unsigned*)(F.lds + MISC_OFF) + 8);
#ifndef PH_MASK
#define PH_MASK 0x3fff
#endif
#define IN(k) (((PH_MASK >> (k)) & 1) && lo <= (k) && (k) < hi)
#define SEAM(k) do { if (IN(k) && ((k) + 1 < hi)) xcd_barrier(bar); } while (0)
#ifndef PROBE_REP
#define PROBE_REP (-1)
#endif
#ifndef PROBE_N
#define PROBE_N 3
#endif
#define REP(k) for (int rep_ = 0; rep_ < ((k) == PROBE_REP ? PROBE_N : 1); ++rep_, ((k) == PROBE_REP && rep_ < PROBE_N ? xcd_barrier(bar) : (void)0))
    const int bx = (int)blockIdx.x;
    bf16* proj = (bf16*)(ws + WS_PROJ); bf16* xn = (bf16*)(ws + WS_XN); bf16* hb = (bf16*)(ws + WS_HB); float* H = args.out;
    float* ssq1 = (float*)(ws + WS_SSQ1); float* ssq2 = (float*)(ws + WS_SSQ2); const unsigned* cnt = (const unsigned*)(ws + WS_CTL) + CW_CNT;

    if (IN(0)) { REP(0) { p0_prologue(F, args, ws); } SEAM(0); }
    if (IN(1)) { REP(1) {
        SchedInproj S{F.G, bx, (const char*)xn, (const char*)(ws + WS_MN), (const char*)(ws + WS_WIN), (const char*)(ws + WS_WKV)};
        EpiProj E{proj, (bf16*)(ws + WS_KVM), (const float2*)(ws + WS_ROPE)};
        gemm_phase<EpiProj, SchedInproj, 0>(F.lds, S, E, DM, DM, DM / 64, 0);
        } SEAM(1);
    }
    if (IN(2)) { REP(2) {
        { const bool dm_ = (PROBE_REP == 2) && rep_ < PROBE_N - 1; conv_rows(F, proj, args.in[4], dm_ ? xn : proj + C_BG, dm_ ? 512 : PROJ_LD); }
        for (int un = F.vcu; un < 256; un += F.G) ret_unit<false>(F, un, proj, (float*)(ws + WS_E));
        } SEAM(2);
    }
    if (IN(3)) { REP(3) { for (int un = F.vcu; un < 256; un += F.G) ret_unit<true>(F, un, proj, (float*)(ws + WS_E)); } SEAM(3); }
    if (IN(4)) { REP(4) {
        SchedSimple S{F.G, bx, (const char*)(proj + C_BG), (const char*)(ws + WS_WCAT), PROJ_LD, 1536};
        EpiMerge E{proj, xn};
        gemm_phase<EpiMerge, SchedSimple, 8>(F.lds, S, E, PROJ_LD, 1536, 24, (C_G - C_BG - 512) * 2);
        } SEAM(4);
    }
    if (IN(5)) { REP(5) {
        SchedSimple S{F.G, bx, (const char*)xn, (const char*)(ws + WS_WMIX), DM, DM};
        EpiResid<false> E{args.in[0], hb, ssq1};
        gemm_phase<EpiResid<false>, SchedSimple, 0>(F.lds, S, E, DM, DM, DM / 64, 0);
        } SEAM(5);
    }
    if (IN(6)) { REP(6) {
        SchedSimple S{F.G, bx, (const char*)hb, (const char*)(ws + WS_WQ), DM, DM};
        EpiQ E{ssq1, xn};
        gemm_phase<EpiQ, SchedSimple, 0>(F.lds, S, E, DM, DM, DM / 64, 0);
        } SEAM(6);
    }
    if (IN(7)) { REP(7) { for (int un = F.vcu; un < 512; un += F.G) xattn_unit(F, un, xn, (const bf16*)(ws + WS_KVM), ((PROBE_REP == 7) && rep_ < PROBE_N - 1) ? hb : xn); } SEAM(7); }
    if (IN(8)) { REP(8) {
        SchedSimple S{F.G, bx, (const char*)xn, (const char*)(ws + WS_WO), DM, DM};
        EpiResid<true> E{hb, hb, ssq2};
        gemm_phase<EpiResid<true>, SchedSimple, 0>(F.lds, S, E, DM, DM, DM / 64, 0);
        } SEAM(8);
    }
    if (IN(9)) { REP(9) { p9_route(F, args, ws, ((PROBE_REP == 9) && rep_ < PROBE_N - 1) ? 1024 * (rep_ + 1) : 0); } SEAM(9); }
    if (IN(11)) { REP(11) {
        SchedMoe<true> S{F.G, bx, moe_table(F.lds, F.tid, cnt), (const LAS int*)(F.lds + TAB_OFF), (const unsigned long long*)(ws + WS_LID), (const char*)hb, (const char*)(ws + WS_EGU), DM, DM};
        EpiGU E{(const unsigned long long*)(ws + WS_LID), (const float*)(ws + WS_RS2), (bf16*)(ws + WS_HID)};
        gemm_phase<EpiGU, SchedMoe<true>, 0>(F.lds, S, E, DM, DM, DM / 64, 0);
        } SEAM(11);
    }
    if (IN(12)) { REP(12) {
        SchedMoe<false> S{F.G, bx, moe_table(F.lds, F.tid, cnt), (const LAS int*)(F.lds + TAB_OFF), (const unsigned long long*)(ws + WS_LID), (const char*)(ws + WS_HID), (const char*)(ws + WS_ED), EH, EH};
        EpiDown E{(const unsigned long long*)(ws + WS_LID), (bf16*)(ws + WS_XS)};
        gemm_phase<EpiDown, SchedMoe<false>, 0>(F.lds, S, E, EH, EH, EH / 64, 0);
        } SEAM(12);
    }
    if (IN(13)) { REP(13) { p13_final(F, args, ws); } }
#undef IN
#undef SEAM
}

#define MEGA_FUSE 1
static const int USE_MEGA[NPH] = {1, 1, 1, 1, 1, 1, 1, 1, 1, 1, 1, 1, 1, 1};
extern "C" void kernel_launch(void* const* d_in, const int* in_sizes, int n_in, void* d_out, int out_size, void* d_ws, size_t ws_size, hipStream_t stream) {
    if (n_in != 22 || out_size != T * DM || ws_size < WS_END) { fprintf(stderr, "kernel_launch: unexpected shapes (n_in %d out %d ws %zu)\n", n_in, out_size, ws_size); return; }
    static int grid = 0;
    if (grid == 0) {
        int dev = 0, cus = 0;
        if (hipGetDevice(&dev) != hipSuccess || hipDeviceGetAttribute(&cus, hipDeviceAttributeMultiprocessorCount, dev) != hipSuccess) { grid = -1; return; }
        if (hipFuncSetAttribute((const void*)mega, hipFuncAttributeMaxDynamicSharedMemorySize, LDS_BYTES) != hipSuccess) { fprintf(stderr, "kernel_launch: hipFuncSetAttribute failed\n"); grid = -1; return; }
        grid = cus;
        if (grid != 256) fprintf(stderr, "kernel_launch: %d CUs (built for 256)\n", grid);
    }
    if (grid < 0) return;
    const float* x = (const float*)d_in[0]; const float* mem = (const float*)d_in[1]; const float* mix_g = (const float*)d_in[2]; const float* w_in = (const float*)d_in[3];
    const float* conv_w = (const float*)d_in[4]; const float* w_conv_out = (const float*)d_in[5]; const float* w_ret_out = (const float*)d_in[6]; const float* w_mix_out = (const float*)d_in[7];
    const float* xa_g = (const float*)d_in[8]; const float* mem_g = (const float*)d_in[9]; const float* w_xa_q = (const float*)d_in[10]; const float* w_xa_kv = (const float*)d_in[11];
    const float* w_xa_o = (const float*)d_in[12]; const float* moe_g = (const float*)d_in[13]; const float* w_group = (const float*)d_in[14]; const float* b_group = (const float*)d_in[15];
    const float* w_router = (const float*)d_in[16]; const float* b_router = (const float*)d_in[17]; const float* w_gate = (const float*)d_in[18]; const float* w_up = (const float*)d_in[19];
    const float* w_down = (const float*)d_in[20]; const float* final_g = (const float*)d_in[21];
    char* ws = (char*)d_ws; float* H = (float*)d_out;
    unsigned* ctl = (unsigned*)(ws + WS_CTL); float2* rope = (float2*)(ws + WS_ROPE);
    bf16 *wcat = (bf16*)(ws + WS_WCAT), *wmix = (bf16*)(ws + WS_WMIX), *wq = (bf16*)(ws + WS_WQ), *wkv = (bf16*)(ws + WS_WKV), *wo = (bf16*)(ws + WS_WO), *wrt = (bf16*)(ws + WS_WRT);
    float *ssq1 = (float*)(ws + WS_SSQ1), *ssq2 = (float*)(ws + WS_SSQ2), *rs2 = (float*)(ws + WS_RS2), *lw = (float*)(ws + WS_LW), *rw = (float*)(ws + WS_RW), *rrs = (float*)(ws + WS_RRS);
    int *lid = (int*)(ws + WS_LID), *rid = (int*)(ws + WS_RID);
    bf16 *mn = (bf16*)(ws + WS_MN), *kvm = (bf16*)(ws + WS_KVM), *win = (bf16*)(ws + WS_WIN), *hid = (bf16*)(ws + WS_HID), *xn = (bf16*)(ws + WS_XN), *proj = (bf16*)(ws + WS_PROJ);
    bf16 *egu = (bf16*)(ws + WS_EGU), *ed = (bf16*)(ws + WS_ED), *xs = (bf16*)(ws + WS_XS), *hb = (bf16*)(ws + WS_HB);
    unsigned* cnt = ctl + CW_CNT;
    (void)hipMemsetAsync(ws + WS_CTL, 0, 1 * MiB, stream);
    ArgsK ak{}; for (int i = 0; i < 22; ++i) ak.a.in[i] = (const float*)d_in[i]; ak.a.out = H; ak.a.ws = (unsigned char*)d_ws;
    int nli = 0;
#if defined(PROBE_SPLIT)
    {   const int cuts[4][2] = {{0, PROBE_SPLIT + 1}, {PROBE_SPLIT, PROBE_SPLIT + 1}, {PROBE_SPLIT, PROBE_SPLIT + 1}, {PROBE_SPLIT + 1, NPH}};
        for (int i = 0; i < 4; ++i) { ak.a.ph_lo = cuts[i][0]; ak.a.ph_hi = cuts[i][1]; ak.li = nli++; ak.pad = 0; hipLaunchKernelGGL(mega, dim3(grid), dim3(NTHR), LDS_BYTES, stream, ak); }
        return; }
#endif
    for (int p = 0; p < NPH; ) {
        if (USE_MEGA[p]) { int q = p; while (q < NPH && USE_MEGA[q]) ++q;
#if !defined(MEGA_FUSE)
            q = p + 1;
#endif
            ak.a.ph_lo = p; ak.a.ph_hi = q; ak.li = nli++; ak.pad = 0;
            hipLaunchKernelGGL(mega, dim3(grid), dim3(NTHR), LDS_BYTES, stream, ak);
            p = q; continue; }
        switch (p) {
        case 0:
            k_transpose<<<dim3(PROJ_LD / 64, 16, 1), 256, 0, stream>>>(w_in, DM, PROJ_LD, win, DM, 0, nullptr, 1, 0, 0);
            k_transpose<<<dim3(16, 8, 1), 256, 0, stream>>>(w_conv_out, 512, DM, wcat, 1536, 0, nullptr, 0, 0, 0);
            k_transpose<<<dim3(16, 16, 1), 256, 0, stream>>>(w_ret_out, DM, DM, wcat, 1536, 512, nullptr, 0, 0, 0);
            k_transpose<<<dim3(16, 16, 1), 256, 0, stream>>>(w_mix_out, DM, DM, wmix, DM, 0, nullptr, 0, 0, 0);
            k_transpose<<<dim3(16, 16, 1), 256, 0, stream>>>(w_xa_q, DM, DM, wq, DM, 0, xa_g, 0, 0, 0);
            k_transpose<<<dim3(32, 16, 1), 256, 0, stream>>>(w_xa_kv, DM, 2048, wkv, DM, 0, nullptr, 0, 0, 0);
            k_transpose<<<dim3(16, 16, 1), 256, 0, stream>>>(w_xa_o, DM, DM, wo, DM, 0, nullptr, 0, 0, 0);
            k_zero_bf16<<<(48 * DM + 255) / 256, 256, 0, stream>>>(wrt, 48 * DM);
            k_transpose<<<dim3(1, 16, 1), 256, 0, stream>>>(w_group, DM, 4, wrt, DM, 0, moe_g, 0, 0, 0);
            k_transpose<<<dim3(1, 16, 1), 256, 0, stream>>>(w_router, DM, 32, wrt + 4 * DM, DM, 0, moe_g, 0, 0, 0);
            k_rmsnorm_bf16<<<T, 256, 0, stream>>>(x, mix_g, xn);
            k_rmsnorm_bf16<<<NB * MEML, 256, 0, stream>>>(mem, mem_g, mn);
            k_rope<<<SEQ * 32 / 256, 256, 0, stream>>>(rope);
            break;
        case 1:
            { P_inproj pp{DM, 0, xn, win, proj, rope}; k_ngemm<<<dim3(PROJ_LD / 64, T / 64), 256, 0, stream>>>(pp); }
            { P_plain pp{DM, 0, mn, wkv, kvm, DM, DM, 2048, 0}; k_ngemm<<<dim3(2048 / 64, NB * MEML / 64), 256, 0, stream>>>(pp); }
            break;
        case 2: k_conv<<<2 * (T / 16), 256, 0, stream>>>(proj, conv_w); break;
        case 3: k_ret_scan<<<NB * RH, 256, 0, stream>>>(proj, H); k_ret_gn<<<T, 256, 0, stream>>>(proj, H); break;
        case 4: { P_merge pp{512, 1024, proj, wcat, xn}; k_ngemm<<<dim3(DM / 64, T / 64), 256, 0, stream>>>(pp); } break;
        case 5: { P_resid pp{DM, 0, xn, wmix, x, H, hb}; k_ngemm<<<dim3(DM / 64, T / 64), 256, 0, stream>>>(pp); } k_rowssq<<<T, 256, 0, stream>>>(H, ssq1); break;
        case 6: { P_q pp{DM, 0, hb, wq, ssq1, xn}; k_ngemm<<<dim3(DM / 64, T / 64), 256, 0, stream>>>(pp); } break;
        case 7: k_xattn<<<T * XH, 256, 0, stream>>>(xn, kvm); break;
        case 8: { P_resid pp{DM, 0, xn, wo, H, H, hb}; k_ngemm<<<dim3(DM / 64, T / 64), 256, 0, stream>>>(pp); } k_rowssq<<<T, 256, 0, stream>>>(H, ssq2); break;
        case 9:
            k_transpose<<<dim3(8, 16, NE), 256, 0, stream>>>(w_gate, DM, EH, egu, DM, 0, moe_g, 2, (size_t)DM * EH, (size_t)1024 * DM);
            k_transpose<<<dim3(8, 16, NE), 256, 0, stream>>>(w_up, DM, EH, egu, DM, 0, moe_g, 3, (size_t)DM * EH, (size_t)1024 * DM);
            k_transpose<<<dim3(16, 8, NE), 256, 0, stream>>>(w_down, EH, DM, ed, EH, 0, nullptr, 0, (size_t)EH * DM, (size_t)1024 * EH);
            k_route<<<T / 64, 64, 0, stream>>>(hb, wrt, ssq2, b_group, b_router, rs2, cnt, lid, lw);
            break;
        case 10: k_gather<<<XS_ROWS, 256, 0, stream>>>(hb, cnt, lid, lw, rs2, xs, rid, rw, rrs); break;
        case 11: { P_gu pp{DM, DM, xs, egu, cnt, rrs, hid}; k_ngemm<<<dim3(EH / 64, XS_ROWS / 64), 256, 0, stream>>>(pp); } break;
        case 12: { P_down pp{EH, 0, hid, ed, cnt, rid, rw, xs}; k_ngemm<<<dim3(DM / 64, XS_ROWS / 64), 256, 0, stream>>>(pp); } break;
        case 13: k_final<<<T, 256, 0, stream>>>(H, xs, final_g); break;
        }
        ++p;
    }
}
```

```cpp
#include <hip/hip_runtime.h>
#include <cstdio>
#include <cstdint>

typedef unsigned short bf16;
#define DEVI __device__ __forceinline__

constexpr int DM = 1024, NB = 4, SEQ = 4096, T = NB * SEQ;
constexpr int PROJ_LD = 6656;
constexpr int C_XIN = 0, C_BG = 512, C_CG = 1024, C_Q = 1536, C_K = 2048, C_V = 2560, C_G = 3584, C_GC = 4608, C_GR = 5632;
constexpr int RH = 8, RDK = 64, RDV = 128, RCH = 128;
constexpr int MEML = 256, XH = 4, XHD = 256;
constexpr int NE = 32, EH = 512;
constexpr int XS_ROWS = 40960;
constexpr float EPS = 1e-6f;
constexpr float QSCALE = 0.0625f * 1.4426950408889634f;

constexpr size_t MiB = 1u << 20;
constexpr size_t WS_CTL = 0;
constexpr size_t WS_ROPE = 1 * MiB;
constexpr size_t WS_WCAT = 2 * MiB;
constexpr size_t WS_WMIX = 5 * MiB;
constexpr size_t WS_WQ = 7 * MiB;
constexpr size_t WS_WKV = 9 * MiB;
constexpr size_t WS_WO = 13 * MiB;
constexpr size_t WS_WRT = 15 * MiB;
constexpr size_t WS_SSQ1 = 16 * MiB;
constexpr size_t WS_SSQ2 = 17 * MiB;
constexpr size_t WS_RS2 = 18 * MiB;
constexpr size_t WS_LID = 19 * MiB;
constexpr size_t WS_LW = 21 * MiB;
constexpr size_t WS_LRS = 291 * MiB;
constexpr size_t WS_RID = 23 * MiB;
constexpr size_t WS_RW = WS_RID + 256 * 1024;
constexpr size_t WS_RRS = WS_RW + 256 * 1024;
constexpr size_t WS_MN = 24 * MiB;
constexpr size_t WS_KVM = 26 * MiB;
constexpr size_t WS_E = 30 * MiB;
constexpr size_t WS_WIN = 38 * MiB;
constexpr size_t WS_HID = 38 * MiB;
constexpr size_t WS_XN = 51 * MiB;
constexpr size_t WS_PROJ = 83 * MiB;
constexpr size_t WS_EGU = 83 * MiB;
constexpr size_t WS_ED = 147 * MiB;
constexpr size_t WS_XS = 179 * MiB;
constexpr size_t WS_HB = 259 * MiB;
constexpr size_t WS_END = 293 * MiB;
constexpr int CW_CNT = 1024, CNT_STRIDE = 32;

DEVI float bf2f(bf16 v) { return __uint_as_float((unsigned)v << 16); }
DEVI bf16 f2bf(float f) { unsigned u = __float_as_uint(f); return (bf16)((u + 0x7fffu + ((u >> 16) & 1u)) >> 16); }
DEVI float sigmoidf_(float x) { return 1.f / (1.f + __expf(-x)); }

__constant__ double c_invfreq[32] = {
    1.0, 0.7498942093324559, 0.5623413251903491, 0.4216965034285822, 0.31622776601683794, 0.23713737056616552,
    0.1778279410038923, 0.1333521432163324, 0.1, 0.07498942093324558, 0.05623413251903491, 0.04216965034285822,
    0.03162277660168379, 0.023713737056616554, 0.01778279410038923, 0.01333521432163324, 0.01, 0.007498942093324558,
    0.005623413251903491, 0.004216965034285823, 0.0031622776601683794, 0.0023713737056616554, 0.0017782794100389228,
    0.001333521432163324, 0.001, 0.0007498942093324559, 0.0005623413251903491, 0.0004216965034285823,
    0.00031622776601683794, 0.00023713737056616554, 0.00017782794100389227, 0.0001333521432163324};

DEVI float rstd_from_ssq(const float* ssq, int row) {
    const float4* p = (const float4*)(ssq + (size_t)row * 16); float s = 0.f;
#pragma unroll
    for (int i = 0; i < 4; ++i) { const float4 v = p[i]; s += (v.x + v.y) + (v.z + v.w); }
    return rsqrtf(s * (1.f / DM) + EPS);
}
#define LAS __attribute__((address_space(3)))
#define GAS __attribute__((address_space(1)))
typedef short bf16x8 __attribute__((ext_vector_type(8)));
typedef float f32x4 __attribute__((ext_vector_type(4)));
typedef float f32x2 __attribute__((ext_vector_type(2)));
typedef unsigned u32x4 __attribute__((ext_vector_type(4)));
typedef unsigned u32x2 __attribute__((ext_vector_type(2)));
typedef GAS unsigned gu32;
#define RLX_AGENT __ATOMIC_RELAXED, __HIP_MEMORY_SCOPE_AGENT
#define LDS_WAIT() asm volatile("s_waitcnt lgkmcnt(0)" ::: "memory")
#define VM_WAIT() asm volatile("s_waitcnt vmcnt(0)" ::: "memory")
constexpr int NWAVES = 8, NTHR = 512;
constexpr int RING_BYTES = 131072, LDSCTL_OFF = RING_BYTES, MISC_OFF = LDSCTL_OFF + 320, LDS_BYTES = 147456;
constexpr int CW_BAR = 4096;

#define XB_TMO      128
#define XB_XCNT(j)  (256  + 64 * (j))
#define XB_XSUB(j)  (1280 + 64 * (j))
#define XB_XGEN(j)  (2304 + 64 * (j))
#define XB_TOP      3328
#define XB_TOPGEN   3392
#define XCD_BAR_WORDS 3456
#define XB_SPIN_CAP (1u << 18)

__device__ __forceinline__ unsigned xb_ld(unsigned* p)              { return __hip_atomic_load(p, __ATOMIC_RELAXED, __HIP_MEMORY_SCOPE_AGENT); }
__device__ __forceinline__ unsigned xb_add(unsigned* p, unsigned v) { return __hip_atomic_fetch_add(p, v, __ATOMIC_RELAXED, __HIP_MEMORY_SCOPE_AGENT); }
__device__ __forceinline__ unsigned xb_xcc_id() { return (unsigned)__builtin_amdgcn_s_getreg((3 << 11) | 20) & 0xFu; }
#define XB_SPIN(cond, bar) do { unsigned _sp = 0; while (cond) { __builtin_amdgcn_s_sleep(1); \
    if ((++_sp & 255u) == 0u) { if (xb_ld(&(bar)[XB_TMO])) break; if (_sp > XB_SPIN_CAP) { atomicAdd(&(bar)[XB_TMO], 1u); break; } } } } while (0)

struct XcdBarrier {
    unsigned* bar; unsigned x;
    volatile LAS unsigned* st;
};

__device__ __forceinline__ XcdBarrier xcd_barrier_post(unsigned* bar, volatile LAS unsigned* st) {
    XcdBarrier b; b.bar = bar; b.x = xb_xcc_id(); b.st = st;
    if (threadIdx.x == 0) (void)xb_add(&bar[XB_XCNT(b.x)], 1u);
    return b;
}
__device__ __forceinline__ void xcd_barrier_complete(unsigned* bar, unsigned x, unsigned& nloc, unsigned& nx) {
    const unsigned G = gridDim.x * gridDim.y * gridDim.z;
    unsigned sum, cnt, mine, sp = 0u;
    for (;;) {
        sum = 0u; cnt = 0u; mine = 0u;
#pragma unroll
        for (unsigned j = 0; j < 16; ++j) { const unsigned c = xb_ld(&bar[XB_XCNT(j)]); sum += c; cnt += (c > 0u) ? 1u : 0u; mine = (j == x) ? c : mine; }
        if (sum == G) break;
        __builtin_amdgcn_s_sleep(1);
        if ((++sp & 255u) == 0u) { if (xb_ld(&bar[XB_TMO])) break; if (sp > XB_SPIN_CAP) { atomicAdd(&bar[XB_TMO], 1u); break; } }
    }
    nloc = mine > 0u ? mine : 1u; nx = cnt > 0u ? cnt : 1u;
}

__device__ __forceinline__ void xcd_barrier(const XcdBarrier& b) {
    asm volatile("s_waitcnt vmcnt(0)" ::: "memory");
    __syncthreads();
    if (threadIdx.x == 0) {
        unsigned* bar = b.bar;
        __builtin_amdgcn_s_waitcnt(0);
        unsigned nloc = b.st[0], nx = b.st[1];
        if (nloc == 0u) { xcd_barrier_complete(bar, b.x, nloc, nx); b.st[0] = nloc; b.st[1] = nx; }
        const unsigned old = xb_add(&bar[XB_XSUB(b.x)], 1u);
        const unsigned gen = old / nloc;
        if (old + 1u == (gen + 1u) * nloc) {
            __builtin_amdgcn_fence(__ATOMIC_RELEASE, "agent");
            asm volatile("s_waitcnt vmcnt(0)" ::: "memory");
            const unsigned og = xb_add(&bar[XB_TOP], 1u);
            const unsigned tg = og / nx;
            if (og + 1u == (tg + 1u) * nx) xb_add(&bar[XB_TOPGEN], 1u);
            else XB_SPIN(xb_ld(&bar[XB_TOPGEN]) == tg, bar);
            __builtin_amdgcn_fence(__ATOMIC_ACQUIRE, "agent");
            xb_add(&bar[XB_XGEN(b.x)], 1u);
            asm volatile("s_waitcnt vmcnt(0)" ::: "memory");
        } else {
            XB_SPIN(xb_ld(&bar[XB_XGEN(b.x)]) == gen, bar);
            __builtin_amdgcn_fence(__ATOMIC_ACQUIRE, "agent");
            asm volatile("s_waitcnt vmcnt(0)" ::: "memory");
        }
    }
    __syncthreads();
}


constexpr int BM = 256, BK = 64, HALF = 128, HTB = HALF * BK * 2, NXCD = 8, WGM = 8;
DEVI int lds_byte(int r, int c) { const int st = (r >> 4) * 2 + (c >> 5), rr = r & 15, cc = c & 31, ob = rr * 64 + cc * 2; return st * 1024 + (ob ^ (((ob >> 9) & 1) << 5)); }
DEVI void stage_rc(int b, int& R, int& C) { const int st = b / 1024, sb = b % 1024, swz = sb ^ (((sb >> 9) & 1) << 5); R = (st >> 1) * 16 + swz / 64; C = (st & 1) * 32 + (swz % 64) / 2; }
DEVI int perm32(int rho) { const int n = rho >> 4, i = rho & 15; return 8 * (i >> 2) + 4 * n + (i & 3); }
DEVI unsigned cvt_pk_bf16(float lo, float hi) { unsigned r; asm volatile("v_cvt_pk_bf16_f32 %0, %1, %2" : "=v"(r) : "v"(lo), "v"(hi)); return r; }
DEVI u32x4 pack8(const f32x4 a, const f32x4 b) { u32x4 w; w.x = cvt_pk_bf16(a[0], a[1]); w.y = cvt_pk_bf16(a[2], a[3]); w.z = cvt_pk_bf16(b[0], b[1]); w.w = cvt_pk_bf16(b[2], b[3]); return w; }
DEVI float bflo(unsigned w) { return __uint_as_float(w << 16); }
DEVI float bfhi(unsigned w) { return __uint_as_float(w & 0xffff0000u); }

DEVI unsigned launder(unsigned x) { asm volatile("" : "+v"(x)); return x; }
struct Unit { int pm, pn, e, lb, rem; };
DEVI bool tile_order(int L, int nM, int nN, int& pm, int& pn) {
    const int nwg = nM * nN; if (L >= nwg) return false;
    int wgid = L; { const int q = nwg / NXCD, r = nwg % NXCD, xcd = wgid % NXCD, off = wgid / NXCD; wgid = (xcd < r ? xcd * (q + 1) : r * (q + 1) + (xcd - r) * q) + off; }
    const int nig = WGM * nN, gid = wgid / nig, fm = gid * WGM, gsz = (nM - fm) < WGM ? (nM - fm) : WGM;
    pm = fm + ((wgid % nig) % gsz); pn = (wgid % nig) / gsz; return true;
}

template <class Epi, class Sched, int JT>
DEVI void gemm_phase(LAS unsigned char* lds, const Sched& S, const Epi& E, const int lda, const int ldb, const int nt, const int jumpA) {
    const int tid = threadIdx.x, wid = __builtin_amdgcn_readfirstlane(tid >> 6), lane = tid & 63, wr = wid >> 2, wc = wid & 3, fr = lane & 15, fq = lane >> 4;
    unsigned voffA[2], voffB[2];
#pragma unroll
    for (int i = 0; i < 2; ++i) { int R, C; stage_rc(tid * 16 + i * 8192, R, C); const int Rb = (R & ~31) + perm32(R & 31);
        voffA[i] = (unsigned)(R * lda + C) * 2u; voffB[i] = (unsigned)(Rb * ldb + C) * 2u; }
    const size_t kstep = (size_t)(BK * 2);
    const size_t hstepA = (size_t)HALF * lda * 2, hstepB = (size_t)HALF * ldb * 2;
    const unsigned ldsw = (unsigned)wid * 1024u;
    const int aoff = lds_byte(wr * 64 + fr, fq * 8), boff = lds_byte(wc * 32 + fr, fq * 8);
#define PG8_SA(b, h) (((b) * 2 + (h)) * HTB)
#define PG8_SB(b, h) ((4 + (b) * 2 + (h)) * HTB)
#define PG8_STAGE(bufoff, gbase, voff) do { _Pragma("unroll") for (int _i = 0; _i < 2; ++_i) \
        __builtin_amdgcn_global_load_lds((const unsigned*)((const char*)(gbase) + (voff)[_i]), (LAS unsigned*)(lds + (bufoff) + ldsw + _i * 8192), 16, 0, 0); } while (0)
#define PG8_LDA(dst, b, h) do { _Pragma("unroll") for (int m = 0; m < 4; ++m) _Pragma("unroll") for (int k = 0; k < 2; ++k) dst[m][k] = *(const LAS bf16x8*)(lds + PG8_SA(b, h) + aoff + m * 2048 + k * 1024); } while (0)
#define PG8_LDB(dst, b, h) do { _Pragma("unroll") for (int n = 0; n < 2; ++n) _Pragma("unroll") for (int k = 0; k < 2; ++k) dst[n][k] = *(const LAS bf16x8*)(lds + PG8_SB(b, h) + boff + n * 2048 + k * 1024); } while (0)
#define PG8_MMA(ai, bj, At, Bt) do { __builtin_amdgcn_s_setprio(1); _Pragma("unroll") for (int m = 0; m < 4; ++m) _Pragma("unroll") for (int n = 0; n < 2; ++n) _Pragma("unroll") for (int k = 0; k < 2; ++k) \
        acc[ai][bj][m][n] = __builtin_amdgcn_mfma_f32_16x16x32_bf16(Bt[n][k], At[m][k], acc[ai][bj][m][n], 0, 0, 0); __builtin_amdgcn_s_setprio(0); } while (0)
#define PG8_WAIT_V(n) asm volatile("s_waitcnt vmcnt(" #n ")" ::: "memory")
#define PG8_WAIT_L(n) asm volatile("s_waitcnt lgkmcnt(" #n ")" ::: "memory")
#define PG8_BAR __builtin_amdgcn_s_barrier()
#define PG8_SCHED __builtin_amdgcn_sched_barrier(0)
#define PG8_AK(t) ((size_t)(t) * kstep + ((JT > 0 && (t) >= JT) ? (size_t)jumpA : (size_t)0))
#define PG8_KBODY(t) do { \
            const bool last = (t == nt - 2); const bool ln_ = last && has_next; \
            const char* a1 = cA + PG8_AK(t + 1); \
            const char* a2 = last ? nA : cA + PG8_AK(t + 2); const char* b2 = last ? nB : cB + (size_t)(t + 2) * kstep; \
            const char* a3 = last ? nA + kstep : cA + PG8_AK(t + 3); const char* b3 = b2 + kstep; \
            PG8_LDB(B0, 0, 0); PG8_LDB(B1, 0, 1); PG8_SCHED; PG8_LDA(At, 0, 0); PG8_STAGE_A(PG8_SA(1, 1), a1, 1, false); \
            PG8_WAIT_V(8); PG8_WAIT_L(0); PG8_BAR; PG8_MMA(0, 0, At, B0); PG8_MMA(0, 1, At, B1); PG8_BAR; PG8_SCHED; \
            PG8_LDA(At, 0, 1); PG8_STAGE(PG8_SB(0, 0), b2, voffB); PG8_STAGE(PG8_SB(0, 1), b2 + hstepB, voffB); PG8_STAGE_A(PG8_SA(0, 0), a2, 0, ln_); \
            PG8_WAIT_V(8); PG8_WAIT_L(0); PG8_BAR; PG8_MMA(1, 0, At, B0); PG8_MMA(1, 1, At, B1); PG8_BAR; PG8_SCHED; \
            PG8_LDB(B0, 1, 0); PG8_LDB(B1, 1, 1); PG8_SCHED; PG8_LDA(At, 1, 0); PG8_STAGE_A(PG8_SA(0, 1), a2, 1, ln_); \
            PG8_WAIT_V(8); PG8_WAIT_L(0); PG8_BAR; PG8_MMA(0, 0, At, B0); PG8_MMA(0, 1, At, B1); PG8_BAR; PG8_SCHED; \
            PG8_LDA(At, 1, 1); PG8_STAGE(PG8_SB(1, 0), b3, voffB); PG8_STAGE(PG8_SB(1, 1), b3 + hstepB, voffB); PG8_STAGE_A(PG8_SA(1, 0), a3, 0, ln_); \
            PG8_WAIT_V(8); PG8_WAIT_L(0); PG8_BAR; PG8_MMA(1, 0, At, B0); PG8_MMA(1, 1, At, B1); PG8_BAR; PG8_SCHED; \
        } while (0)
    Unit cur, nxt; int ui = 0;
    if (!S.next(0, cur)) return;
    constexpr bool GATHER = Sched::GATHER;
    unsigned gvo[2][2], gnx[2][2];
#define PG8_GOFF(dst, u) do { _Pragma("unroll") for (int h_ = 0; h_ < 2; ++h_) _Pragma("unroll") for (int i_ = 0; i_ < 2; ++i_) { int R_, C_; stage_rc((int)launder((unsigned)tid) * 16 + i_ * 8192, R_, C_); dst[h_][i_] = S.gather_row(u, h_ * HALF + R_) * (unsigned)(lda * 2) + (unsigned)(C_ * 2); } } while (0)
#define PG8_STAGE2(bufoff, gbase, o0, o1) do { __builtin_amdgcn_global_load_lds((const unsigned*)((const char*)(gbase) + (o0)), (LAS unsigned*)(lds + (bufoff) + ldsw), 16, 0, 0); \
        __builtin_amdgcn_global_load_lds((const unsigned*)((const char*)(gbase) + (o1)), (LAS unsigned*)(lds + (bufoff) + ldsw + 8192), 16, 0, 0); } while (0)
#define PG8_STAGE_X(bufoff, gbase, voff) do { _Pragma("unroll") for (int _i = 0; _i < 2; ++_i) \
        __builtin_amdgcn_global_load_lds((const unsigned*)((const char*)(gbase) + (voff)[_i]), (LAS unsigned*)(lds + (bufoff) + ldsw + _i * 8192), 16, 0, Sched::A_AUX); } while (0)
#define PG8_STAGE_A(bufoff, gptr, half, usenext) do { if constexpr (GATHER) { const unsigned o0_ = (usenext) ? gnx[half][0] : gvo[half][0], o1_ = (usenext) ? gnx[half][1] : gvo[half][1]; PG8_STAGE2(bufoff, gptr, o0_, o1_); } \
        else { PG8_STAGE_X(bufoff, (gptr) + (half) * hstepA, voffA); } } while (0)
    if constexpr (GATHER) { PG8_GOFF(gvo, cur); }
    f32x4 acc[2][2][4][2];
#pragma unroll
    for (int a = 0; a < 2; ++a)
#pragma unroll
        for (int b = 0; b < 2; ++b)
#pragma unroll
            for (int m = 0; m < 4; ++m)
#pragma unroll
                for (int n = 0; n < 2; ++n) acc[a][b][m][n] = (f32x4){0.f, 0.f, 0.f, 0.f};
    bf16x8 At[4][2], B0[2][2], B1[2][2];
    const char* cA = S.abase(cur); const char* cB = S.bbase(cur);
    PG8_STAGE(PG8_SB(0, 0), cB, voffB); PG8_STAGE(PG8_SB(0, 1), cB + hstepB, voffB); PG8_STAGE_A(PG8_SA(0, 0), cA, 0, false); PG8_STAGE_A(PG8_SA(0, 1), cA, 1, false);
    if (wr == 1) PG8_BAR;
    PG8_WAIT_V(2); PG8_BAR;
    PG8_STAGE(PG8_SB(1, 0), cB + kstep, voffB); PG8_STAGE_A(PG8_SA(1, 0), cA + kstep, 0, false); PG8_STAGE(PG8_SB(1, 1), cB + hstepB + kstep, voffB);
    PG8_WAIT_V(6); PG8_BAR;
    for (;;) {
        const bool has_next = S.next(ui + 1, nxt);
        const char* nA = has_next ? S.abase(nxt) : cA; const char* nB = has_next ? S.bbase(nxt) : cB;
        if constexpr (GATHER) { if (has_next) PG8_GOFF(gnx, nxt); }
        if constexpr (JT > 0) {
            for (int t = 0; t < JT; t += 2) PG8_KBODY(t);
            E.mid(acc, cur, wr, wc, fr, fq);
            for (int t = JT; t < nt; t += 2) PG8_KBODY(t);
        } else {
            for (int t = 0; t < nt; t += 2) PG8_KBODY(t);
        }
        if (wr == 0) PG8_BAR;
        E(acc, cur, wr, wc, fr, fq);
        if (!has_next) break;
#pragma unroll
        for (int a = 0; a < 2; ++a)
#pragma unroll
            for (int b = 0; b < 2; ++b)
#pragma unroll
                for (int m = 0; m < 4; ++m)
#pragma unroll
                    for (int n = 0; n < 2; ++n) acc[a][b][m][n] = (f32x4){0.f, 0.f, 0.f, 0.f};
        cur = nxt; cA = nA; cB = nB; ++ui;
        if constexpr (GATHER) { gvo[0][0] = gnx[0][0]; gvo[0][1] = gnx[0][1]; gvo[1][0] = gnx[1][0]; gvo[1][1] = gnx[1][1]; }
        if (wr == 1) PG8_BAR;
    }
    PG8_WAIT_V(0);
    PG8_BAR;
#undef PG8_SA
#undef PG8_SB
#undef PG8_STAGE
#undef PG8_LDA
#undef PG8_LDB
#undef PG8_MMA
#undef PG8_WAIT_V
#undef PG8_WAIT_L
#undef PG8_BAR
#undef PG8_SCHED
#undef PG8_AK
#undef PG8_KBODY
#undef PG8_GOFF
#undef PG8_STAGE2
#undef PG8_STAGE_A
#undef PG8_STAGE_X
}

struct SchedInproj {
    static constexpr bool GATHER = false; static constexpr int A_AUX = 0; DEVI unsigned gather_row(const Unit&, int) const { return 0u; }
    int G, c; const char *xn, *mn, *win, *wkv;
    DEVI bool next(int i, Unit& u) const {
        const int L = i * G + c;
        if (L < 64 * 26) { u.e = 0; return tile_order(L, 64, 26, u.pm, u.pn); }
        const int r = L - 64 * 26; if (r >= 32) return false;
        u.e = 1; u.pm = r & 3; u.pn = r >> 2; return true;
    }
    DEVI const char* abase(const Unit& u) const { return (u.e ? mn : xn) + (size_t)u.pm * (256 * DM * 2); }
    DEVI const char* bbase(const Unit& u) const { return (u.e ? wkv : win) + (size_t)u.pn * (256 * DM * 2); }
};
struct SchedSimple {
    static constexpr bool GATHER = false; static constexpr int A_AUX = 0; DEVI unsigned gather_row(const Unit&, int) const { return 0u; }
    int G, c; const char *A, *B; int lda, ldb;
    DEVI bool next(int i, Unit& u) const { u.e = 0; return tile_order(i * G + c, 64, 4, u.pm, u.pn); }
    DEVI const char* abase(const Unit& u) const { return A + (size_t)u.pm * 256 * lda * 2; }
    DEVI const char* bbase(const Unit& u) const { return B + (size_t)u.pn * 256 * ldb * 2; }
};
constexpr int TAB_OFF = LDSCTL_OFF + 1024;
template <bool GATHER_> struct SchedMoe {
    static constexpr bool GATHER = GATHER_;
    static constexpr int A_AUX = GATHER_ ? 0 : 16;
    int G, c, ntile; const LAS int* tab; const unsigned long long* lrec; const char *A, *B; int lda, ldb;
    DEVI bool next(int i, Unit& u) const { if (!tile_order(i * G + c, ntile, 4, u.pm, u.pn)) return false;
        const LAS int* t = tab + 4 * u.pm; u.e = __builtin_amdgcn_readfirstlane(t[0]); u.lb = __builtin_amdgcn_readfirstlane(t[1]); u.rem = __builtin_amdgcn_readfirstlane(t[2]); return true; }
    DEVI const char* abase(const Unit& u) const { return GATHER_ ? A : A + (size_t)u.pm * 256 * lda * 2; }
    DEVI const char* bbase(const Unit& u) const { return B + ((size_t)u.e * 1024 + u.pn * 256) * ldb * 2; }
    DEVI unsigned gather_row(const Unit& u, int r) const { return r < u.rem ? ((unsigned)__hip_atomic_load(lrec + u.lb + r, __ATOMIC_RELAXED, __HIP_MEMORY_SCOPE_AGENT) >> 1) : 0u; }
};
DEVI int moe_table(LAS unsigned char* lds, int tid_, const unsigned* cnt) {
    LAS int* tab = (LAS int*)(lds + TAB_OFF); int ts = 0, me = -1, mlb = 0, mrem = 0;
    for (int e = 0; e < NE; ++e) { const int c = (int)__hip_atomic_load(cnt + e * CNT_STRIDE, __ATOMIC_RELAXED, __HIP_MEMORY_SCOPE_AGENT), nt = (c + 255) >> 8;
        if (tid_ >= ts && tid_ < ts + nt) { me = e; mlb = e * 16384 + (tid_ - ts) * 256; mrem = c - (tid_ - ts) * 256; } ts += nt; }
    if (me >= 0) { tab[4 * tid_ + 0] = me; tab[4 * tid_ + 1] = mlb; tab[4 * tid_ + 2] = mrem; tab[4 * tid_ + 3] = 0; }
    __syncthreads();
    return __builtin_amdgcn_readfirstlane(ts);
}
DEVI int moe_ntiles(const unsigned* cnt) { int ts = 0; for (int e = 0; e < NE; ++e) ts += ((int)cnt[e * CNT_STRIDE] + 255) >> 8; return ts; }

typedef f32x4 Acc[2][2][4][2];
#define EPI_FENCE() asm volatile("" ::: "memory")
#define ROT2(V, I, C, J) do { const float t1_ = V[I], t2_ = V[I + 1]; V[I] = (t1_ * C[J] - t2_ * C[J + 1]) * sc; V[I + 1] = (t1_ * C[J + 1] + t2_ * C[J]) * sc; } while (0)
#define ROWOFF(ai, m, ld, esz) ((unsigned)(((ai) * 128 + (m) * 16) * (ld) * (esz)))
struct EpiProj {
    bf16* proj; bf16* kvm; const float2* rope;
    DEVI void mid(Acc&, const Unit&, int, int, int, int) const {}
    DEVI void operator()(const Acc& acc, const Unit& u, int wr, int wc, int fr, int fq) const {
        const int row0 = u.pm * 256 + wr * 64 + fr, cl = wc * 32 + 8 * fq;
        if (u.e) {
            const unsigned lo = launder((unsigned)(row0 * 2048 + u.pn * 256 + cl) * 2u); char* base = (char*)kvm;
#pragma unroll
            for (int ai = 0; ai < 2; ++ai)
#pragma unroll
                for (int m = 0; m < 4; ++m) {
#pragma unroll
                    for (int bj = 0; bj < 2; ++bj) *(u32x4*)(base + lo + ROWOFF(ai, m, 2048, 2) + bj * 256) = pack8(acc[ai][bj][m][0], acc[ai][bj][m][1]); }
        } else {
            const bool rot = (u.pn >= 6) && (u.pn < 10), kq = (u.pn >= 8), gate = (u.pn >= 18);
            float lgk[2];
#pragma unroll
            for (int bj = 0; bj < 2; ++bj) { const int hh = ((u.pn & 1) * 256 + bj * 128 + cl) >> 6; lgk[bj] = __log2f(1.f - exp2f(-5.f - (float)hh)); }
            const unsigned lo = launder((unsigned)(row0 * PROJ_LD + u.pn * 256 + cl) * 2u); char* base = (char*)proj;
            const unsigned ro = launder((unsigned)((row0 & (SEQ - 1)) * 32 + ((cl & 63) >> 1)) * 8u); const char* rbase = (const char*)rope;
#pragma unroll
            for (int ai = 0; ai < 2; ++ai)
#pragma unroll
                for (int m = 0; m < 4; ++m) {
                    f32x4 c01 = (f32x4){1.f, 0.f, 1.f, 0.f}, c23 = c01;
                    if (rot) { const f32x4* tp = (const f32x4*)(rbase + ro + ROWOFF(ai, m, 32, 8)); c01 = tp[0]; c23 = tp[1]; }
                    const float pe = (float)(127 - ((fr + m * 16) & 127));
#pragma unroll
                    for (int bj = 0; bj < 2; ++bj) { f32x4 v0 = acc[ai][bj][m][0], v1 = acc[ai][bj][m][1];
                        if (rot) { const float e_ = exp2f((pe - (float)(wr * 64)) * (kq ? lgk[bj] : -lgk[bj])); const float sc = kq ? 0.125f * e_ : e_;
                            ROT2(v0, 0, c01, 0); ROT2(v0, 2, c01, 2); ROT2(v1, 0, c23, 0); ROT2(v1, 2, c23, 2); }
                        if (gate) {
#pragma unroll
                            for (int q = 0; q < 4; ++q) { v0[q] = __builtin_amdgcn_rcpf(1.f + __expf(-v0[q])); v1[q] = __builtin_amdgcn_rcpf(1.f + __expf(-v1[q])); } }
                        *(u32x4*)(base + lo + ROWOFF(ai, m, PROJ_LD, 2) + bj * 256) = pack8(v0, v1); }
                    if (m & 1) EPI_FENCE(); }
        }
    }
};
struct EpiMerge {
    const bf16* proj; bf16* mrg;
    DEVI void mid(Acc& acc, const Unit& u, int wr, int wc, int fr, int fq) const {
        const int row0 = u.pm * 256 + wr * 64 + fr, cl = wc * 32 + 8 * fq;
        const unsigned lo = launder((unsigned)(row0 * PROJ_LD + u.pn * 256 + cl) * 2u); const char* base = (const char*)proj;
#pragma unroll
        for (int ai = 0; ai < 2; ++ai)
#pragma unroll
            for (int m = 0; m < 4; ++m) { const char* rp = base + lo + ROWOFF(ai, m, PROJ_LD, 2);
#pragma unroll
                for (int bj = 0; bj < 2; ++bj) { const u32x4 gc = *(const u32x4*)(rp + C_GC * 2 + bj * 256), gr = *(const u32x4*)(rp + C_GR * 2 + bj * 256);
#pragma unroll
                    for (int q = 0; q < 2; ++q) { acc[ai][bj][m][0][2 * q] *= bflo(gc[q]) * __builtin_amdgcn_rcpf(bflo(gr[q])); acc[ai][bj][m][0][2 * q + 1] *= bfhi(gc[q]) * __builtin_amdgcn_rcpf(bfhi(gr[q]));
                        acc[ai][bj][m][1][2 * q] *= bflo(gc[2 + q]) * __builtin_amdgcn_rcpf(bflo(gr[2 + q])); acc[ai][bj][m][1][2 * q + 1] *= bfhi(gc[2 + q]) * __builtin_amdgcn_rcpf(bfhi(gr[2 + q])); } }
                EPI_FENCE(); }
    }
    DEVI void operator()(const Acc& acc, const Unit& u, int wr, int wc, int fr, int fq) const {
        const int row0 = u.pm * 256 + wr * 64 + fr, cl = wc * 32 + 8 * fq;
        const unsigned lo = launder((unsigned)(row0 * PROJ_LD + u.pn * 256 + cl) * 2u); const char* base = (const char*)proj;
        const unsigned oo = launder((unsigned)(row0 * DM + u.pn * 256 + cl) * 2u); char* ob = (char*)mrg;
#pragma unroll
        for (int ai = 0; ai < 2; ++ai)
#pragma unroll
            for (int m = 0; m < 4; ++m) { const char* rp = base + lo + ROWOFF(ai, m, PROJ_LD, 2); char* op = ob + oo + ROWOFF(ai, m, DM, 2);
#pragma unroll
                for (int bj = 0; bj < 2; ++bj) { const u32x4 gr = *(const u32x4*)(rp + C_GR * 2 + bj * 256); f32x4 v0 = acc[ai][bj][m][0], v1 = acc[ai][bj][m][1];
#pragma unroll
                    for (int q = 0; q < 2; ++q) { v0[2 * q] *= bflo(gr[q]); v0[2 * q + 1] *= bfhi(gr[q]); v1[2 * q] *= bflo(gr[2 + q]); v1[2 * q + 1] *= bfhi(gr[2 + q]); }
                    *(u32x4*)(op + bj * 256) = pack8(v0, v1); }
                EPI_FENCE(); }
    }
};
template <bool BASE_BF16> struct EpiResid {
    const void* base; bf16* HB; float* ssq;
    DEVI void mid(Acc&, const Unit&, int, int, int, int) const {}
    DEVI void operator()(const Acc& acc, const Unit& u, int wr, int wc, int fr, int fq) const {
        const int row0 = u.pm * 256 + wr * 64 + fr, cl = wc * 32 + 8 * fq;
        const unsigned eo = launder((unsigned)(row0 * DM + u.pn * 256 + cl)); const unsigned so = launder((unsigned)(row0 * 16 + u.pn * 4 + wc) * 4u);
        const char* bb = (const char*)base; char* hbb = (char*)HB; char* sb = (char*)ssq;
#pragma unroll
        for (int ai = 0; ai < 2; ++ai)
#pragma unroll
            for (int m = 0; m < 4; ++m) { const unsigned o4 = eo * 4u + ROWOFF(ai, m, DM, 4), o2 = eo * 2u + ROWOFF(ai, m, DM, 2); float ss = 0.f;
#pragma unroll
                for (int bj = 0; bj < 2; ++bj) { f32x4 b0, b1;
                    if (BASE_BF16) { const u32x4 bw = *(const u32x4*)(bb + o2 + bj * 256); b0 = (f32x4){bflo(bw.x), bfhi(bw.x), bflo(bw.y), bfhi(bw.y)}; b1 = (f32x4){bflo(bw.z), bfhi(bw.z), bflo(bw.w), bfhi(bw.w)}; }
                    else { b0 = *(const f32x4*)(bb + o4 + bj * 512); b1 = *(const f32x4*)(bb + o4 + bj * 512 + 16); }
                    const f32x4 v0 = b0 + acc[ai][bj][m][0], v1 = b1 + acc[ai][bj][m][1];
                    *(u32x4*)(hbb + o2 + bj * 256) = pack8(v0, v1);
                    ss += (v0[0] * v0[0] + v0[1] * v0[1]) + (v0[2] * v0[2] + v0[3] * v0[3]) + (v1[0] * v1[0] + v1[1] * v1[1]) + (v1[2] * v1[2] + v1[3] * v1[3]); }
                ss += __shfl_xor(ss, 16); ss += __shfl_xor(ss, 32);
                if (fq == 0) *(float*)(sb + so + ROWOFF(ai, m, 16, 4)) = ss;
                EPI_FENCE(); }
    }
};
struct EpiQ {
    const float* ssq; bf16* Q;
    DEVI void mid(Acc&, const Unit&, int, int, int, int) const {}
    DEVI void operator()(const Acc& acc, const Unit& u, int wr, int wc, int fr, int fq) const {
        const int row0 = u.pm * 256 + wr * 64 + fr, cl = wc * 32 + 8 * fq;
        const unsigned oo = launder((unsigned)(row0 * DM + u.pn * 256 + cl) * 2u); const unsigned so = launder((unsigned)(row0 * 16) * 4u); char* ob = (char*)Q; const char* sb = (const char*)ssq;
#pragma unroll
        for (int ai = 0; ai < 2; ++ai)
#pragma unroll
            for (int m = 0; m < 4; ++m) { const f32x4* p = (const f32x4*)(sb + so + ROWOFF(ai, m, 16, 4)); float t = 0.f;
#pragma unroll
                for (int i = 0; i < 4; ++i) { const f32x4 v = p[i]; t += (v[0] + v[1]) + (v[2] + v[3]); }
                const float s = rsqrtf(t * (1.f / DM) + EPS) * QSCALE; char* op = ob + oo + ROWOFF(ai, m, DM, 2);
#pragma unroll
                for (int bj = 0; bj < 2; ++bj) *(u32x4*)(op + bj * 256) = pack8(acc[ai][bj][m][0] * s, acc[ai][bj][m][1] * s);
                if (m & 1) EPI_FENCE(); }
    }
};
struct EpiGU {
    const unsigned long long* lrec; const float* rs2; bf16* HID;
    DEVI void mid(Acc&, const Unit&, int, int, int, int) const {}
    DEVI void operator()(const Acc& acc, const Unit& u, int wr, int wc, int fr, int fq) const {
        const int rt = wr * 64 + fr, row0 = u.pm * 256 + rt, cl = wc * 32 + 8 * fq;
        const unsigned oo = launder((unsigned)(row0 * EH + u.pn * 128 + cl) * 2u); const unsigned so = launder((unsigned)(u.lb + rt) * 8u); char* ob = (char*)HID; const char* sb = (const char*)lrec;
#pragma unroll
        for (int ai = 0; ai < 2; ++ai)
#pragma unroll
            for (int m = 0; m < 4; ++m) { const bool real = rt + ai * 128 + m * 16 < u.rem; float rs = 0.f;
                if (real) { const unsigned id = (unsigned)__hip_atomic_load((const unsigned long long*)(sb + so + ROWOFF(ai, m, 1, 8)), __ATOMIC_RELAXED, __HIP_MEMORY_SCOPE_AGENT); rs = rs2[id >> 1]; }
                f32x4 h[2];
#pragma unroll
                for (int n = 0; n < 2; ++n)
#pragma unroll
                    for (int q = 0; q < 4; ++q) { const float g = acc[ai][0][m][n][q] * rs, up = acc[ai][1][m][n][q] * rs; h[n][q] = g * sigmoidf_(g) * up; }
                *(u32x4*)(ob + oo + ROWOFF(ai, m, EH, 2)) = pack8(h[0], h[1]);
                if (m & 1) EPI_FENCE(); }
    }
};
struct EpiDown {
    const unsigned long long* lrec; bf16* YB;
    DEVI void mid(Acc&, const Unit&, int, int, int, int) const {}
    DEVI void operator()(const Acc& acc, const Unit& u, int wr, int wc, int fr, int fq) const {
        const int rt = wr * 64 + fr, cl = wc * 32 + 8 * fq;
        const unsigned so = launder((unsigned)(u.lb + rt) * 8u); const unsigned co = launder((unsigned)(u.pn * 256 + cl) * 2u); const char* sb = (const char*)lrec; char* ob = (char*)YB;
#pragma unroll
        for (int ai = 0; ai < 2; ++ai)
#pragma unroll
            for (int m = 0; m < 4; ++m) { const bool real = rt + ai * 128 + m * 16 < u.rem;
                if (real) { const unsigned long long rec = __hip_atomic_load((const unsigned long long*)(sb + so + ROWOFF(ai, m, 1, 8)), __ATOMIC_RELAXED, __HIP_MEMORY_SCOPE_AGENT);
                    const unsigned id = (unsigned)rec; const float w = __uint_as_float((unsigned)(rec >> 32)); char* op = ob + (size_t)id * (DM * 2) + co;
#pragma unroll
                    for (int bj = 0; bj < 2; ++bj) *(u32x4*)(op + bj * 256) = pack8(acc[ai][bj][m][0] * w, acc[ai][bj][m][1] * w); }
                if (m & 1) EPI_FENCE(); }
    }
};

struct Args { const float* in[22]; float* out; unsigned char* ws; int ph_lo, ph_hi; };
struct Frame {
    LAS unsigned char* lds; int tid, lane, wave, vcu, G;
    DEVI int gw() const { return vcu * NWAVES + wave; }
    DEVI int ngw() const { return G * NWAVES; }
};
DEVI float wave_sum(float v) {
#pragma unroll
    for (int o = 1; o < 64; o <<= 1) v += __shfl_xor(v, o);
    return v;
}
DEVI unsigned pk2(float lo, float hi) { return (unsigned)f2bf(lo) | ((unsigned)f2bf(hi) << 16); }
DEVI int wt_rowmap(int n, int mode) {
    if (mode == 1) { if (n >= C_Q && n < C_V) { const int o = n & 63; return (n & ~63) + 2 * (o & 31) + (o >> 5); } return n; }
    if (mode == 2) return (n >> 7) * 256 + (n & 127);
    if (mode == 3) return (n >> 7) * 256 + 128 + (n & 127);
    return n;
}
DEVI void transpose_item(const float* W, int K, int N, bf16* WT, int ldwt, int koff, const float* kscale, int mode, LAS float* scr, int item, int lane) {
    const int nblk = N / 32, kb = item / nblk, nb = item % nblk, k0 = 64 * kb, n0 = 32 * nb;
#pragma unroll 8
    for (int i = 0; i < 32; ++i) { const int kk = 2 * i + (lane >> 5); float v = W[(size_t)(k0 + kk) * N + n0 + (lane & 31)]; if (kscale) v *= kscale[k0 + kk]; scr[kk * 33 + (lane & 31)] = v; }
    LDS_WAIT(); asm volatile("" ::: "memory");
    const int c = lane & 7;
#pragma unroll
    for (int j = 0; j < 4; ++j) { const int n = (lane >> 3) + 8 * j; const LAS float* s = scr + (8 * c) * 33 + n;
        u32x4 o; o.x = pk2(s[0 * 33], s[1 * 33]); o.y = pk2(s[2 * 33], s[3 * 33]); o.z = pk2(s[4 * 33], s[5 * 33]); o.w = pk2(s[6 * 33], s[7 * 33]);
        *(u32x4*)(WT + (size_t)wt_rowmap(n0 + n, mode) * ldwt + koff + k0 + 8 * c) = o; }
    LDS_WAIT(); asm volatile("" ::: "memory");
}
DEVI void rms_row_to_bf16(const float* xrow, const float* g, bf16* orow, int lane) {
    const f32x4* xr = (const f32x4*)xrow + lane; const f32x4* gr = (const f32x4*)g + lane;
    f32x4 v[4]; float s = 0.f;
#pragma unroll
    for (int j = 0; j < 4; ++j) { v[j] = xr[64 * j]; s += (v[j].x * v[j].x + v[j].y * v[j].y) + (v[j].z * v[j].z + v[j].w * v[j].w); }
    const float rstd = rsqrtf(wave_sum(s) * (1.f / DM) + EPS);
    unsigned long long* o8 = (unsigned long long*)orow + lane;
#pragma unroll
    for (int j = 0; j < 4; ++j) { const f32x4 gg = gr[64 * j]; o8[64 * j] = (unsigned long long)pk2(v[j].x * rstd * gg.x, v[j].y * rstd * gg.y) | ((unsigned long long)pk2(v[j].z * rstd * gg.z, v[j].w * rstd * gg.w) << 32); }
}

#define MFMA16(a, b, c) __builtin_amdgcn_mfma_f32_16x16x32_bf16((a), (b), (c), 0, 0, 0)
typedef short v4i16_t __attribute__((ext_vector_type(4)));
DEVI bf16x8 tr_frag(const LAS unsigned char* p0, const LAS unsigned char* p1) {
    const v4i16_t a = __builtin_amdgcn_ds_read_tr16_b64_v4i16((LAS v4i16_t*)p0), b = __builtin_amdgcn_ds_read_tr16_b64_v4i16((LAS v4i16_t*)p1);
    return (bf16x8){a[0], a[1], a[2], a[3], b[0], b[1], b[2], b[3]};
}
constexpr int TI_P = 144, TI_BYTES = 64 * TI_P;
DEVI void transpose_item64(const float* W, int K, int N, bf16* WT, int ldwt, int koff, const float* kscale, int mode, LAS unsigned char* scr, int item, int lane) {
    const int nblk = N >> 6, kb = item / nblk, nb = item - kb * nblk, k0 = 64 * kb, n0 = 64 * nb;
    const int kr = lane >> 4, nc = 4 * (lane & 15);
    const float* src = W + (size_t)(k0 + kr) * N + n0 + nc;
    f32x4 v[16];
#pragma unroll
    for (int i = 0; i < 16; ++i) v[i] = __builtin_nontemporal_load((const f32x4*)(src + (size_t)(4 * i) * N));
#pragma unroll
    for (int i = 0; i < 16; ++i) { f32x4 t = v[i]; if (kscale) t = t * kscale[k0 + 4 * i + kr];
        u32x2 w; w.x = cvt_pk_bf16(t[0], t[1]); w.y = cvt_pk_bf16(t[2], t[3]); *(LAS u32x2*)(scr + (4 * i + kr) * TI_P + nc * 2) = w; }
    LDS_WAIT(); asm volatile("" ::: "memory");
    const int g = lane >> 4, q4 = (lane & 15) >> 2, p4 = lane & 3, ii = lane & 15;
    const LAS unsigned char* rb = scr + (8 * g + q4) * TI_P + 8 * p4;
#pragma unroll
    for (int c = 0; c < 4; ++c) { bf16* drow = WT + (size_t)wt_rowmap(n0 + 16 * c + ii, mode) * ldwt + koff + k0 + 8 * g;
#pragma unroll
        for (int kh = 0; kh < 2; ++kh) { const bf16x8 v = tr_frag(rb + 32 * kh * TI_P + 32 * c, rb + (32 * kh + 4) * TI_P + 32 * c); *(bf16x8*)(drow + 32 * kh) = v; } }
    LDS_WAIT(); asm volatile("" ::: "memory");
}

DEVI void p0_prologue(Frame& F, const Args& a, unsigned char* ws) {
    LAS unsigned char* scr = F.lds + F.wave * TI_BYTES;
    const int gw = F.gw(), NGW = F.ngw();
    const float* w_in = a.in[3]; const float* w_conv_out = a.in[5]; const float* w_ret_out = a.in[6]; const float* w_mix_out = a.in[7];
    const float* xa_g = a.in[8]; const float* w_xa_q = a.in[10]; const float* w_xa_kv = a.in[11]; const float* w_xa_o = a.in[12]; const float* moe_g = a.in[13];
    bf16 *win = (bf16*)(ws + WS_WIN), *wcat = (bf16*)(ws + WS_WCAT), *wmix = (bf16*)(ws + WS_WMIX), *wq = (bf16*)(ws + WS_WQ), *wkv = (bf16*)(ws + WS_WKV), *wo = (bf16*)(ws + WS_WO), *wrt = (bf16*)(ws + WS_WRT);
    constexpr int I_IN = 16 * 104, I_C = 8 * 16, I_S = 16 * 16, I_KV = 16 * 32;
    constexpr int NITEMS = I_IN + I_C + 4 * I_S + I_KV;
    for (int it = gw; it < NITEMS; it += NGW) {
        int r = it;
        if (r < I_IN) { transpose_item64(w_in, DM, PROJ_LD, win, DM, 0, nullptr, 1, scr, r, F.lane); continue; } r -= I_IN;
        if (r < I_C) { transpose_item64(w_conv_out, 512, DM, wcat, 1536, 0, nullptr, 0, scr, r, F.lane); continue; } r -= I_C;
        if (r < I_S) { transpose_item64(w_ret_out, DM, DM, wcat, 1536, 512, nullptr, 0, scr, r, F.lane); continue; } r -= I_S;
        if (r < I_S) { transpose_item64(w_mix_out, DM, DM, wmix, DM, 0, nullptr, 0, scr, r, F.lane); continue; } r -= I_S;
        if (r < I_S) { transpose_item64(w_xa_q, DM, DM, wq, DM, 0, xa_g, 0, scr, r, F.lane); continue; } r -= I_S;
        if (r < I_S) { transpose_item64(w_xa_o, DM, DM, wo, DM, 0, nullptr, 0, scr, r, F.lane); continue; } r -= I_S;
        transpose_item64(w_xa_kv, DM, 2048, wkv, DM, 0, nullptr, 0, scr, r, F.lane);
    }
    const int gt = F.vcu * NTHR + F.tid, NGT = F.G * NTHR;
    {   const float* w_group = a.in[14]; const float* w_router = a.in[16];
        for (int i = gt; i < 48 * DM; i += NGT) { const int n = i >> 10, k = i & 1023; float v = 0.f;
            if (n < 4) v = w_group[k * 4 + n] * moe_g[k]; else if (n < 36) v = w_router[k * 32 + (n - 4)] * moe_g[k];
            wrt[i] = f2bf(v); } }
    {   float2* rope = (float2*)(ws + WS_ROPE);
        for (int i = gt; i < SEQ * 32; i += NGT) { const int pos = i >> 5, p = i & 31;
            const float ang = (float)pos * (float)c_invfreq[p]; const double rev = (double)ang * 0.15915494309189535; const float fr = (float)(rev - floor(rev));
            rope[i] = make_float2(__builtin_amdgcn_cosf(fr), __builtin_amdgcn_sinf(fr)); } }
    const float* x = a.in[0]; const float* mem = a.in[1]; bf16* xn = (bf16*)(ws + WS_XN); bf16* mn = (bf16*)(ws + WS_MN);
    for (int m = gw; m < T; m += NGW) rms_row_to_bf16(x + (size_t)m * DM, a.in[2], xn + (size_t)m * DM, F.lane);
    for (int m = gw; m < NB * MEML; m += NGW) rms_row_to_bf16(mem + (size_t)m * DM, a.in[9], mn + (size_t)m * DM, F.lane);
}
DEVI void p9_route(Frame& F, const Args& a, unsigned char* ws, int cntoff = 0) {
    const bf16* HB = (const bf16*)(ws + WS_HB); const bf16* wrt = (const bf16*)(ws + WS_WRT); const float* ssq = (const float*)(ws + WS_SSQ2);
    const float* bg = a.in[15]; const float* br = a.in[17]; float* rs2 = (float*)(ws + WS_RS2); unsigned* cnt = (unsigned*)(ws + WS_CTL) + CW_CNT + cntoff; unsigned long long* lrec = (unsigned long long*)(ws + WS_LID);
    const int lane = F.lane, fr = lane & 15, fq = lane >> 4, w = F.wave, tid = F.tid;
    LAS float* lg = (LAS float*)F.lds;
    LAS unsigned* hist = (LAS unsigned*)(F.lds + 2 * 64 * 49 * 4); LAS unsigned* base = hist + 32;
    for (int tb = F.vcu; tb < T / 64; tb += F.G) {
        if (tid < 32) hist[tid] = 0u;
        {   const int tg = w & 3, kh = w >> 2, tok0 = tb * 64 + tg * 16;
            f32x4 acc[3]; acc[0] = acc[1] = acc[2] = (f32x4){0.f, 0.f, 0.f, 0.f};
            const bf16* ap = HB + (size_t)(tok0 + fr) * DM + 512 * kh + 8 * fq; const bf16* bp = wrt + (size_t)fr * DM + 512 * kh + 8 * fq;
#pragma unroll 8
            for (int ks = 0; ks < 16; ++ks) { const bf16x8 av = *(const bf16x8*)(ap + 32 * ks);
#pragma unroll
                for (int nb = 0; nb < 3; ++nb) { const bf16x8 bv = *(const bf16x8*)(bp + (size_t)nb * 16 * DM + 32 * ks); acc[nb] = MFMA16(av, bv, acc[nb]); } }
            LAS float* l = lg + (kh * 64 + tg * 16) * 49;
#pragma unroll
            for (int nb = 0; nb < 3; ++nb)
#pragma unroll
                for (int r = 0; r < 4; ++r) l[(4 * fq + r) * 49 + 16 * nb + fr] = acc[nb][r];
        }
        __syncthreads();
        int E1 = 0, E2 = 0; unsigned r1 = 0, r2 = 0; float w1 = 0.f, w2 = 0.f, rsv = 0.f;
        if (tid < 64) {
            const int tok = tb * 64 + tid; const float rs = rstd_from_ssq(ssq, tok); rsv = rs; const LAS float* l0 = lg + tid * 49; const LAS float* l1 = l0 + 64 * 49;
            int gi = 0; float gm = -3.0e38f, gs = 0.f; float l4[4];
#pragma unroll
            for (int n = 0; n < 4; ++n) l4[n] = (l0[n] + l1[n]) * rs + bg[n];
#pragma unroll
            for (int n = 0; n < 4; ++n) if (l4[n] > gm) { gm = l4[n]; gi = n; }
#pragma unroll
            for (int n = 0; n < 4; ++n) gs += __expf(l4[n] - gm);
            const float pg = 1.f / gs; float le[8];
#pragma unroll
            for (int n = 0; n < 8; ++n) le[n] = (l0[4 + gi * 8 + n] + l1[4 + gi * 8 + n]) * rs + br[gi * 8 + n];
            int e1 = 0; float m1 = -3.0e38f;
#pragma unroll
            for (int n = 0; n < 8; ++n) if (le[n] > m1) { m1 = le[n]; e1 = n; }
            int e2 = 0; float m2 = -3.0e38f;
#pragma unroll
            for (int n = 0; n < 8; ++n) if (n != e1 && le[n] > m2) { m2 = le[n]; e2 = n; }
            const float x2 = __expf(m2 - m1); w1 = pg / (1.f + x2); w2 = pg * x2 / (1.f + x2);
            E1 = gi * 8 + e1; E2 = gi * 8 + e2;
            r1 = __hip_atomic_fetch_add(hist + E1, 1u, __ATOMIC_RELAXED, __HIP_MEMORY_SCOPE_WORKGROUP); r2 = __hip_atomic_fetch_add(hist + E2, 1u, __ATOMIC_RELAXED, __HIP_MEMORY_SCOPE_WORKGROUP);
        }
        __syncthreads();
        if (tid < 32) { const unsigned hc = hist[tid]; base[tid] = hc ? atomicAdd(&cnt[tid * CNT_STRIDE], hc) : 0u; }
        __syncthreads();
        if (tid < 64) { const int tok = tb * 64 + tid; const unsigned p1 = base[E1] + r1, p2 = base[E2] + r2;
            __hip_atomic_store(lrec + E1 * 16384 + p1, (unsigned long long)(unsigned)(tok * 2) | ((unsigned long long)__float_as_uint(w1) << 32), __ATOMIC_RELAXED, __HIP_MEMORY_SCOPE_AGENT);
            __hip_atomic_store(lrec + E2 * 16384 + p2, (unsigned long long)(unsigned)(tok * 2 + 1) | ((unsigned long long)__float_as_uint(w2) << 32), __ATOMIC_RELAXED, __HIP_MEMORY_SCOPE_AGENT); rs2[tok] = rsv; }
        __syncthreads();
    }
    {
        LAS unsigned char* scr = F.lds + F.wave * TI_BYTES;
        const float* w_gate = a.in[18]; const float* w_up = a.in[19]; const float* w_down = a.in[20]; const float* moe_g = a.in[13];
        bf16* egu = (bf16*)(ws + WS_EGU); bf16* ed = (bf16*)(ws + WS_ED);
        for (int it = F.gw(); it < 3 * NE * 128; it += F.ngw()) { const int ty = it / (NE * 128), r = it % (NE * 128), e = r >> 7, li = r & 127;
            if (ty == 0) transpose_item64(w_gate + (size_t)e * DM * EH, DM, EH, egu + (size_t)e * 1024 * DM, DM, 0, moe_g, 2, scr, li, lane);
            else if (ty == 1) transpose_item64(w_up + (size_t)e * DM * EH, DM, EH, egu + (size_t)e * 1024 * DM, DM, 0, moe_g, 3, scr, li, lane);
            else transpose_item64(w_down + (size_t)e * EH * DM, EH, DM, ed + (size_t)e * 1024 * EH, EH, 0, nullptr, 0, scr, li, lane); }
    }
}
DEVI void p13_final(Frame& F, const Args& a, unsigned char* ws) {
    float* O = a.out; const bf16* HB = (const bf16*)(ws + WS_HB); const bf16* YB = (const bf16*)(ws + WS_XS); const f32x4* g4 = (const f32x4*)a.in[21];
    for (int row = F.gw(); row < T; row += F.ngw()) {
        f32x4* orow = (f32x4*)(O + (size_t)row * DM); const u32x2* hr = (const u32x2*)(HB + (size_t)row * DM); const u32x2* y0 = (const u32x2*)(YB + (size_t)(2 * row) * DM); const u32x2* y1 = (const u32x2*)(YB + (size_t)(2 * row + 1) * DM);
        f32x4 v[4]; float s = 0.f;
#pragma unroll
        for (int j = 0; j < 4; ++j) { const int i = F.lane + 64 * j; const u32x2 hh = hr[i], a0 = y0[i], a1 = y1[i];
            v[j].x = bflo(hh.x) + bflo(a0.x) + bflo(a1.x); v[j].y = bfhi(hh.x) + bfhi(a0.x) + bfhi(a1.x); v[j].z = bflo(hh.y) + bflo(a0.y) + bflo(a1.y); v[j].w = bfhi(hh.y) + bfhi(a0.y) + bfhi(a1.y);
            s += (v[j].x * v[j].x + v[j].y * v[j].y) + (v[j].z * v[j].z + v[j].w * v[j].w); }
        const float rstd = rsqrtf(wave_sum(s) * (1.f / DM) + EPS);
#pragma unroll
        for (int j = 0; j < 4; ++j) { const int i = F.lane + 64 * j; orow[i] = v[j] * rstd * g4[i]; }
    }
}

DEVI bf16x8 pack_frag(const f32x4 a, const f32x4 b) { const u32x4 w = pack8(a, b); return __builtin_bit_cast(bf16x8, w); }
constexpr int RT_QP = 160, RT_VP = 288, RT_SP = 144;
constexpr int RT_Q = 0, RT_K = 128 * RT_QP, RT_V = 2 * 128 * RT_QP, RT_S = RT_V + 128 * RT_VP, RT_O = RT_S + 128 * RT_SP, RT_OP = 272, RT_END = RT_O + 8 * 16 * RT_OP;
static_assert(RT_END <= RING_BYTES, "retention LDS");
template <bool OUT> DEVI void ret_unit(Frame& F, int un, bf16* proj, float* Eg) {
    const int b = un >> 6, h = (un >> 3) & 7, grp = un & 7, lane = F.lane, w = F.wave, fr = lane & 15, fq = lane >> 4, tid = F.tid;
    const float lg2 = __log2f(1.f - exp2f(-5.f - (float)h)), cd = exp2f(128.f * lg2);
    LAS unsigned char* L = F.lds;
    f32x4 sb[4];
#pragma unroll
    for (int db = 0; db < 4; ++db) sb[db] = (f32x4){0.f, 0.f, 0.f, 0.f};
    if (OUT) {
        const float cd4 = cd * cd * cd * cd; f32x4 ev[7][4];
        const float* e0 = Eg + (size_t)(un - grp) * 8192 + (16 * w + fr) * 64 + 4 * fq;
#pragma unroll
        for (int gp = 0; gp < 7; ++gp) if (gp < grp) {
#pragma unroll
            for (int db = 0; db < 4; ++db) ev[gp][db] = *(const f32x4*)(e0 + (size_t)gp * 8192 + 16 * db); }
#pragma unroll
        for (int gp = 0; gp < 7; ++gp) if (gp < grp) {
#pragma unroll
            for (int db = 0; db < 4; ++db) sb[db] = sb[db] * cd4 + ev[gp][db]; }
    }
    const int q4 = (lane & 15) >> 2, p4 = lane & 3;
    for (int n = 0; n < 4; ++n) {
        const size_t t0 = (size_t)b * SEQ + (size_t)(grp * 4 + n) * 128;
#pragma unroll
        for (int i = 0; i < 2; ++i) { const int idx = tid + 512 * i, row = idx >> 3, c = idx & 7; const bf16* g = proj + (t0 + row) * PROJ_LD + h * 64 + c * 8;
            *(LAS u32x4*)(L + RT_K + row * RT_QP + c * 16) = *(const u32x4*)(g + C_K);
            if (OUT) *(LAS u32x4*)(L + RT_Q + row * RT_QP + c * 16) = *(const u32x4*)(g + C_Q); }
#pragma unroll
        for (int i = 0; i < 4; ++i) { const int idx = tid + 512 * i, row = idx >> 4, c = idx & 15;
            *(LAS u32x4*)(L + RT_V + row * RT_VP + c * 16) = *(const u32x4*)(proj + (t0 + row) * PROJ_LD + C_V + h * 128 + c * 8); }
        u32x4 gv[4];
        bf16* grow = proj + (t0 + 16 * w + (lane >> 2)) * PROJ_LD + C_G + h * 128 + 32 * (lane & 3);
        if (OUT) {
#pragma unroll
            for (int i = 0; i < 4; ++i) gv[i] = *(const u32x4*)(grow + 8 * i); }
#pragma unroll
        for (int db = 0; db < 4; ++db) { sb[db] = sb[db] * cd;
            if (OUT) { u32x2 wv; wv.x = cvt_pk_bf16(sb[db][0], sb[db][1]); wv.y = cvt_pk_bf16(sb[db][2], sb[db][3]); *(LAS u32x2*)(L + RT_S + (16 * w + fr) * RT_SP + (16 * db + 4 * fq) * 2) = wv; } }
        __syncthreads();
        if (OUT) {
            bf16x8 qf[2];
#pragma unroll
            for (int ks = 0; ks < 2; ++ks) qf[ks] = *(const LAS bf16x8*)(L + RT_Q + (16 * w + fr) * RT_QP + 64 * ks + 16 * fq);
            f32x4 o[8];
#pragma unroll
            for (int d = 0; d < 8; ++d) o[d] = (f32x4){0.f, 0.f, 0.f, 0.f};
#pragma unroll
            for (int ks = 0; ks < 2; ++ks)
#pragma unroll
                for (int d = 0; d < 8; ++d) { const bf16x8 sf = *(const LAS bf16x8*)(L + RT_S + (16 * d + fr) * RT_SP + 64 * ks + 16 * fq); o[d] = MFMA16(qf[ks], sf, o[d]); }
            for (int s = 0; 2 * s <= w; ++s) {
                f32x4 st[2];
#pragma unroll
                for (int hh = 0; hh < 2; ++hh) { const int kb = 2 * s + hh; st[hh] = (f32x4){0.f, 0.f, 0.f, 0.f};
                    if (kb <= w) {
#pragma unroll
                        for (int ks = 0; ks < 2; ++ks) { const bf16x8 kf = *(const LAS bf16x8*)(L + RT_K + (16 * kb + fr) * RT_QP + 64 * ks + 16 * fq); st[hh] = MFMA16(kf, qf[ks], st[hh]); }
                        if (kb == w) {
#pragma unroll
                            for (int r = 0; r < 4; ++r) if (4 * fq + r > fr) st[hh][r] = 0.f; }
                    } }
                const bf16x8 pa = pack_frag(st[0], st[1]);
                const LAS unsigned char* vb = L + RT_V + (32 * s + 4 * fq + q4) * RT_VP + 8 * p4;
#pragma unroll
                for (int d = 0; d < 8; ++d) { const bf16x8 vf = tr_frag(vb + 32 * d, vb + 16 * RT_VP + 32 * d); o[d] = MFMA16(pa, vf, o[d]); }
            }
            LAS unsigned char* ot = L + RT_O + w * (16 * RT_OP);
#pragma unroll
            for (int r = 0; r < 4; ++r) { float s1 = 0.f;
#pragma unroll
                for (int d = 0; d < 8; ++d) s1 += o[d][r];
                s1 += __shfl_xor(s1, 1); s1 += __shfl_xor(s1, 2); s1 += __shfl_xor(s1, 4); s1 += __shfl_xor(s1, 8);
                const float mu = s1 * (1.f / 128.f); float s2 = 0.f;
#pragma unroll
                for (int d = 0; d < 8; ++d) { const float dd = o[d][r] - mu; s2 += dd * dd; }
                s2 += __shfl_xor(s2, 1); s2 += __shfl_xor(s2, 2); s2 += __shfl_xor(s2, 4); s2 += __shfl_xor(s2, 8);
                const float rs = rsqrtf(s2 * (1.f / 128.f) + EPS);
#pragma unroll
                for (int d = 0; d < 8; ++d) *(LAS bf16*)(ot + (4 * fq + r) * RT_OP + (16 * d + fr) * 2) = f2bf((o[d][r] - mu) * rs); }
            LDS_WAIT(); asm volatile("" ::: "memory");
#pragma unroll
            for (int i = 0; i < 4; ++i) { const u32x4 ov = *(const LAS u32x4*)(ot + (lane >> 2) * RT_OP + 64 * (lane & 3) + 16 * i); u32x4 res;
#pragma unroll
                for (int q = 0; q < 4; ++q) { const float g0 = bflo(gv[i][q]), g1 = bfhi(gv[i][q]); res[q] = cvt_pk_bf16(g0 * sigmoidf_(g0) * bflo(ov[q]), g1 * sigmoidf_(g1) * bfhi(ov[q])); }
                *(u32x4*)(grow + 8 * i) = res; }
        }
        {   const LAS unsigned char* kb_ = L + RT_K + (4 * fq + q4) * RT_QP + 8 * p4; const LAS unsigned char* vb_ = L + RT_V + (4 * fq + q4) * RT_VP + 32 * w + 8 * p4;
#pragma unroll
            for (int ks = 0; ks < 4; ++ks) { const bf16x8 vf = tr_frag(vb_ + 32 * ks * RT_VP, vb_ + (32 * ks + 16) * RT_VP);
#pragma unroll
                for (int db = 0; db < 4; ++db) { const bf16x8 kf = tr_frag(kb_ + 32 * ks * RT_QP + 32 * db, kb_ + (32 * ks + 16) * RT_QP + 32 * db); sb[db] = MFMA16(kf, vf, sb[db]); } }
        }
        __syncthreads();
    }
    if (!OUT) { float* e = Eg + (size_t)un * 8192 + (16 * w + fr) * 64 + 4 * fq;
#pragma unroll
        for (int db = 0; db < 4; ++db) *(f32x4*)(e + 16 * db) = sb[db]; }
}
DEVI void conv_rows(Frame& F, bf16* proj, const float* cw, bf16* outb, int ldo) {
    const int lane = F.lane; float w0[8], w1[8], w2[8];
#pragma unroll
    for (int j = 0; j < 8; ++j) { w0[j] = cw[8 * lane + j]; w1[j] = cw[512 + 8 * lane + j]; w2[j] = cw[1024 + 8 * lane + j]; }
    for (int blk = F.gw(); blk < T / 4; blk += F.ngw()) {
        const int t0 = blk * 4, tb = t0 & ~(SEQ - 1); u32x4 xv[6], cv[6], bv[4];
#pragma unroll
        for (int i = 0; i < 6; ++i) { const int t = t0 - 2 + i; const bool ok = t >= tb; const bf16* r = proj + (size_t)(ok ? t : t0) * PROJ_LD + 8 * lane;
            xv[i] = *(const u32x4*)(r + C_XIN); cv[i] = *(const u32x4*)(r + C_CG); if (!ok) { xv[i] = (u32x4){0u, 0u, 0u, 0u}; } }
#pragma unroll
        for (int i = 0; i < 4; ++i) bv[i] = *(const u32x4*)(proj + (size_t)(t0 + i) * PROJ_LD + C_BG + 8 * lane);
        float u[6][8];
#pragma unroll
        for (int i = 0; i < 6; ++i)
#pragma unroll
            for (int q = 0; q < 4; ++q) { u[i][2 * q] = bflo(xv[i][q]) * bflo(cv[i][q]); u[i][2 * q + 1] = bfhi(xv[i][q]) * bfhi(cv[i][q]); }
#pragma unroll
        for (int i = 0; i < 4; ++i) { u32x4 ov;
#pragma unroll
            for (int q = 0; q < 4; ++q) { const float a0 = bflo(bv[i][q]) * (w0[2 * q] * u[i][2 * q] + w1[2 * q] * u[i + 1][2 * q] + w2[2 * q] * u[i + 2][2 * q]);
                const float a1 = bfhi(bv[i][q]) * (w0[2 * q + 1] * u[i][2 * q + 1] + w1[2 * q + 1] * u[i + 1][2 * q + 1] + w2[2 * q + 1] * u[i + 2][2 * q + 1]); ov[q] = cvt_pk_bf16(a0, a1); }
            *(u32x4*)(outb + (size_t)(t0 + i) * ldo + 8 * lane) = ov; }
    }
}
constexpr int XA_KP = 528, XA_VP = 544, XA_BUF = 64 * XA_VP;
static_assert(2 * XA_BUF <= RING_BYTES, "xattn LDS");
DEVI void xattn_unit(Frame& F, int un, const bf16* Q, const bf16* kvm, bf16* O) {
    const int bh = un >> 5, rb = un & 31, b = bh >> 2, h = bh & 3, lane = F.lane, w = F.wave, fr = lane & 15, fq = lane >> 4, tid = F.tid, q4 = (lane & 15) >> 2, p4 = lane & 3;
    const size_t q0 = (size_t)b * SEQ + rb * 128 + 16 * w;
    LAS unsigned char* L = F.lds;
    const bf16* kbase = kvm + (size_t)(b * MEML) * 2048 + h * XHD;
    bf16x8 qf[8];
#pragma unroll
    for (int ks = 0; ks < 8; ++ks) qf[ks] = *(const bf16x8*)(Q + (q0 + fr) * DM + h * XHD + 32 * ks + 8 * fq);
    u32x4 sr[4];
#define XA_LOAD(sl) do { const bf16* src_ = kbase + ((sl) >= 4 ? 1024 : 0) + (size_t)(((sl) & 3) * 64) * 2048; \
        _Pragma("unroll") for (int i = 0; i < 4; ++i) { const int idx = tid + 512 * i, row = idx >> 5, c = idx & 31; sr[i] = *(const u32x4*)(src_ + (size_t)row * 2048 + c * 8); } } while (0)
#define XA_WRITE(sl) do { const int pitch_ = (sl) >= 4 ? XA_VP : XA_KP; LAS unsigned char* dst_ = L + ((sl) & 1) * XA_BUF; \
        _Pragma("unroll") for (int i = 0; i < 4; ++i) { const int idx = tid + 512 * i, row = idx >> 5, c = idx & 31; *(LAS u32x4*)(dst_ + row * pitch_ + c * 16) = sr[i]; } } while (0)
    XA_LOAD(0); XA_WRITE(0);
    __syncthreads();
    f32x4 st[16];
#pragma unroll
    for (int j = 0; j < 4; ++j) {
        XA_LOAD(j + 1);
        const LAS unsigned char* kb_ = L + (j & 1) * XA_BUF + fr * XA_KP + 16 * fq;
#pragma unroll
        for (int kk = 0; kk < 4; ++kk) { f32x4 a = (f32x4){0.f, 0.f, 0.f, 0.f};
#pragma unroll
            for (int ks = 0; ks < 8; ++ks) { const bf16x8 kf = *(const LAS bf16x8*)(kb_ + 16 * kk * XA_KP + 64 * ks); a = MFMA16(kf, qf[ks], a); }
            st[4 * j + kk] = a; }
        XA_WRITE(j + 1);
        __syncthreads();
    }
    float mx = -3.0e38f;
#pragma unroll
    for (int kb = 0; kb < 16; ++kb) mx = fmaxf(fmaxf(fmaxf(mx, st[kb][0]), fmaxf(st[kb][1], st[kb][2])), st[kb][3]);
    mx = fmaxf(mx, __shfl_xor(mx, 16)); mx = fmaxf(mx, __shfl_xor(mx, 32));
    float sm = 0.f;
#pragma unroll
    for (int kb = 0; kb < 16; ++kb)
#pragma unroll
        for (int r = 0; r < 4; ++r) { const float p = exp2f(st[kb][r] - mx); st[kb][r] = p; sm += p; }
    sm += __shfl_xor(sm, 16); sm += __shfl_xor(sm, 32);
    bf16x8 pa[8];
#pragma unroll
    for (int s = 0; s < 8; ++s) pa[s] = pack_frag(st[2 * s], st[2 * s + 1]);
    f32x4 o[16];
#pragma unroll
    for (int d = 0; d < 16; ++d) o[d] = (f32x4){0.f, 0.f, 0.f, 0.f};
#pragma unroll
    for (int j = 4; j < 8; ++j) {
        if (j < 7) XA_LOAD(j + 1);
        const LAS unsigned char* vb_ = L + (j & 1) * XA_BUF + (4 * fq + q4) * XA_VP + 8 * p4;
#pragma unroll
        for (int s2 = 0; s2 < 2; ++s2)
#pragma unroll
            for (int d = 0; d < 16; ++d) { const bf16x8 vf = tr_frag(vb_ + 32 * s2 * XA_VP + 32 * d, vb_ + (32 * s2 + 16) * XA_VP + 32 * d); o[d] = MFMA16(pa[2 * (j - 4) + s2], vf, o[d]); }
        if (j < 7) XA_WRITE(j + 1);
        __syncthreads();
    }
#undef XA_LOAD
#undef XA_WRITE
    const float inv = 1.f / sm;
    LAS unsigned char* ot = L + w * (16 * XA_KP);
#pragma unroll
    for (int r = 0; r < 4; ++r) { const float iv = __shfl(inv, 4 * fq + r);
#pragma unroll
        for (int d = 0; d < 16; ++d) *(LAS bf16*)(ot + (4 * fq + r) * XA_KP + (16 * d + fr) * 2) = f2bf(o[d][r] * iv); }
    LDS_WAIT(); asm volatile("" ::: "memory");
    {   bf16* op = O + (q0 + (lane >> 2)) * DM + h * XHD + 64 * (lane & 3); const LAS unsigned char* rp = ot + (lane >> 2) * XA_KP + 128 * (lane & 3);
#pragma unroll
        for (int i = 0; i < 8; ++i) *(u32x4*)(op + 8 * i) = *(const LAS u32x4*)(rp + 16 * i); }
    __syncthreads();
}

constexpr int NPH = 14;
struct ArgsK { Args a; int li, pad; };
__global__ void __launch_bounds__(NTHR, 2) mega(ArgsK ak) {
    extern __shared__ __attribute__((aligned(16))) unsigned char lds_raw[];
    const Args& args = ak.a;
    Frame F; F.lds = (LAS unsigned char*)lds_raw; F.tid = threadIdx.x; F.lane = F.tid & 63; F.wave = __builtin_amdgcn_readfirstlane(F.tid >> 6);
    F.G = gridDim.x; { const int bx = blockIdx.x; F.vcu = (F.G % 8 == 0) ? (bx % 8) * (F.G / 8) + bx / 8 : bx; }
    unsigned char* ws = args.ws; gu32* ctl = (gu32*)(ws + WS_CTL);
    for (int u = F.tid; u < (LDS_BYTES - LDSCTL_OFF) / 4; u += NTHR) ((LAS unsigned*)(F.lds + LDSCTL_OFF))[u] = 0u;
    __syncthreads();
    const int lo = args.ph_lo, hi = args.ph_hi;
    XcdBarrier bar; bar.bar = (unsigned*)(ctl + CW_BAR) + ak.li * XCD_BAR_WORDS; bar.x = 0; bar.st = nullptr;
    if (hi - lo > 1) bar = xcd_barrier_post((unsigned*)(ctl + CW_BAR) + ak.li * XCD_BAR_WORDS, (volatile LAS unsigned*)(F.lds + MISC_OFF) + 8);
#define IN(k) (lo <= (k) && (k) < hi)
#define SEAM(k) do { if (IN(k) && ((k) + 1 < hi)) xcd_barrier(bar); } while (0)
    const int bx = (int)blockIdx.x;
    bf16* proj = (bf16*)(ws + WS_PROJ); bf16* xn = (bf16*)(ws + WS_XN); bf16* hb = (bf16*)(ws + WS_HB); float* H = args.out;
    float* ssq1 = (float*)(ws + WS_SSQ1); float* ssq2 = (float*)(ws + WS_SSQ2); const unsigned* cnt = (const unsigned*)(ws + WS_CTL) + CW_CNT;

    if (IN(0)) { { p0_prologue(F, args, ws); } SEAM(0); }
    if (IN(1)) { {
        SchedInproj S{F.G, bx, (const char*)xn, (const char*)(ws + WS_MN), (const char*)(ws + WS_WIN), (const char*)(ws + WS_WKV)};
        EpiProj E{proj, (bf16*)(ws + WS_KVM), (const float2*)(ws + WS_ROPE)};
        gemm_phase<EpiProj, SchedInproj, 0>(F.lds, S, E, DM, DM, DM / 64, 0);
        } SEAM(1);
    }
    if (IN(2)) { {
        conv_rows(F, proj, args.in[4], proj + C_BG, PROJ_LD);
        for (int un = F.vcu; un < 256; un += F.G) ret_unit<false>(F, un, proj, (float*)(ws + WS_E));
        } SEAM(2);
    }
    if (IN(3)) { { for (int un = F.vcu; un < 256; un += F.G) ret_unit<true>(F, un, proj, (float*)(ws + WS_E)); } SEAM(3); }
    if (IN(4)) { {
        SchedSimple S{F.G, bx, (const char*)(proj + C_BG), (const char*)(ws + WS_WCAT), PROJ_LD, 1536};
        EpiMerge E{proj, xn};
        gemm_phase<EpiMerge, SchedSimple, 8>(F.lds, S, E, PROJ_LD, 1536, 24, (C_G - C_BG - 512) * 2);
        } SEAM(4);
    }
    if (IN(5)) { {
        SchedSimple S{F.G, bx, (const char*)xn, (const char*)(ws + WS_WMIX), DM, DM};
        EpiResid<false> E{args.in[0], hb, ssq1};
        gemm_phase<EpiResid<false>, SchedSimple, 0>(F.lds, S, E, DM, DM, DM / 64, 0);
        } SEAM(5);
    }
    if (IN(6)) { {
        SchedSimple S{F.G, bx, (const char*)hb, (const char*)(ws + WS_WQ), DM, DM};
        EpiQ E{ssq1, xn};
        gemm_phase<EpiQ, SchedSimple, 0>(F.lds, S, E, DM, DM, DM / 64, 0);
        } SEAM(6);
    }
    if (IN(7)) { { for (int un = F.vcu; un < 512; un += F.G) xattn_unit(F, un, xn, (const bf16*)(ws + WS_KVM), xn); } SEAM(7); }
    if (IN(8)) { {
        SchedSimple S{F.G, bx, (const char*)xn, (const char*)(ws + WS_WO), DM, DM};
        EpiResid<true> E{hb, hb, ssq2};
        gemm_phase<EpiResid<true>, SchedSimple, 0>(F.lds, S, E, DM, DM, DM / 64, 0);
        } SEAM(8);
    }
    if (IN(9)) { { p9_route(F, args, ws); } SEAM(9); }
    if (IN(11)) { {
        SchedMoe<true> S{F.G, bx, moe_table(F.lds, F.tid, cnt), (const LAS int*)(F.lds + TAB_OFF), (const unsigned long long*)(ws + WS_LID), (const char*)hb, (const char*)(ws + WS_EGU), DM, DM};
        EpiGU E{(const unsigned long long*)(ws + WS_LID), (const float*)(ws + WS_RS2), (bf16*)(ws + WS_HID)};
        gemm_phase<EpiGU, SchedMoe<true>, 0>(F.lds, S, E, DM, DM, DM / 64, 0);
        } SEAM(11);
    }
    if (IN(12)) { {
        SchedMoe<false> S{F.G, bx, moe_table(F.lds, F.tid, cnt), (const LAS int*)(F.lds + TAB_OFF), (const unsigned long long*)(ws + WS_LID), (const char*)(ws + WS_HID), (const char*)(ws + WS_ED), EH, EH};
        EpiDown E{(const unsigned long long*)(ws + WS_LID), (bf16*)(ws + WS_XS)};
        gemm_phase<EpiDown, SchedMoe<false>, 0>(F.lds, S, E, EH, EH, EH / 64, 0);
        } SEAM(12);
    }
    if (IN(13)) { { p13_final(F, args, ws); } }
#undef IN
#undef SEAM
}

extern "C" void kernel_launch(void* const* d_in, const int* in_sizes, int n_in, void* d_out, int out_size, void* d_ws, size_t ws_size, hipStream_t stream) {
    if (n_in != 22 || out_size != T * DM || ws_size < WS_END) { fprintf(stderr, "kernel_launch: unexpected shapes (n_in %d out %d ws %zu): nothing launched\n", n_in, out_size, ws_size); return; }
    static int grid = 0;
    if (grid == 0) {
        int dev = 0, cus = 0;
        if (hipGetDevice(&dev) != hipSuccess || hipDeviceGetAttribute(&cus, hipDeviceAttributeMultiprocessorCount, dev) != hipSuccess) { grid = -1; return; }
        if (hipFuncSetAttribute((const void*)mega, hipFuncAttributeMaxDynamicSharedMemorySize, LDS_BYTES) != hipSuccess) { fprintf(stderr, "kernel_launch: hipFuncSetAttribute failed\n"); grid = -1; return; }
        grid = cus;
        if (grid != 256) { fprintf(stderr, "kernel_launch: %d CUs (built for 256): nothing launched\n", grid); grid = -1; return; }
    }
    if (grid < 0) return;
    (void)hipMemsetAsync((char*)d_ws + WS_CTL, 0, 1 * MiB, stream);
    ArgsK ak{}; for (int i = 0; i < 22; ++i) ak.a.in[i] = (const float*)d_in[i]; ak.a.out = (float*)d_out; ak.a.ws = (unsigned char*)d_ws;
    ak.a.ph_lo = 0; ak.a.ph_hi = NPH; ak.li = 0; ak.pad = 0;
    hipLaunchKernelGGL(mega, dim3(grid), dim3(NTHR), LDS_BYTES, stream, ak);
}
```
